# Optimizing an MI355X kernel written in HIP

```python
import math
import jax, jax.numpy as jnp
from jax import lax
import numpy as np

D_MODEL = 4096
BATCH = 2
SEQ = 8192
DEPTH = 1

CHUNK = 64
N_META = 16
HEAD_DIM = 128
Q_BLOCK = 128
MIX_WIDTH = D_MODEL
DIFF_WIDTH = MIX_WIDTH // 2
FOX_WIDTH = MIX_WIDTH - DIFF_WIDTH
DIFF_V_DIM = 2 * HEAD_DIM
N_DIFF_HEADS = DIFF_WIDTH // DIFF_V_DIM
N_FOX_HEADS = FOX_WIDTH // HEAD_DIM
D_FF = 4 * D_MODEL
ROPE_THETA = 10000.0
LN_EPS = 1e-5
SUBLN_EPS = 1e-5
DEEPNORM_ALPHA = (2.0 * DEPTH) ** 0.25
DEEPNORM_BETA = (8.0 * DEPTH) ** -0.25

DQ_OFF = 0
DK_OFF = DQ_OFF + N_DIFF_HEADS * 2 * HEAD_DIM
DV_OFF = DK_OFF + N_DIFF_HEADS * 2 * HEAD_DIM
FQ_OFF = DV_OFF + N_DIFF_HEADS * DIFF_V_DIM
FK_OFF = FQ_OFF + N_FOX_HEADS * HEAD_DIM
FV_OFF = FK_OFF + N_FOX_HEADS * HEAD_DIM
FF_OFF = FV_OFF + N_FOX_HEADS * HEAD_DIM
IN_WIDTH = FF_OFF + N_FOX_HEADS

kernel_name = "hymba_diff_fox_deepnorm_block"


def _layer_norm(h, g, b):
    hf = h.astype(jnp.float32)
    mu = jnp.mean(hf, axis=-1, keepdims=True)
    var = jnp.mean(jnp.square(hf - mu), axis=-1, keepdims=True)
    y = (hf - mu) * lax.rsqrt(var + LN_EPS) * g.astype(jnp.float32) + b.astype(jnp.float32)
    return y.astype(h.dtype)


def _rope_tables(n):
    inv = 1.0 / (ROPE_THETA ** (jnp.arange(0, HEAD_DIM, 2, dtype=jnp.float32) / HEAD_DIM))
    ang = jnp.arange(n, dtype=jnp.float32)[:, None] * inv[None, :]
    ang = jnp.concatenate([ang, ang], axis=-1)
    return jnp.cos(ang), jnp.sin(ang)


def _apply_rope(t, cos, sin):
    t1, t2 = jnp.split(t, 2, axis=-1)
    rot = jnp.concatenate([-t2, t1], axis=-1)
    out = t.astype(jnp.float32) * cos[:, None, :] + rot.astype(jnp.float32) * sin[:, None, :]
    return out.astype(t.dtype)


def _chunk_ids(n):
    pos = jnp.arange(n)
    return jnp.where(pos < N_META, 0, 1 + (pos - N_META) // CHUNK)


def _pad_seq(a, pad):
    return jnp.pad(a, [(0, 0), (0, pad)] + [(0, 0)] * (a.ndim - 2))


def _sweep(block_fn, n_pad, batch):
    out = lax.map(block_fn, jnp.arange(n_pad // Q_BLOCK))
    out = jnp.moveaxis(out, 0, 1)
    return out.reshape(batch, n_pad, out.shape[3], out.shape[4])


def _diff_attention(q, k, v, lam, lambda_init, subln_g):
    B, L = q.shape[0], q.shape[1]
    Lp = -(-L // Q_BLOCK) * Q_BLOCK
    pad = Lp - L
    qp, kp, vp = _pad_seq(q, pad), _pad_seq(k, pad), _pad_seq(v, pad)
    cid = _chunk_ids(Lp)
    key_ok = jnp.arange(Lp) < L
    scale = HEAD_DIM ** -0.5

    def block(bi):
        start = bi * Q_BLOCK
        qb = lax.dynamic_slice_in_dim(qp, start, Q_BLOCK, axis=1)
        qc = lax.dynamic_slice_in_dim(cid, start, Q_BLOCK)
        s = jnp.einsum('bqhcd,bkhcd->bhcqk', qb, kp).astype(jnp.float32) * scale
        mask = (cid[None, :] <= qc[:, None]) & key_ok[None, :]
        s = jnp.where(mask, s, -jnp.inf)
        p = jax.nn.softmax(s, axis=-1)
        a = (p[:, :, 0] - lam * p[:, :, 1]).astype(vp.dtype)
        return jnp.einsum('bhqk,bkhe->bqhe', a, vp)

    o = _sweep(block, Lp, B)[:, :L]
    of = o.astype(jnp.float32)
    of = of * lax.rsqrt(jnp.mean(jnp.square(of), axis=-1, keepdims=True) + SUBLN_EPS)
    of = of * subln_g.astype(jnp.float32) * (1.0 - lambda_init)
    return of.astype(v.dtype).reshape(B, L, -1)


def _forgetting_attention(q, k, v, log_f):
    B, L = q.shape[0], q.shape[1]
    Lp = -(-L // Q_BLOCK) * Q_BLOCK
    pad = Lp - L
    c = jnp.cumsum(log_f, axis=1)
    cT = jnp.transpose(_pad_seq(c, pad), (0, 2, 1))
    qp, kp, vp = _pad_seq(q, pad), _pad_seq(k, pad), _pad_seq(v, pad)
    idx = jnp.arange(Lp)
    scale = HEAD_DIM ** -0.5

    def block(bi):
        start = bi * Q_BLOCK
        qb = lax.dynamic_slice_in_dim(qp, start, Q_BLOCK, axis=1)
        cq = lax.dynamic_slice_in_dim(cT, start, Q_BLOCK, axis=2)
        qi = start + jnp.arange(Q_BLOCK)
        s = jnp.einsum('bqhd,bkhd->bhqk', qb, kp).astype(jnp.float32) * scale
        s = s + (cq[..., :, None] - cT[..., None, :])
        mask = idx[None, :] <= qi[:, None]
        s = jnp.where(mask, s, -jnp.inf)
        p = jax.nn.softmax(s, axis=-1).astype(vp.dtype)
        return jnp.einsum('bhqk,bkhd->bqhd', p, vp)

    o = _sweep(block, Lp, B)[:, :L]
    return o.reshape(B, L, -1)


def setup_inputs(seed: int = 0) -> dict:
    key = jax.random.key(seed)
    ks = jax.random.split(key, 20)
    f32 = jnp.float32
    x = jax.random.normal(ks[0], (BATCH, SEQ, D_MODEL), f32)
    meta_tokens = jax.random.normal(ks[1], (N_META, D_MODEL), f32)
    ln_in_g = 1.0 + 0.02 * jax.random.normal(ks[2], (D_MODEL,), f32)
    ln_in_b = 0.02 * jax.random.normal(ks[3], (D_MODEL,), f32)
    col_scale = jnp.ones((IN_WIDTH,), f32)
    col_scale = col_scale.at[DV_OFF:FQ_OFF].set(DEEPNORM_BETA).at[FV_OFF:FF_OFF].set(DEEPNORM_BETA)
    w_in = jax.random.normal(ks[4], (DEPTH, D_MODEL, IN_WIDTH), f32) * (D_MODEL ** -0.5) * col_scale
    b_forget = 1.0 + 3.0 * jax.random.uniform(ks[5], (DEPTH, N_FOX_HEADS), f32)
    lambda_q1 = 0.1 * jax.random.normal(ks[6], (DEPTH, HEAD_DIM), f32)
    lambda_k1 = 0.1 * jax.random.normal(ks[7], (DEPTH, HEAD_DIM), f32)
    lambda_q2 = 0.1 * jax.random.normal(ks[8], (DEPTH, HEAD_DIM), f32)
    lambda_k2 = 0.1 * jax.random.normal(ks[9], (DEPTH, HEAD_DIM), f32)
    subln_g = 1.0 + 0.02 * jax.random.normal(ks[10], (DEPTH, DIFF_V_DIM), f32)
    w_out = jax.random.normal(ks[11], (DEPTH, MIX_WIDTH, D_MODEL), f32) * (MIX_WIDTH ** -0.5) * DEEPNORM_BETA
    ln_attn_g = 1.0 + 0.02 * jax.random.normal(ks[12], (DEPTH, D_MODEL), f32)
    ln_attn_b = 0.02 * jax.random.normal(ks[13], (DEPTH, D_MODEL), f32)
    w_up = jax.random.normal(ks[14], (DEPTH, D_MODEL, D_FF), f32) * (D_MODEL ** -0.5) * DEEPNORM_BETA
    w_down = jax.random.normal(ks[15], (DEPTH, D_FF, D_MODEL), f32) * (D_FF ** -0.5) * DEEPNORM_BETA
    ln_mlp_g = 1.0 + 0.02 * jax.random.normal(ks[16], (DEPTH, D_MODEL), f32)
    ln_mlp_b = 0.02 * jax.random.normal(ks[17], (DEPTH, D_MODEL), f32)
    return {"x": x, "meta_tokens": meta_tokens, "ln_in_g": ln_in_g, "ln_in_b": ln_in_b,
            "w_in": w_in, "b_forget": b_forget, "lambda_q1": lambda_q1, "lambda_k1": lambda_k1,
            "lambda_q2": lambda_q2, "lambda_k2": lambda_k2, "subln_g": subln_g, "w_out": w_out,
            "ln_attn_g": ln_attn_g, "ln_attn_b": ln_attn_b, "w_up": w_up, "w_down": w_down,
            "ln_mlp_g": ln_mlp_g, "ln_mlp_b": ln_mlp_b}


def reference(x, meta_tokens, ln_in_g, ln_in_b, w_in, b_forget, lambda_q1, lambda_k1,
              lambda_q2, lambda_k2, subln_g, w_out, ln_attn_g, ln_attn_b, w_up, w_down,
              ln_mlp_g, ln_mlp_b):
    B = x.shape[0]
    meta = jnp.broadcast_to(meta_tokens[None].astype(x.dtype), (B, N_META, x.shape[2]))
    h = jnp.concatenate([meta, x], axis=1)
    h = _layer_norm(h, ln_in_g, ln_in_b)
    L = h.shape[1]
    cos, sin = _rope_tables(L)

    for li in range(DEPTH):
        lambda_init = 0.8 - 0.6 * math.exp(-0.3 * li)
        proj = jnp.einsum('bld,de->ble', h, w_in[li])
        dq = _apply_rope(proj[..., DQ_OFF:DK_OFF].reshape(B, L, 2 * N_DIFF_HEADS, HEAD_DIM), cos, sin)
        dk = _apply_rope(proj[..., DK_OFF:DV_OFF].reshape(B, L, 2 * N_DIFF_HEADS, HEAD_DIM), cos, sin)
        dq = dq.reshape(B, L, N_DIFF_HEADS, 2, HEAD_DIM)
        dk = dk.reshape(B, L, N_DIFF_HEADS, 2, HEAD_DIM)
        dv = proj[..., DV_OFF:FQ_OFF].reshape(B, L, N_DIFF_HEADS, DIFF_V_DIM)
        lam = (jnp.exp(jnp.sum(lambda_q1[li].astype(jnp.float32) * lambda_k1[li].astype(jnp.float32)))
               - jnp.exp(jnp.sum(lambda_q2[li].astype(jnp.float32) * lambda_k2[li].astype(jnp.float32)))
               + lambda_init)
        diff_out = _diff_attention(dq, dk, dv, lam, lambda_init, subln_g[li])
        fq = proj[..., FQ_OFF:FK_OFF].reshape(B, L, N_FOX_HEADS, HEAD_DIM)
        fk = proj[..., FK_OFF:FV_OFF].reshape(B, L, N_FOX_HEADS, HEAD_DIM)
        fv = proj[..., FV_OFF:FF_OFF].reshape(B, L, N_FOX_HEADS, HEAD_DIM)
        log_f = jax.nn.log_sigmoid(proj[..., FF_OFF:].astype(jnp.float32)
                                   + b_forget[li].astype(jnp.float32))
        fox_out = _forgetting_attention(fq, fk, fv, log_f)
        mix = jnp.einsum('ble,ed->bld', jnp.concatenate([diff_out, fox_out], axis=-1), w_out[li])
        h = _layer_norm(DEEPNORM_ALPHA * h + mix, ln_attn_g[li], ln_attn_b[li])
        up = jnp.einsum('bld,df->blf', h, w_up[li])
        ff = jnp.einsum('blf,fd->bld', jnp.square(jax.nn.relu(up)), w_down[li])
        h = _layer_norm(DEEPNORM_ALPHA * h + ff, ln_mlp_g[li], ln_mlp_b[li])

    return h[:, N_META:, :]
```

```cpp
#include <hip/hip_runtime.h>
#include <hip/hip_bf16.h>
#include <cstdio>
#include <cstdint>
#include <cmath>
#ifndef MK_FUSED
#define MK_FUSED 0
#endif
namespace pg8 {
#define PG8_LAS __attribute__((address_space(3)))
typedef unsigned short bf16_t;
typedef short bf16x8 __attribute__((ext_vector_type(8)));
typedef float f32x4 __attribute__((ext_vector_type(4)));
typedef unsigned u32x4 __attribute__((ext_vector_type(4)));
constexpr int BM = 256, BK = 64, HALF = 128, HTB = HALF * BK * 2  , STAGE_BYTES = 8 * HTB, NXCD = 8, WGM = 8;

__host__ __device__ __forceinline__ int lds_byte(int r, int c) { const int st = (r >> 4) * 2 + (c >> 5), rr = r & 15, cc = c & 31, ob = rr * 64 + cc * 2; return st * 1024 + (ob ^ (((ob >> 9) & 1) << 5)); }
__host__ __device__ __forceinline__ void stage_rc(int b, int& R, int& C) { const int st = b / 1024, sb = b % 1024, swz = sb ^ (((sb >> 9) & 1) << 5); R = (st >> 1) * 16 + swz / 64; C = (st & 1) * 32 + (swz % 64) / 2; }
__host__ __device__ __forceinline__ int perm32(int rho) { const int n = rho >> 4, i = rho & 15; return 8 * (i >> 2) + 4 * n + (i & 3); }

struct Unit { int pm, pn; };
struct Gemm { const bf16_t* A; const bf16_t* Bt; int M, N, K; };

struct StaticOrder {
    int nM, nN, nwg, G, c;
    __host__ __device__ void init(int M, int N, int G_, int c_) { nM = M / BM; nN = N / BM; nwg = nM * nN; G = G_; c = c_; }
    __host__ __device__ bool next(int i, Unit& u) const {
        const long L = (long)i * G + c; if (L >= nwg) return false;
        int wgid = (int)L; { const int q = nwg / NXCD, r = nwg % NXCD, xcd = wgid % NXCD, off = wgid / NXCD; wgid = (xcd < r ? xcd * (q + 1) : r * (q + 1) + (xcd - r) * q) + off; }
        const int nig = WGM * nN, gid = wgid / nig, fm = gid * WGM, gsz = (nM - fm) < WGM ? (nM - fm) : WGM;
        u.pm = fm + ((wgid % nig) % gsz); u.pn = (wgid % nig) / gsz; return true;
    }
    __device__ __forceinline__ void a_ready(const Unit&) const {}
    __device__ __forceinline__ void done(const Unit&) const {}
};

__device__ __forceinline__ unsigned cvt_pk_bf16(float lo, float hi) { unsigned r; asm volatile("v_cvt_pk_bf16_f32 %0, %1, %2" : "=v"(r) : "v"(lo), "v"(hi)); return r; }
__device__ __forceinline__ u32x4 pack8bf(const f32x4 v0, const f32x4 v1) { u32x4 w; w.x = cvt_pk_bf16(v0[0], v0[1]); w.y = cvt_pk_bf16(v0[2], v0[3]); w.z = cvt_pk_bf16(v1[0], v1[1]); w.w = cvt_pk_bf16(v1[2], v1[3]); return w; }

struct EpiProj {
    static constexpr bool PERM = true, AFTER_DRAIN = false;
    bf16_t* QKV; const float* ropeC; const float* ropeS; int kvr, nb;
    __device__ __forceinline__ void operator()(const f32x4 (&acc)[2][2][4][2], const Unit& u, int wr, int wc, int fr, int fq) const {
        const int m0 = u.pm * BM, b = m0 >> 13, t0 = (m0 & 8191) + wr * 64 + fr;
        if (u.pn < 16) {
            const int hh = wc >> 1, dl0 = 32 * (wc & 1) + 8 * fq, g = 2 * u.pn + hh;
            bf16_t* base = QKV + ((size_t)(g * nb + b) * kvr + 64) * 128 + dl0;
#pragma unroll
            for (int ai = 0; ai < 2; ++ai)
#pragma unroll
                for (int m = 0; m < 4; ++m) { const int t = t0 + ai * HALF + m * 16; const float* cp = ropeC + (size_t)(16 + t) * 64 + dl0; const float* sp = ropeS + (size_t)(16 + t) * 64 + dl0;
                    const f32x4 c0 = *(const f32x4*)cp, c1 = *(const f32x4*)(cp + 4), s0 = *(const f32x4*)sp, s1 = *(const f32x4*)(sp + 4);
                    const f32x4 x1a = acc[ai][0][m][0], x1b = acc[ai][0][m][1], x2a = acc[ai][1][m][0], x2b = acc[ai][1][m][1];
                    const f32x4 o1a = x1a * c0 - x2a * s0, o1b = x1b * c1 - x2b * s1, o2a = x2a * c0 + x1a * s0, o2b = x2b * c1 + x1b * s1;
                    bf16_t* rowp = base + (size_t)t * 128;
                    *(u32x4*)rowp = pack8bf(o1a, o1b); *(u32x4*)(rowp + 64) = pack8bf(o2a, o2b); }
        } else {
#pragma unroll
            for (int bj = 0; bj < 2; ++bj) { const int g = 2 * u.pn + bj; bf16_t* base = QKV + ((size_t)(g * nb + b) * kvr + 64) * 128 + 32 * wc + 8 * fq;
#pragma unroll
                for (int ai = 0; ai < 2; ++ai)
#pragma unroll
                    for (int m = 0; m < 4; ++m) { const int t = t0 + ai * HALF + m * 16; *(u32x4*)(base + (size_t)t * 128) = pack8bf(acc[ai][bj][m][0], acc[ai][bj][m][1]); } }
        }
    }
};
struct EpiOut {
    static constexpr bool PERM = false, AFTER_DRAIN = false;
    const float* X; const float* stats; const float* g; const float* bta; float* Y; int ldc; float alpha;
    __device__ __forceinline__ void operator()(const f32x4 (&acc)[2][2][4][2], const Unit& u, int wr, int wc, int fr, int fq) const {
        const int row0 = u.pm * BM + wr * 64 + fr, col0 = u.pn * BM + wc * 32 + 4 * fq;
        f32x4 gv[2][2], bv[2][2];
#pragma unroll
        for (int bj = 0; bj < 2; ++bj)
#pragma unroll
            for (int n = 0; n < 2; ++n) { gv[bj][n] = *(const f32x4*)(g + col0 + bj * HALF + n * 16); bv[bj][n] = *(const f32x4*)(bta + col0 + bj * HALF + n * 16); }
#pragma unroll
        for (int ai = 0; ai < 2; ++ai)
#pragma unroll
            for (int m = 0; m < 4; ++m) { const int r = row0 + ai * HALF + m * 16; const float mu = stats[2 * r], rs = stats[2 * r + 1] * alpha; const size_t off = (size_t)r * ldc + col0;
#pragma unroll
                for (int bj = 0; bj < 2; ++bj)
#pragma unroll
                    for (int n = 0; n < 2; ++n) { const f32x4 xv = *(const f32x4*)(X + off + bj * HALF + n * 16);
                        *(f32x4*)(Y + off + bj * HALF + n * 16) = (xv - mu) * rs * gv[bj][n] + bv[bj][n] * alpha + acc[ai][bj][m][n]; }
                if (m & 1) asm volatile("" ::: "memory"); }
    }
};
struct EpiUp {
    static constexpr bool PERM = true, AFTER_DRAIN = false;
    bf16_t* O; int ldc;
    __device__ __forceinline__ void operator()(const f32x4 (&acc)[2][2][4][2], const Unit& u, int wr, int wc, int fr, int fq) const {
        const int row0 = u.pm * BM + wr * 64 + fr, col0 = u.pn * BM + wc * 32 + 8 * fq;
#pragma unroll
        for (int ai = 0; ai < 2; ++ai)
#pragma unroll
            for (int m = 0; m < 4; ++m) { bf16_t* rowp = O + (size_t)(row0 + ai * HALF + m * 16) * ldc + col0;
#pragma unroll
                for (int bj = 0; bj < 2; ++bj) { f32x4 v0 = acc[ai][bj][m][0], v1 = acc[ai][bj][m][1];
#pragma unroll
                    for (int e = 0; e < 4; ++e) { const float a = fmaxf(v0[e], 0.f), c = fmaxf(v1[e], 0.f); v0[e] = a * a; v1[e] = c * c; }
                    *(u32x4*)(rowp + bj * HALF) = pack8bf(v0, v1); } }
    }
};
struct EpiDown {
    static constexpr bool PERM = false, AFTER_DRAIN = false;
    float* Y; const float* stats; const float* g; const float* bta; int ldc; float alpha;
    __device__ __forceinline__ void operator()(const f32x4 (&acc)[2][2][4][2], const Unit& u, int wr, int wc, int fr, int fq) const {
        const int row0 = u.pm * BM + wr * 64 + fr, col0 = u.pn * BM + wc * 32 + 4 * fq;
        f32x4 gv[2][2], bv[2][2];
#pragma unroll
        for (int bj = 0; bj < 2; ++bj)
#pragma unroll
            for (int n = 0; n < 2; ++n) { gv[bj][n] = *(const f32x4*)(g + col0 + bj * HALF + n * 16); bv[bj][n] = *(const f32x4*)(bta + col0 + bj * HALF + n * 16); }
#pragma unroll
        for (int ai = 0; ai < 2; ++ai)
#pragma unroll
            for (int m = 0; m < 4; ++m) { const int r = row0 + ai * HALF + m * 16; const float mu = stats[2 * r], rs = stats[2 * r + 1] * alpha; const size_t off = (size_t)r * ldc + col0;
#pragma unroll
                for (int bj = 0; bj < 2; ++bj)
#pragma unroll
                    for (int n = 0; n < 2; ++n) { float* p = Y + off + bj * HALF + n * 16; const f32x4 yv = *(const f32x4*)p;
                        *(f32x4*)p = (yv - mu) * rs * gv[bj][n] + bv[bj][n] * alpha + acc[ai][bj][m][n]; }
                if (m & 1) asm volatile("" ::: "memory"); }
    }
};

template <class Epi, class Sched, bool ALIGN_EPI = false, bool SP2 = false>
__device__ __forceinline__ void gemm_phase(PG8_LAS unsigned char* lds, const Gemm g, const Sched& S, const Epi& E) {
    const int tid = threadIdx.x, wid = __builtin_amdgcn_readfirstlane(tid >> 6), lane = tid & 63, wr = wid >> 2, wc = wid & 3, fr = lane & 15, fq = lane >> 4;
    const int K = g.K, nt = K / BK;
    unsigned voffA[2], voffB[2];
#pragma unroll
    for (int i = 0; i < 2; ++i) { int R, C; stage_rc(tid * 16 + i * 8192, R, C); const int Rb = Epi::PERM ? ((R & ~31) + perm32(R & 31)) : R;
        voffA[i] = (unsigned)(R * K + C) * 2u; voffB[i] = (unsigned)(Rb * K + C) * 2u; }
    const size_t kstep = (size_t)(BK * 2);
    const size_t hstep = (size_t)HALF * K * 2;
    const size_t tstep = 2 * hstep;
    const unsigned ldsw = (unsigned)wid * 1024u;
    const int aoff = lds_byte(wr * 64 + fr, fq * 8), boff = lds_byte(wc * 32 + fr, fq * 8);
#define PG8_SA(b, h) (((b) * 2 + (h)) * HTB)
#define PG8_SB(b, h) ((4 + (b) * 2 + (h)) * HTB)
#define PG8_STAGE(bufoff, gbase, voff) do { _Pragma("unroll") for (int _i = 0; _i < 2; ++_i) \
        __builtin_amdgcn_global_load_lds((const unsigned*)((const char*)(gbase) + (voff)[_i]), (PG8_LAS unsigned*)(lds + (bufoff) + ldsw + _i * 8192), 16, 0, 0); } while (0)
#define PG8_LDA(dst, b, h) do { _Pragma("unroll") for (int m = 0; m < 4; ++m) _Pragma("unroll") for (int k = 0; k < 2; ++k) dst[m][k] = *(const PG8_LAS bf16x8*)(lds + PG8_SA(b, h) + aoff + m * 2048 + k * 1024); } while (0)
#define PG8_LDB(dst, b, h) do { _Pragma("unroll") for (int n = 0; n < 2; ++n) _Pragma("unroll") for (int k = 0; k < 2; ++k) dst[n][k] = *(const PG8_LAS bf16x8*)(lds + PG8_SB(b, h) + boff + n * 2048 + k * 1024); } while (0)
#define PG8_MMA(ai, bj, At, Bt) do { __builtin_amdgcn_s_setprio(1); _Pragma("unroll") for (int m = 0; m < 4; ++m) _Pragma("unroll") for (int n = 0; n < 2; ++n) _Pragma("unroll") for (int k = 0; k < 2; ++k) \
        acc[ai][bj][m][n] = __builtin_amdgcn_mfma_f32_16x16x32_bf16(Bt[n][k], At[m][k], acc[ai][bj][m][n], 0, 0, 0); __builtin_amdgcn_s_setprio(0); } while (0)
#define PG8_WAIT_V(n) asm volatile("s_waitcnt vmcnt(" #n ")" ::: "memory")
#define PG8_WAIT_L(n) asm volatile("s_waitcnt lgkmcnt(" #n ")" ::: "memory")
#define PG8_BAR __builtin_amdgcn_s_barrier()
#define PG8_SCHED __builtin_amdgcn_sched_barrier(0)
    Unit cur, nxt; int ui = 0;
    if (!S.next(0, cur)) return;
    f32x4 acc[2][2][4][2];
#pragma unroll
    for (int a = 0; a < 2; ++a)
#pragma unroll
        for (int b = 0; b < 2; ++b)
#pragma unroll
            for (int m = 0; m < 4; ++m)
#pragma unroll
                for (int n = 0; n < 2; ++n) acc[a][b][m][n] = (f32x4){0.f, 0.f, 0.f, 0.f};
    bf16x8 At[4][2], B0[2][2], B1[2][2];
    const char* cA = (const char*)g.A + (size_t)cur.pm * tstep; const char* cB = (const char*)g.Bt + (size_t)cur.pn * tstep;
    S.a_ready(cur);
    if constexpr (SP2) {
        PG8_STAGE(PG8_SB(0, 0), cB, voffB); PG8_STAGE(PG8_SB(0, 1), cB + hstep, voffB); PG8_STAGE(PG8_SA(0, 0), cA, voffA); PG8_STAGE(PG8_SA(0, 1), cA + hstep, voffA);
        if (wr == 1) PG8_BAR;
        PG8_WAIT_V(2); PG8_BAR;
        PG8_STAGE(PG8_SB(1, 0), cB + kstep, voffB); PG8_STAGE(PG8_SA(1, 0), cA + kstep, voffA); PG8_STAGE(PG8_SB(1, 1), cB + hstep + kstep, voffB);
        PG8_WAIT_V(6); PG8_BAR;
    } else {
        PG8_STAGE(PG8_SB(0, 0), cB, voffB); PG8_STAGE(PG8_SA(0, 0), cA, voffA); PG8_STAGE(PG8_SB(0, 1), cB + hstep, voffB); PG8_STAGE(PG8_SA(0, 1), cA + hstep, voffA);
        if (wr == 1) PG8_BAR;
        PG8_WAIT_V(4); PG8_BAR;
        PG8_STAGE(PG8_SB(1, 0), cB + kstep, voffB); PG8_STAGE(PG8_SA(1, 0), cA + kstep, voffA); PG8_STAGE(PG8_SB(1, 1), cB + hstep + kstep, voffB);
        PG8_WAIT_V(6); PG8_BAR;
    }
    for (;;) {
        const bool has_next = S.next(ui + 1, nxt);
        const char* nA = has_next ? (const char*)g.A + (size_t)nxt.pm * tstep : cA; const char* nB = has_next ? (const char*)g.Bt + (size_t)nxt.pn * tstep : cB;
        for (int t = 0; t < nt; t += 2) {
            const bool last = (t == nt - 2);
            const char* a1 = cA + (size_t)(t + 1) * kstep;
            const char* a2 = last ? nA : cA + (size_t)(t + 2) * kstep; const char* b2 = last ? nB : cB + (size_t)(t + 2) * kstep;
            const char* a3 = a2 + kstep; const char* b3 = b2 + kstep;
            if (last && has_next) S.a_ready(nxt);
            if constexpr (SP2) {
            PG8_LDB(B0, 0, 0); PG8_LDB(B1, 0, 1); PG8_SCHED; PG8_LDA(At, 0, 0); PG8_STAGE(PG8_SA(1, 1), a1 + hstep, voffA);
            PG8_WAIT_V(8); PG8_WAIT_L(0); PG8_BAR; PG8_MMA(0, 0, At, B0); PG8_MMA(0, 1, At, B1); PG8_BAR; PG8_SCHED;
            PG8_LDA(At, 0, 1); PG8_STAGE(PG8_SB(0, 0), b2, voffB); PG8_STAGE(PG8_SB(0, 1), b2 + hstep, voffB); PG8_STAGE(PG8_SA(0, 0), a2, voffA);
            PG8_WAIT_V(8); PG8_WAIT_L(0); PG8_BAR; PG8_MMA(1, 0, At, B0); PG8_MMA(1, 1, At, B1); PG8_BAR; PG8_SCHED;
            PG8_LDB(B0, 1, 0); PG8_LDB(B1, 1, 1); PG8_SCHED; PG8_LDA(At, 1, 0); PG8_STAGE(PG8_SA(0, 1), a2 + hstep, voffA);
            PG8_WAIT_V(8); PG8_WAIT_L(0); PG8_BAR; PG8_MMA(0, 0, At, B0); PG8_MMA(0, 1, At, B1); PG8_BAR; PG8_SCHED;
            PG8_LDA(At, 1, 1); PG8_STAGE(PG8_SB(1, 0), b3, voffB); PG8_STAGE(PG8_SB(1, 1), b3 + hstep, voffB); PG8_STAGE(PG8_SA(1, 0), a3, voffA);
            PG8_WAIT_V(8); PG8_WAIT_L(0); PG8_BAR; PG8_MMA(1, 0, At, B0); PG8_MMA(1, 1, At, B1); PG8_BAR; PG8_SCHED;
            } else {
            PG8_LDB(B0, 0, 0); PG8_SCHED; PG8_LDA(At, 0, 0); PG8_STAGE(PG8_SA(1, 1), a1 + hstep, voffA);
            PG8_WAIT_L(8); PG8_BAR; PG8_WAIT_L(0); PG8_MMA(0, 0, At, B0); PG8_BAR; PG8_SCHED;
            PG8_LDB(B1, 0, 1); PG8_STAGE(PG8_SB(0, 0), b2, voffB);
            PG8_BAR; PG8_WAIT_L(0); PG8_MMA(0, 1, At, B1); PG8_BAR;
            PG8_LDA(At, 0, 1); PG8_STAGE(PG8_SA(0, 0), a2, voffA);
            PG8_BAR; PG8_WAIT_L(0); PG8_MMA(1, 0, At, B0); PG8_BAR; PG8_SCHED;
            PG8_STAGE(PG8_SB(0, 1), b2 + hstep, voffB);
            PG8_WAIT_V(6); PG8_BAR; PG8_MMA(1, 1, At, B1); PG8_BAR;
            PG8_LDB(B0, 1, 0); PG8_SCHED; PG8_LDA(At, 1, 0); PG8_STAGE(PG8_SA(0, 1), a2 + hstep, voffA);
            PG8_WAIT_L(8); PG8_BAR; PG8_WAIT_L(0); PG8_MMA(0, 0, At, B0); PG8_BAR; PG8_SCHED;
            PG8_LDB(B1, 1, 1); PG8_STAGE(PG8_SB(1, 0), b3, voffB);
            PG8_BAR; PG8_WAIT_L(0); PG8_MMA(0, 1, At, B1); PG8_BAR;
            PG8_LDA(At, 1, 1); PG8_STAGE(PG8_SA(1, 0), a3, voffA);
            PG8_BAR; PG8_WAIT_L(0); PG8_MMA(1, 0, At, B0); PG8_BAR; PG8_SCHED;
            PG8_STAGE(PG8_SB(1, 1), b3 + hstep, voffB);
            PG8_WAIT_V(6); PG8_BAR; PG8_MMA(1, 1, At, B1); PG8_BAR;
            }
        }
        if constexpr (ALIGN_EPI) { if (wr == 0) PG8_BAR; }
        if constexpr (!Epi::AFTER_DRAIN) { E(acc, cur, wr, wc, fr, fq); S.done(cur); }
        if (!has_next) break;
#pragma unroll
        for (int a = 0; a < 2; ++a)
#pragma unroll
            for (int b = 0; b < 2; ++b)
#pragma unroll
                for (int m = 0; m < 4; ++m)
#pragma unroll
                    for (int n = 0; n < 2; ++n) acc[a][b][m][n] = (f32x4){0.f, 0.f, 0.f, 0.f};
        cur = nxt; cA = nA; cB = nB; ++ui;
        if constexpr (ALIGN_EPI) { if (wr == 1) PG8_BAR; }
    }
    PG8_WAIT_V(0);
    if constexpr (!ALIGN_EPI) { if (wr == 0) PG8_BAR; }
    PG8_BAR;
    if constexpr (Epi::AFTER_DRAIN) { E.fused(acc, cur, wr, wc, fr, fq, lds, wid, lane); S.done(cur); }
#undef PG8_SA
#undef PG8_SB
#undef PG8_STAGE
#undef PG8_LDA
#undef PG8_LDB
#undef PG8_MMA
#undef PG8_WAIT_V
#undef PG8_WAIT_L
#undef PG8_BAR
#undef PG8_SCHED
}
}

#ifndef PG8_SP2
#define PG8_SP2 true
#endif
#ifndef PG8_ALIGN
#define PG8_ALIGN true
#endif
#include <hip/hip_bf16.h>
namespace att {
__device__ __forceinline__ int fresh_tid() { int t = threadIdx.x; asm volatile("" : "+v"(t)); return t; }
constexpr int D = 128;
constexpr float THR = 8.f;
constexpr bool WSKIP = false;
constexpr float SCALE = 0.08838834764831845f;
constexpr float RSCALE = 11.313708498984761f;
constexpr int NW = 8, QBLK = 32, KVBLK = 64, QB = NW * QBLK;
constexpr int SHM_V = KVBLK * D * 2, SHM_K = KVBLK * D * 2;
constexpr int LDS_BIAS = 2 * SHM_V + 2 * SHM_K + NW * 64 * 4;
constexpr int LDS_BYTES = LDS_BIAS + 2 * 64 * 4;

using bf16 = __hip_bfloat16;
typedef short bf16x8 __attribute__((ext_vector_type(8)));
typedef short s16x4 __attribute__((ext_vector_type(4)));
typedef float f32x16 __attribute__((ext_vector_type(16)));
typedef float f32x4 __attribute__((ext_vector_type(4)));
typedef unsigned u32x4 __attribute__((ext_vector_type(4)));
template <class A, class Bt> struct same_t { static constexpr bool v = false; };
template <class A> struct same_t<A, A> { static constexpr bool v = true; };

#define KSWZ(row, colB) ((row) * 256 + ((colB) ^ (((row) & 7) << 4)))
#define SBAR() __builtin_amdgcn_sched_barrier(0)
__device__ __forceinline__ int v_st(int k, int c) { const int kk = (k & ~0xC) | ((k & 4) << 1) | ((k & 8) >> 1); return ((kk >> 3) * 4 + (c >> 5)) * 512 + ((kk & 7) * 32 + (c & 31)) * 2; }
__device__ __forceinline__ int v_rd_base(int lane) { return ((lane & 3) << 3) | (((lane >> 2) & 3) << 6) | (((lane >> 4) & 1) << 5) | (((lane >> 5) & 1) << 8); }
constexpr int v_rd_off(int d0, int ks, int half) { return d0 * 512 + ks * 4096 + half * 2048; }
__device__ __forceinline__ int crow(int r, int hi) { return (r & 3) + 8 * (r >> 2) + 4 * hi; }
__device__ __forceinline__ unsigned cvtpk(float lo, float hi) {
    unsigned r; asm volatile("v_cvt_pk_bf16_f32 %0, %1, %2" : "=v"(r) : "v"(lo), "v"(hi)); return r;
}
__device__ __forceinline__ bf16x8 pack8(f32x4 a, f32x4 b) {
    u32x4 w = {cvtpk(a[0], a[1]), cvtpk(a[2], a[3]), cvtpk(b[0], b[1]), cvtpk(b[2], b[3])};
    return *reinterpret_cast<bf16x8*>(&w);
}
template <class T> __device__ __forceinline__ bf16x8 load8(const T* p) {
    if constexpr (same_t<T, float>::v) { return pack8(*(const f32x4*)p, *(const f32x4*)(p + 4)); }
    else { return *reinterpret_cast<const bf16x8*>(p); }
}
__device__ __forceinline__ void mask_tile(f32x16& p0, f32x16& p1, int dq, unsigned W) {
    const float NEG = -__builtin_inff();
#pragma unroll
    for (int r = 0; r < 16; ++r) {
        const int c = (r & 3) + 8 * (r >> 2);
        if ((unsigned)(dq - c) >= W) p0[r] = NEG;
        if ((unsigned)(dq - c - 32) >= W) p1[r] = NEG;
    }
}
__device__ __forceinline__ void partialSM(f32x16& p0, f32x16& p1, float& m_reg, float& mn, float& alpha) {
    float pmax = p0[0]; for (int r = 1; r < 16; ++r) pmax = fmaxf(pmax, p0[r]); for (int r = 0; r < 16; ++r) pmax = fmaxf(pmax, p1[r]);
    { auto rr = __builtin_amdgcn_permlane32_swap(__float_as_uint(pmax), __float_as_uint(pmax), false, false);
      pmax = fmaxf(__uint_as_float(rr[0]), __uint_as_float(rr[1])); }
    constexpr float C2 = 1.4426950408889634f * SCALE;
    if (__builtin_expect(__all((pmax - m_reg) * SCALE <= THR), 1)) { mn = m_reg; alpha = 1.f; }
    else { mn = fmaxf(m_reg, pmax); alpha = __builtin_amdgcn_exp2f((m_reg - mn) * C2); m_reg = mn; }
    const float mnL = -mn * C2;
    for (int r = 0; r < 16; ++r) p0[r] = fmaf(p0[r], C2, mnL); for (int r = 0; r < 16; ++r) p1[r] = fmaf(p1[r], C2, mnL);
    for (int r = 0; r < 16; ++r) p0[r] = __builtin_amdgcn_exp2f(p0[r]);
}
__device__ __forceinline__ void finishSM(f32x16& p0, f32x16& p1, float alpha, float& l_reg, bf16x8& pa0, bf16x8& pa1, bf16x8& pa2, bf16x8& pa3) {
    for (int r = 0; r < 16; ++r) p1[r] = __builtin_amdgcn_exp2f(p1[r]);
    float ps = 0; for (int r = 0; r < 16; ++r) ps += p0[r]; for (int r = 0; r < 16; ++r) ps += p1[r];
    { auto rr = __builtin_amdgcn_permlane32_swap(__float_as_uint(ps), __float_as_uint(ps), false, false);
      ps = __uint_as_float(rr[0]) + __uint_as_float(rr[1]); }
    l_reg = l_reg * alpha + ps;
#define PK4(P, B_, OUT) do { unsigned a0 = cvtpk(P[B_+0], P[B_+1]), a1 = cvtpk(P[B_+2], P[B_+3]);                          \
        unsigned b0 = cvtpk(P[B_+4], P[B_+5]), b1 = cvtpk(P[B_+6], P[B_+7]);                                             \
        auto r0 = __builtin_amdgcn_permlane32_swap(a0, b0, false, false); auto r1 = __builtin_amdgcn_permlane32_swap(a1, b1, false, false); \
        u32x4 w = {r0[0], r1[0], r0[1], r1[1]}; OUT = *reinterpret_cast<bf16x8*>(&w); } while (0)
    PK4(p0, 0, pa0); PK4(p0, 8, pa1); PK4(p1, 0, pa2); PK4(p1, 8, pa3);
#undef PK4
}
template <int KB, bool SK>
__device__ __forceinline__ void qkt(f32x16& p0, f32x16& p1, const char* K_lds, int r32, int hi, const bf16x8* qr, bool act) {
    if (SK && !act) { const float NEG = -__builtin_inff();
#pragma unroll
        for (int r = 0; r < 16; ++r) { p0[r] = NEG; p1[r] = NEG; } return; }
    p0 = f32x16{}; p1 = f32x16{};
    const char* kb[4];
#pragma unroll
    for (int dd = 0; dd < 4; ++dd) kb[dd] = K_lds + KB * SHM_K + KSWZ(r32, (dd * 16 + hi * 8) * 2);
#pragma unroll
    for (int d0 = 0; d0 < 8; ++d0) { const char* a = kb[d0 & 3] + (d0 >> 2) * 128;
        bf16x8 b0 = *reinterpret_cast<const bf16x8*>(a);
        bf16x8 b1 = *reinterpret_cast<const bf16x8*>(a + 32 * 256);
        p0 = __builtin_amdgcn_mfma_f32_32x32x16_bf16(b0, qr[d0], p0, 0, 0, 0);
        p1 = __builtin_amdgcn_mfma_f32_32x32x16_bf16(b1, qr[d0], p1, 0, 0, 0); }
}
template <int VB, bool SK>
__device__ __forceinline__ void pv_tile(f32x16* o, int vb0, bf16x8 pa0, bf16x8 pa1, bf16x8 pa2, bf16x8 pa3, bool act) {
    if (SK && !act) return;
#define TRRD(dst, off) asm volatile("ds_read_b64_tr_b16 %0, %1 offset:%2" : "=&v"(dst) : "v"(vb0), "i"(off) : "memory")
#define PV_D0(d0) do { s16x4 l0, l1, l2, l3, h0, h1, h2, h3; constexpr int b_ = VB * SHM_V + v_rd_off(d0, 0, 0);     \
        TRRD(l0, b_); TRRD(h0, b_ + 2048); TRRD(l1, b_ + 4096); TRRD(h1, b_ + 6144); TRRD(l2, b_ + 8192); TRRD(h2, b_ + 10240); TRRD(l3, b_ + 12288); TRRD(h3, b_ + 14336); \
        asm volatile("s_waitcnt lgkmcnt(0)" ::: "memory"); SBAR();                 \
        o[d0] = __builtin_amdgcn_mfma_f32_32x32x16_bf16(pa0, (bf16x8){l0[0], l0[1], l0[2], l0[3], h0[0], h0[1], h0[2], h0[3]}, o[d0], 0, 0, 0);   \
        o[d0] = __builtin_amdgcn_mfma_f32_32x32x16_bf16(pa1, (bf16x8){l1[0], l1[1], l1[2], l1[3], h1[0], h1[1], h1[2], h1[3]}, o[d0], 0, 0, 0);   \
        o[d0] = __builtin_amdgcn_mfma_f32_32x32x16_bf16(pa2, (bf16x8){l2[0], l2[1], l2[2], l2[3], h2[0], h2[1], h2[2], h2[3]}, o[d0], 0, 0, 0);   \
        o[d0] = __builtin_amdgcn_mfma_f32_32x32x16_bf16(pa3, (bf16x8){l3[0], l3[1], l3[2], l3[3], h3[0], h3[1], h3[2], h3[3]}, o[d0], 0, 0, 0); } while (0)
    PV_D0(0); PV_D0(1); PV_D0(2); PV_D0(3);
#undef PV_D0
#undef TRRD
}

template <class TIn, class TOut> struct BlockRef { const TIn* Q; const TIn* K; const TIn* V; TOut* O; int P0; int ldo; const float* cb; };
template <class TIn> struct Seam {
    bf16x8 qr[8];
    bf16x8 st_v0, st_v1, st_k0, st_k1; f32x4 sf0, sf1, sf2, sf3;
    f32x4 tq[16];
    float st_b;
};
__device__ __forceinline__ int swa_jlo(int P0, int W) { const int lowk = P0 - W + 1; return lowk > 0 ? lowk / KVBLK : 0; }
#define ROW(p, k0, rr) ((p) + (size_t)((k0) + (rr)) * D + sc)
#define VMW() asm volatile("s_waitcnt vmcnt(0)" ::: "memory")
#define VMWN(n) asm volatile("s_waitcnt vmcnt(%0)" :: "i"(n) : "memory")
#define SLOAD_H(Kp, Vp, Cp, k0) do { S.st_v0 = load8<TIn>(ROW(Vp, k0, sr)); S.st_v1 = load8<TIn>(ROW(Vp, k0, 32 + sr));              \
                         S.st_k0 = load8<TIn>(ROW(Kp, k0, sr)); S.st_k1 = load8<TIn>(ROW(Kp, k0, 32 + sr));                       \
                         if constexpr (MODE == 1) { if (tid < 64) S.st_b = (Cp)[(k0) + tid]; } } while (0)
#define SWRITE_HK(bf, cref) do { *(bf16x8*)(K_lds + (bf) * SHM_K + kws) = S.st_k0; *(bf16x8*)(K_lds + (bf) * SHM_K + kws + 32 * 256) = S.st_k1; \
                         if constexpr (MODE == 1) { if (tid < 64) bias_l[(bf) * 64 + tid] = ((cref) - S.st_b) * RSCALE; } } while (0)
#define SWRITE_HV(bf) do { *(bf16x8*)(V_lds + (bf) * SHM_V + vst0) = S.st_v0; *(bf16x8*)(V_lds + (bf) * SHM_V + vst1) = S.st_v1; } while (0)
#define SWRITE_H(bf, cref) do { SWRITE_HV(bf); SWRITE_HK(bf, cref); } while (0)
#define BIASADD(P0_, P1_, kb) do { if constexpr (MODE == 1) { const float* bp_ = bias_l + (kb) * 64 + 4 * hi;                    \
        _Pragma("unroll") for (int g_ = 0; g_ < 4; ++g_) { const f32x4 b0_ = *(const f32x4*)(bp_ + 8 * g_), b1_ = *(const f32x4*)(bp_ + 32 + 8 * g_); \
            _Pragma("unroll") for (int e_ = 0; e_ < 4; ++e_) { P0_[4 * g_ + e_] += b0_[e_]; P1_[4 * g_ + e_] += b1_[e_]; } } } } while (0)
#define PADMASK(P0_, P1_) do { const float NEG_ = -__builtin_inff(); _Pragma("unroll") for (int r_ = 0; r_ < 16; ++r_) { if (r_ >= 8) P0_[r_] = NEG_; P1_[r_] = NEG_; } } while (0)
#define SLOAD_F(p, k0) do { S.sf0 = *(const f32x4*)ROW(p, k0, sr); S.sf1 = *(const f32x4*)(ROW(p, k0, sr) + 4);                \
                            S.sf2 = *(const f32x4*)ROW(p, k0, 32 + sr); S.sf3 = *(const f32x4*)(ROW(p, k0, 32 + sr) + 4); } while (0)
#define SWRITE_KF(bf) do { *(bf16x8*)(K_lds + (bf) * SHM_K + kws) = pack8(S.sf0, S.sf1); *(bf16x8*)(K_lds + (bf) * SHM_K + kws + 32 * 256) = pack8(S.sf2, S.sf3); } while (0)
#define SWRITE_VF(bf) do { *(bf16x8*)(V_lds + (bf) * SHM_V + vst0) = pack8(S.sf0, S.sf1); *(bf16x8*)(V_lds + (bf) * SHM_V + vst1) = pack8(S.sf2, S.sf3); } while (0)
template <class TIn, class TOut, int MODE  >
__device__ __forceinline__ void causal_swa_prime(const BlockRef<TIn, TOut>& cur, int W, char* lds, Seam<TIn>& S) {
    constexpr bool F32 = same_t<TIn, float>::v;
    const int tid = fresh_tid(), wid = __builtin_amdgcn_readfirstlane(tid >> 6), lane = tid & 63, r32 = lane & 31, hi = lane >> 5;
    const int sr = tid >> 4, sc = (tid & 15) * 8, kws = KSWZ(sr, sc * 2); char* K_lds = lds + 2 * SHM_V; float* bias_l = (float*)(lds + LDS_BIAS);
    float cref_cur = 0.f; if constexpr (MODE == 1) cref_cur = cur.cb[cur.P0];
    const int kb0 = swa_jlo(cur.P0, W) * KVBLK;
    for (int d0 = 0; d0 < 8; ++d0) S.qr[d0] = load8<TIn>(cur.Q + (size_t)(wid * QBLK + r32) * D + d0 * 16 + hi * 8);
    if constexpr (F32) { SLOAD_F((const float*)cur.K, kb0); VMW(); SWRITE_KF(0); SBAR(); SLOAD_F((const float*)cur.V, kb0); }
    else { SLOAD_H(cur.K, cur.V, cur.cb, kb0); VMW(); SWRITE_HK(0, cref_cur); }
    __syncthreads();
}
template <class TIn, class TOut, int MODE>
__device__ __forceinline__ void causal_swa_block(const BlockRef<TIn, TOut>& cur, const BlockRef<TIn, TOut>& nxt, int skv, int W, char* lds, Seam<TIn>& S) {
    constexpr bool F32 = same_t<TIn, float>::v;
    const int tid = fresh_tid(), wid = __builtin_amdgcn_readfirstlane(tid >> 6), lane = tid & 63, r32 = lane & 31, hi = lane >> 5;
    const int j_lo = swa_jlo(cur.P0, W);
    int j_hi = (cur.P0 + QB - 1) / KVBLK + 1; if (j_hi > skv / KVBLK) j_hi = skv / KVBLK;
    const int NT = j_hi - j_lo;
    const int kbn = swa_jlo(nxt.P0, W) * KVBLK;
    const int qlo_r = cur.P0 + wid * QBLK, qlo = (MODE == 0) ? (qlo_r | 63) : qlo_r, qm = (MODE == 0) ? (qlo - 4 * hi) : (qlo_r + r32 - 4 * hi);
    char* V_lds = lds; char* K_lds = lds + 2 * SHM_V; float* bias_l = (float*)(lds + LDS_BIAS);
    float cref_cur = 0.f, cref_nxt = 0.f; if constexpr (MODE == 1) { cref_cur = cur.cb[cur.P0]; cref_nxt = nxt.cb[nxt.P0]; }
    const float* Ch = cur.cb;
    float* ws = (float*)(lds + 2 * SHM_V + 2 * SHM_K) + wid * 64; float* li_l = ws, * al_l = ws + 32;
    float m_reg = -1e30f, l_reg = 0; f32x16 o[4] = {};
    const int sr = tid >> 4, sc = (tid & 15) * 8, vst0 = v_st(sr, sc), vst1 = v_st(32 + sr, sc), kws = KSWZ(sr, sc * 2);
    const int vb0 = (int)(uintptr_t)V_lds + v_rd_base(lane);
    const TIn* Kh = cur.K; const TIn* Vh = cur.V;
#define RESC(a) do { if (__any((a) < 1.f)) { if (hi == 0) al_l[r32] = (a); asm volatile("s_waitcnt lgkmcnt(0)" ::: "memory");              \
                     for (int d_ = 0; d_ < 4; ++d_) for (int r = 0; r < 16; ++r) o[d_][r] *= al_l[crow(r, hi)]; } } while (0)
#define KBASE(t) ((j_lo + (t)) * KVBLK)
#define ACT(t) (KBASE(t) <= qlo + QBLK - 1 && KBASE(t) + KVBLK - 1 >= qlo - W + 1)
#define MASKT(P0_, P1_, t) do { const int kb_ = KBASE(t); if ((!SK || ACT(t)) && (kb_ + KVBLK - 1 > qlo || kb_ <= qlo + QBLK - 1 - W)) mask_tile(P0_, P1_, qm - kb_, (unsigned)W); } while (0)
    constexpr int NQL = F32 ? 16 : 8;
    constexpr bool SK = WSKIP && !F32;
#define SEAM_K0() do { VMWN(NQL); if constexpr (F32) { SWRITE_KF(0); SBAR(); SLOAD_F((const float*)nxt.V, kbn); } else { SWRITE_HK(0, cref_nxt); } SBAR(); } while (0)
    f32x16 pA0, pA1, pB0, pB1; float mnA, mnB, alA, alB; bf16x8 pa0, pa1, pa2, pa3;
    if constexpr (F32) { VMW(); SWRITE_VF(0); SBAR(); } else { SWRITE_HV(0); SBAR(); }
    if (NT > 1) { if constexpr (F32) SLOAD_F((const float*)Kh, KBASE(1)); else SLOAD_H(Kh, Vh, Ch, KBASE(1)); }
    SBAR(); qkt<0, SK>(pA0, pA1, K_lds, r32, hi, S.qr, ACT(0));
    if constexpr (F32) { if (NT > 1) { VMW(); SWRITE_KF(1); SBAR(); SLOAD_F((const float*)Vh, KBASE(1)); } }
    BIASADD(pA0, pA1, 0); PADMASK(pA0, pA1); MASKT(pA0, pA1, 0); partialSM(pA0, pA1, m_reg, mnA, alA);
    if (NT > 1) { VMW(); if constexpr (F32) { SWRITE_VF(1); SBAR(); if (NT > 2) SLOAD_F((const float*)Kh, KBASE(2)); } else SWRITE_H(1, cref_cur); }
    __syncthreads();
#define HALF_STEP(PX0, PX1, mnX, alX, PY0, PY1, alY, t, KB, VB, SB) do {                                                      \
        SBAR(); qkt<KB, SK>(PX0, PX1, K_lds, r32, hi, S.qr, ACT(t));                                             \
        finishSM(PY0, PY1, alY, l_reg, pa0, pa1, pa2, pa3); SBAR();                                                           \
        if ((t) + 1 < NT) { if constexpr (F32) { VMW(); SWRITE_KF(SB); SBAR(); SLOAD_F((const float*)Vh, KBASE((t) + 1)); }  \
                            else { SLOAD_H(Kh, Vh, Ch, KBASE((t) + 1)); } SBAR(); }                                               \
        pv_tile<VB, SK>(o, vb0, pa0, pa1, pa2, pa3, ACT((t) - 1)); BIASADD(PX0, PX1, KB); MASKT(PX0, PX1, (t)); partialSM(PX0, PX1, m_reg, mnX, alX);                                        \
        __syncthreads();                                                                                                      \
        if ((t) + 1 < NT) { VMW(); if constexpr (F32) { SWRITE_VF(SB); SBAR(); if ((t) + 2 < NT) SLOAD_F((const float*)Kh, KBASE((t) + 2)); } \
                            else { SWRITE_H(SB, cref_cur); } }                                                                          \
        RESC(alX); __syncthreads(); } while (0)
    for (int t = 1; t + 1 < NT; t += 2) {
        HALF_STEP(pB0, pB1, mnB, alB, pA0, pA1, alA, t, 1, 0, 0);
        HALF_STEP(pA0, pA1, mnA, alA, pB0, pB1, alB, t + 1, 0, 1, 1);
    }
    const bool even = (NT & 1) == 0;
    if (even) { SBAR(); qkt<1, SK>(pB0, pB1, K_lds, r32, hi, S.qr, ACT(NT - 1)); SBAR(); }
#define QROW(e) (nxt.Q + (size_t)(wid * QBLK + r32) * D + ((e) >> 1) * 16 + hi * 8 + ((e) & 1) * 4)
    if constexpr (F32) { SLOAD_F((const float*)nxt.K, kbn); SBAR();
#pragma unroll
        for (int e = 0; e < 8; ++e) S.tq[e] = *(const f32x4*)QROW(e); }
    else { SLOAD_H(nxt.K, nxt.V, nxt.cb, kbn); SBAR();
#pragma unroll
        for (int d0 = 0; d0 < 8; ++d0) S.qr[d0] = load8<TIn>(nxt.Q + (size_t)(wid * QBLK + r32) * D + d0 * 16 + hi * 8); }
    SBAR();
    finishSM(pA0, pA1, alA, l_reg, pa0, pa1, pa2, pa3); SBAR();
    if constexpr (F32) {
#pragma unroll
        for (int e = 8; e < 16; ++e) S.tq[e] = *(const f32x4*)QROW(e); SBAR(); }
#undef QROW
    pv_tile<0, SK>(o, vb0, pa0, pa1, pa2, pa3, ACT(even ? NT - 2 : NT - 1));
    if (even) { BIASADD(pB0, pB1, 1); MASKT(pB0, pB1, NT - 1); partialSM(pB0, pB1, m_reg, mnB, alB); __syncthreads(); RESC(alB);
        finishSM(pB0, pB1, alB, l_reg, pa0, pa1, pa2, pa3); SBAR(); pv_tile<1, SK>(o, vb0, pa0, pa1, pa2, pa3, ACT(NT - 1)); }
    SBAR(); SEAM_K0();
    if (hi == 0) li_l[r32] = l_reg; asm volatile("s_waitcnt lgkmcnt(0)" ::: "memory");
    float rli[16];
#pragma unroll
    for (int r = 0; r < 16; ++r) rli[r] = __builtin_amdgcn_rcpf(li_l[crow(r, hi)]);
    TOut* Ow = cur.O + (size_t)(wid * QBLK) * cur.ldo; const int ldo = cur.ldo;
#pragma unroll
    for (int r = 0; r < 16; ++r) { const int orow = crow(r, hi);
#pragma unroll
        for (int d0 = 0; d0 < 4; ++d0) { const float v = o[d0][r] * rli[r];
            if constexpr (same_t<TOut, float>::v) { Ow[(size_t)orow * ldo + d0 * 32 + r32] = v; }
            else { const float vn = __shfl_xor(v, 1);
                   if ((r32 & 1) == 0) *(unsigned*)(Ow + (size_t)orow * ldo + d0 * 32 + r32) = cvtpk(v, vn); } } }
    if constexpr (F32) {
#pragma unroll
        for (int d0 = 0; d0 < 8; ++d0) S.qr[d0] = pack8(S.tq[2 * d0], S.tq[2 * d0 + 1]); }
    __syncthreads();
#undef RESC
#undef KBASE
#undef ACT
#undef MASKT
#undef SEAM_K0
#undef HALF_STEP
}
#undef ROW
#undef VMW
#undef VMWN
#undef SLOAD_H
#undef SWRITE_HK
#undef SWRITE_HV
#undef SWRITE_H
#undef SLOAD_F
#undef SWRITE_KF
#undef SWRITE_VF
#undef BIASADD
#undef PADMASK
}


constexpr int NWAVES = 8;
constexpr int NB = 2, T = 8192, DM = 4096, NMETA = 16, LSEQ = NMETA + T;
constexpr int MR = NB * T;
constexpr int KVR = 64 + T;
constexpr int NPROJ = 12288, INW = 12304, FFW = 16384, NGRP = 96;
constexpr int NFH = 16;
constexpr float LN_EPS = 1e-5f, SUBLN_EPS = 1e-5f;
constexpr float DN_ALPHA = 1.189207115002721f;
constexpr float LAMBDA_INIT = 0.2f;

constexpr size_t MiB = 1u << 20;
constexpr size_t WS_CTL = 0, CTL_ZERO_BYTES = 1 * MiB;
constexpr size_t WS_STATS0 = 1 * MiB, WS_STATS1 = WS_STATS0 + 131072, WS_HMETA = WS_STATS1 + 131072, WS_WFF = WS_HMETA + 131072;
constexpr size_t WS_ZF = 2 * MiB;
constexpr size_t WS_CUMS = 4 * MiB;
constexpr size_t WS_ROPE = 6 * MiB;
constexpr size_t WS_WUP = 16 * MiB, WS_WDN = 144 * MiB, WS_WOUT = 272 * MiB, WS_WIN = 304 * MiB;
constexpr size_t WS_H0B = 400 * MiB;
constexpr size_t WS_QKV = 528 * MiB;
constexpr size_t WS_PART0 = 304 * MiB, WS_PART1 = 915 * MiB;
constexpr size_t WS_H1B = 304 * MiB;
constexpr size_t WS_ACT = 432 * MiB;
constexpr size_t WS_END = 979 * MiB;
static_assert(WS_ZF + (size_t)NB * KVR * 16 * 4 <= WS_CUMS && WS_CUMS + (size_t)NB * 16 * KVR * 4 <= WS_ROPE && WS_ROPE + (size_t)2 * LSEQ * 64 * 4 <= WS_WUP, "small regions");
static_assert(WS_QKV + (size_t)NGRP * NB * KVR * 128 * 2 <= WS_PART1 && WS_PART1 + (size_t)MR * 2048 * 2 <= WS_END && WS_ACT + (size_t)MR * FFW * 2 <= WS_END, "big regions");
static_assert(WS_H1B + (size_t)MR * DM * 2 <= WS_ACT && WS_WIN + (size_t)NPROJ * DM * 2 <= WS_H0B && WS_PART0 + (size_t)MR * 2048 * 2 <= WS_H0B, "overlays");
constexpr int CW_TMO = 0, CW_CODE = 1;
constexpr int CW_BAR = 4096;

constexpr int RING_OFF = 0, RING_BYTES = 131072;
constexpr int LDSCTL_OFF = RING_BYTES, MISC_OFF = LDSCTL_OFF + 320;
constexpr int LDS_BYTES = 147456;
static_assert(MISC_OFF + 128 <= LDS_BYTES, "LDS map");
static_assert(att::LDS_BYTES <= RING_BYTES, "attention LDS");

#define GAS __attribute__((address_space(1)))
#define LAS __attribute__((address_space(3)))
typedef unsigned short bf16;
typedef unsigned v4u __attribute__((ext_vector_type(4)));
typedef float f32x4 __attribute__((ext_vector_type(4)));
typedef short bf16x8 __attribute__((ext_vector_type(8)));
typedef GAS unsigned gu32;
typedef GAS unsigned long long gu64;
#define RLX_AGENT __ATOMIC_RELAXED, __HIP_MEMORY_SCOPE_AGENT
#define LDS_WAIT() asm volatile("s_waitcnt lgkmcnt(0)" ::: "memory")
#define VM_WAIT() asm volatile("s_waitcnt vmcnt(0)" ::: "memory")
__device__ __forceinline__ unsigned long long rt() { return __builtin_amdgcn_s_memrealtime(); }
__device__ __forceinline__ unsigned f2bf(float f) { unsigned u = __builtin_bit_cast(unsigned, f); return (u + 0x7fffu + ((u >> 16) & 1u)) >> 16; }
__device__ __forceinline__ unsigned pk2(float lo, float hi) { return f2bf(lo) | (f2bf(hi) << 16); }

#define XB_TMO      128
#define XB_XCNT(j)  (256  + 64 * (j))
#define XB_XSUB(j)  (1280 + 64 * (j))
#define XB_XGEN(j)  (2304 + 64 * (j))
#define XB_TOP      3328
#define XB_TOPGEN   3392
#define XCD_BAR_WORDS 3456
#define XB_SPIN_CAP (1u << 18)

__device__ __forceinline__ unsigned xb_ld(unsigned* p)              { return __hip_atomic_load(p, __ATOMIC_RELAXED, __HIP_MEMORY_SCOPE_AGENT); }
__device__ __forceinline__ unsigned xb_add(unsigned* p, unsigned v) { return __hip_atomic_fetch_add(p, v, __ATOMIC_RELAXED, __HIP_MEMORY_SCOPE_AGENT); }
__device__ __forceinline__ unsigned xb_xcc_id() { return (unsigned)__builtin_amdgcn_s_getreg((3 << 11) | 20) & 0xFu; }
#define XB_SPIN(cond, bar) do { unsigned _sp = 0; while (cond) { __builtin_amdgcn_s_sleep(1); \
    if ((++_sp & 255u) == 0u) { if (xb_ld(&(bar)[XB_TMO])) break; if (_sp > XB_SPIN_CAP) { atomicAdd(&(bar)[XB_TMO], 1u); break; } } } } while (0)

struct XcdBarrier {
    unsigned* bar; unsigned x;
    volatile LAS unsigned* st;
};

__device__ __forceinline__ XcdBarrier xcd_barrier_post(unsigned* bar, volatile LAS unsigned* st) {
    XcdBarrier b; b.bar = bar; b.x = xb_xcc_id(); b.st = st;
    if (threadIdx.x == 0) (void)xb_add(&bar[XB_XCNT(b.x)], 1u);
    return b;
}
__device__ __forceinline__ void xcd_barrier_complete(unsigned* bar, unsigned x, unsigned& nloc, unsigned& nx) {
    const unsigned G = gridDim.x * gridDim.y * gridDim.z;
    unsigned sum, cnt, mine, sp = 0u;
    for (;;) {
        sum = 0u; cnt = 0u; mine = 0u;
#pragma unroll
        for (unsigned j = 0; j < 16; ++j) { const unsigned c = xb_ld(&bar[XB_XCNT(j)]); sum += c; cnt += (c > 0u) ? 1u : 0u; mine = (j == x) ? c : mine; }
        if (sum == G) break;
        __builtin_amdgcn_s_sleep(1);
        if ((++sp & 255u) == 0u) { if (xb_ld(&bar[XB_TMO])) break; if (sp > XB_SPIN_CAP) { atomicAdd(&bar[XB_TMO], 1u); break; } }
    }
    nloc = mine > 0u ? mine : 1u; nx = cnt > 0u ? cnt : 1u;
}

__device__ __forceinline__ void xcd_barrier(const XcdBarrier& b) {
    asm volatile("s_waitcnt vmcnt(0)" ::: "memory");
    __syncthreads();
    if (threadIdx.x == 0) {
        unsigned* bar = b.bar;
        __builtin_amdgcn_s_waitcnt(0);
        unsigned nloc = b.st[0], nx = b.st[1];
        if (nloc == 0u) { xcd_barrier_complete(bar, b.x, nloc, nx); b.st[0] = nloc; b.st[1] = nx; }
        const unsigned old = xb_add(&bar[XB_XSUB(b.x)], 1u);
        const unsigned gen = old / nloc;
        if (old + 1u == (gen + 1u) * nloc) {
            __builtin_amdgcn_fence(__ATOMIC_RELEASE, "agent");
            asm volatile("s_waitcnt vmcnt(0)" ::: "memory");
            const unsigned og = xb_add(&bar[XB_TOP], 1u);
            const unsigned tg = og / nx;
            if (og + 1u == (tg + 1u) * nx) xb_add(&bar[XB_TOPGEN], 1u);
            else XB_SPIN(xb_ld(&bar[XB_TOPGEN]) == tg, bar);
            __builtin_amdgcn_fence(__ATOMIC_ACQUIRE, "agent");
            xb_add(&bar[XB_XGEN(b.x)], 1u);
            asm volatile("s_waitcnt vmcnt(0)" ::: "memory");
        } else {
            XB_SPIN(xb_ld(&bar[XB_XGEN(b.x)]) == gen, bar);
            __builtin_amdgcn_fence(__ATOMIC_ACQUIRE, "agent");
            asm volatile("s_waitcnt vmcnt(0)" ::: "memory");
        }
    }
    __syncthreads();
}


__device__ __forceinline__ float wave_sum(float v) {
#pragma unroll
    for (int o = 1; o < 64; o <<= 1) v += __shfl_xor(v, o);
    return v;
}
__device__ __forceinline__ float bf2f(unsigned h) { return __builtin_bit_cast(float, h << 16); }
__device__ __forceinline__ float log_sigmoid(float z) { return fminf(z, 0.f) - log1pf(expf(-fabsf(z))); }

__device__ __forceinline__ int p0_rowmap(int n, int mode) {
    if (mode == 1) return n < 4096 ? ((n & ~192) | ((n & 64) << 1) | ((n & 128) >> 1)) : n;
    if (mode == 2) return n - NPROJ;
    return n;
}
__device__ __forceinline__ void p0_transpose_item(const float* W, int ldw, int K, bf16* WT, LAS float* scr, int k0, int n0, int nvalid, int mode, int lane) {
    const int nl = lane & 31;
#pragma unroll 8
    for (int i = 0; i < 32; ++i) { const int kk = 2 * i + (lane >> 5); float v = 0.f; if (nl < nvalid) v = W[(size_t)(k0 + kk) * ldw + n0 + nl]; scr[kk * 33 + nl] = v; }
    LDS_WAIT(); asm volatile("" ::: "memory");
    const int c = lane & 7;
#pragma unroll
    for (int j = 0; j < 4; ++j) { const int n = (lane >> 3) + 8 * j; const LAS float* s = scr + (8 * c) * 33 + n;
        v4u o; o.x = pk2(s[0 * 33], s[1 * 33]); o.y = pk2(s[2 * 33], s[3 * 33]); o.z = pk2(s[4 * 33], s[5 * 33]); o.w = pk2(s[6 * 33], s[7 * 33]);
        if (n < nvalid) *(GAS v4u*)(WT + (size_t)p0_rowmap(n0 + n, mode) * K + k0 + 8 * c) = o; }
    LDS_WAIT(); asm volatile("" ::: "memory");
}
__device__ __forceinline__ void ln_row(const float* src, const float* g, const float* bta, int lane, float* dstf, bf16* dstb, float* stats) {
    const GAS f32x4* xr = (const GAS f32x4*)src + lane;
    f32x4 v[16]; float s = 0.f;
#pragma unroll
    for (int j = 0; j < 16; ++j) { v[j] = xr[64 * j]; s += (v[j].x + v[j].y) + (v[j].z + v[j].w); }
    const float mean = wave_sum(s) * (1.f / DM); float s2 = 0.f;
#pragma unroll
    for (int j = 0; j < 16; ++j) { v[j] = v[j] - mean; s2 += (v[j].x * v[j].x + v[j].y * v[j].y) + (v[j].z * v[j].z + v[j].w * v[j].w); }
    const float rstd = 1.f / sqrtf(wave_sum(s2) * (1.f / DM) + LN_EPS);
    if (stats && lane == 0) { stats[0] = mean; stats[1] = rstd; }
    const GAS f32x4* g4 = (const GAS f32x4*)g + lane; const GAS f32x4* b4 = (const GAS f32x4*)bta + lane;
#pragma unroll
    for (int j = 0; j < 16; ++j) { const f32x4 o = v[j] * rstd * g4[64 * j] + b4[64 * j];
        if (dstf) ((GAS f32x4*)dstf + lane)[64 * j] = o;
        if (dstb) ((GAS unsigned long long*)dstb + lane)[64 * j] = (unsigned long long)pk2(o.x, o.y) | ((unsigned long long)pk2(o.z, o.w) << 32); }
}
__device__ __forceinline__ void sincos_d(double x, double& sn, double& cs) {
    const double kq = rint(x * 0.63661977236758134308);
    double r = fma(-kq, 1.57079632673412561417e+00, x); r = fma(-kq, 6.07710050630396597660e-11, r); r = fma(-kq, 2.02226624879595063154e-21, r);
    const int q = ((int)kq) & 3; const double z = r * r;
    const double sp = r + r * z * (-1.66666666666666324348e-01 + z * (8.33333333332248946124e-03 + z * (-1.98412698298579493134e-04 + z * (2.75573137070700676789e-06 + z * (-2.50507602534068634195e-08 + z * 1.58969099521155010221e-10)))));
    const double cp = 1.0 - 0.5 * z + z * z * (4.16666666666666019037e-02 + z * (-1.38888888888741095749e-03 + z * (2.48015872894767294178e-05 + z * (-2.75573143513906633035e-07 + z * (2.08757232129817482790e-09 + z * -1.13596475577881948265e-11)))));
    sn = (q == 0) ? sp : (q == 1) ? cp : (q == 2) ? -sp : -cp;
    cs = (q == 0) ? cp : (q == 1) ? -sp : (q == 2) ? -cp : sp;
}

struct Args { const float* in[18]; float* out; unsigned char* ws; int ph_lo, ph_hi; };
static_assert(sizeof(Args) == 18 * 8 + 8 + 8 + 8, "Args has padding");
__device__ const float INV_FREQ[64] = {0x1.0000000000000p+0f, 0x1.bb5fae0000000p-1f, 0x1.7ff2220000000p-1f, 0x1.4c7bc00000000p-1f, 0x1.1feb340000000p-1f, 0x1.f2a79e0000000p-2f, 0x1.afd1360000000p-2f, 0x1.75f0360000000p-2f, 0x1.43d1360000000p-2f, 0x1.186a080000000p-2f, 0x1.e5a8460000000p-3f, 0x1.a48fda0000000p-3f, 0x1.6c310e0000000p-3f, 0x1.3b60800000000p-3f, 0x1.111aee0000000p-3f, 0x1.d8ffac0000000p-4f, 0x1.99999a0000000p-4f, 0x1.62b2f00000000p-4f, 0x1.33281a0000000p-4f, 0x1.09fc9a0000000p-4f, 0x1.ccab840000000p-5f, 0x1.8eec7e0000000p-5f, 0x1.59742a0000000p-5f, 0x1.2b26900000000p-5f, 0x1.030dc60000000p-5f, 0x1.c0a9a40000000p-6f, 0x1.84869e0000000p-6f, 0x1.5073160000000p-6f, 0x1.235a720000000p-6f, 0x1.f89a660000000p-7f, 0x1.b4f7e40000000p-7f, 0x1.7a66220000000p-7f, 0x1.47ae140000000p-7f, 0x1.1bc25a0000000p-7f, 0x1.eb73600000000p-8f, 0x1.a9942a0000000p-8f, 0x1.7089380000000p-8f, 0x1.3f23980000000p-8f, 0x1.145cee0000000p-8f, 0x1.dea41c0000000p-9f, 0x1.9e7c700000000p-9f, 0x1.66ee1e0000000p-9f, 0x1.36d21a0000000p-9f, 0x1.0d28de0000000p-9f, 0x1.d22a500000000p-10f, 0x1.93aeb80000000p-10f, 0x1.5d931c0000000p-10f, 0x1.2eb81c0000000p-10f, 0x1.0624de0000000p-10f, 0x1.c603c40000000p-11f, 0x1.8929180000000p-11f, 0x1.5476880000000p-11f, 0x1.26d42c0000000p-11f, 0x1.fe9f580000000p-12f, 0x1.ba2e4a0000000p-12f, 0x1.7ee9ae0000000p-12f, 0x1.4b96c00000000p-12f, 0x1.1f24e40000000p-12f, 0x1.f1502a0000000p-13f, 0x1.aea7c80000000p-13f, 0x1.74eea60000000p-13f, 0x1.42f22c0000000p-13f, 0x1.17a8e40000000p-13f, 0x1.e459c40000000p-14f};
typedef att::BlockRef<att::bf16, att::bf16> ABR;
__device__ __forceinline__ ABR mkref_diff(int n, int xq, int jq, const att::bf16* Q0, att::bf16* part0, att::bf16* part1) {
    const int idx = (n >> 1) * 32 + jq, s = idx >> 4, pair = idx & 15, ph = 2 * xq + (s >> 2), b = ph >> 3, h = ph & 7, c = (s >> 1) & 1, e = s & 1;
    const int qb = (n & 1) ? 31 - pair : pair; ABR r;
    r.Q = Q0 + ((size_t)((2 * h + c) * NB + b) * KVR + 64 + 256 * qb) * 128; r.K = Q0 + (size_t)((16 + 2 * h + c) * NB + b) * KVR * 128; r.V = Q0 + (size_t)((32 + 2 * h + e) * NB + b) * KVR * 128;
    r.O = (c ? part1 : part0) + (size_t)(b * T + 256 * qb) * 2048 + h * 256 + e * 128; r.P0 = 64 + 256 * qb; r.ldo = 2048; r.cb = nullptr; return r;
}
__device__ __forceinline__ ABR mkref_fox(int n, int xq, int jq, const att::bf16* Q0, att::bf16* mix, const float* cums) {
    const int idx = (n >> 1) * 32 + jq, hidx = 4 * xq + (idx >> 4), pair = idx & 15, b = hidx >> 4, h = hidx & 15;
    const int qb = (n & 1) ? 31 - pair : pair; ABR r;
    r.Q = Q0 + ((size_t)((48 + h) * NB + b) * KVR + 64 + 256 * qb) * 128; r.K = Q0 + (size_t)((64 + h) * NB + b) * KVR * 128; r.V = Q0 + (size_t)((80 + h) * NB + b) * KVR * 128;
    r.O = mix + (size_t)(b * T + 256 * qb) * DM + 2048 + h * 128; r.P0 = 64 + 256 * qb; r.ldo = DM; r.cb = cums + (size_t)(b * NFH + h) * KVR; return r;
}
constexpr int N_PHASES = 10;
#ifndef MK_FUSED
#define MK_FUSED 1
#endif

__device__ __forceinline__ const float* karg_f(int idx) {
    const char __attribute__((address_space(4)))* kb = (const char __attribute__((address_space(4)))*)__builtin_amdgcn_kernarg_segment_ptr();
    int off = 8 * idx; asm volatile("" : "+s"(off));
    return (const float*)(const __attribute__((address_space(1))) float*)*(const unsigned long long __attribute__((address_space(4)))*)(kb + off);
}
__global__ void __launch_bounds__(NWAVES * 64, 2) mk_fwd(Args args) {
    extern __shared__ __attribute__((aligned(16))) unsigned char lds_raw[];
    LAS unsigned char* lds = (LAS unsigned char*)lds_raw;
    volatile LAS unsigned* MISC = (volatile LAS unsigned*)(lds + MISC_OFF);
    const int G = gridDim.x, bx = blockIdx.x;
    const int vcu = (G % 8 == 0) ? (bx % 8) * (G / 8) + bx / 8 : bx;
    const int NGW = G * NWAVES;
#define LANE_IDS() const int tid = att::fresh_tid(), lane = tid & 63, wave = __builtin_amdgcn_readfirstlane(tid >> 6), gw = vcu * NWAVES + wave; (void)lane; (void)gw
    unsigned char* ws = args.ws;
    gu32* ctl = (gu32*)(ws + WS_CTL);
    float* out = args.out;
    float* stats0 = (float*)(ws + WS_STATS0); float* stats1 = (float*)(ws + WS_STATS1);
    bf16* hmeta = (bf16*)(ws + WS_HMETA); bf16* wff = (bf16*)(ws + WS_WFF);
    float* zf = (float*)(ws + WS_ZF); float* cums = (float*)(ws + WS_CUMS);
    float* ropeC = (float*)(ws + WS_ROPE); float* ropeS = ropeC + (size_t)LSEQ * 64;
    bf16* Wup = (bf16*)(ws + WS_WUP); bf16* Wdn = (bf16*)(ws + WS_WDN); bf16* Wout = (bf16*)(ws + WS_WOUT); bf16* Win = (bf16*)(ws + WS_WIN);
    bf16* h0b = (bf16*)(ws + WS_H0B); bf16* mixb = (bf16*)(ws + WS_H0B); bf16* qkv = (bf16*)(ws + WS_QKV);
    bf16* part0 = (bf16*)(ws + WS_PART0); bf16* part1 = (bf16*)(ws + WS_PART1);
    bf16* h1b = (bf16*)(ws + WS_H1B); bf16* actb = (bf16*)(ws + WS_ACT);

    for (int u = threadIdx.x; u < (LDS_BYTES - LDSCTL_OFF) / 4; u += NWAVES * 64) ((LAS unsigned*)(lds + LDSCTL_OFF))[u] = 0u;
    __syncthreads();
    const int lo = args.ph_lo, hi = args.ph_hi;
    XcdBarrier bar; bar.bar = (unsigned*)(ctl + CW_BAR); bar.x = 0; bar.st = nullptr;
    if (hi - lo > 1) bar = xcd_barrier_post((unsigned*)(ctl + CW_BAR), MISC + 8);
#define IN(k) (lo <= (k) && (k) < hi)
#define SEAM(k) do { if (IN(k) && IN((k) + 1)) xcd_barrier(bar); } while (0)

    if (IN(0)) {
        LANE_IDS();
        const float* x = karg_f(0); const float* meta_tok = karg_f(1); const float* ln_in_g = karg_f(2); const float* ln_in_b = karg_f(3);
        const float* w_in = karg_f(4); const float* w_out = karg_f(11); const float* w_up = karg_f(14); const float* w_down = karg_f(15);
        LAS float* scr = (LAS float*)(lds + RING_OFF + wave * 16384);
        constexpr int I_IN = 64 * 385, I_OUT = 64 * 128, I_UP = 64 * 512, I_DN = 256 * 128, NITEMS = I_IN + I_OUT + I_UP + I_DN;
        for (int it = gw; it < NITEMS; it += NGW) {
            int r = it;
            if (r < I_IN) { const int kb = r / 385, nb = r % 385;
                if (nb < 384) p0_transpose_item(w_in, INW, DM, Win, scr, 64 * kb, 32 * nb, 32, 1, lane);
                else p0_transpose_item(w_in, INW, DM, wff, scr, 64 * kb, NPROJ, 16, 2, lane);
                continue; } r -= I_IN;
            if (r < I_OUT) { p0_transpose_item(w_out, DM, DM, Wout, scr, 64 * (r / 128), 32 * (r % 128), 32, 0, lane); continue; } r -= I_OUT;
            if (r < I_UP) { p0_transpose_item(w_up, FFW, DM, Wup, scr, 64 * (r / 512), 32 * (r % 512), 32, 0, lane); continue; } r -= I_UP;
            p0_transpose_item(w_down, DM, FFW, Wdn, scr, 64 * (r / 128), 32 * (r % 128), 32, 0, lane);
        }
        for (int m = gw; m < MR; m += NGW) ln_row(x + (size_t)m * DM, ln_in_g, ln_in_b, lane, nullptr, h0b + (size_t)m * DM, stats0 + 2 * m);
        if (gw < NMETA) ln_row(meta_tok + (size_t)gw * DM, ln_in_g, ln_in_b, lane, nullptr, hmeta + (size_t)gw * DM, nullptr);
        for (int idx = bx * (NWAVES * 64) + tid; idx < LSEQ * 64; idx += G * NWAVES * 64) {
            const int pos = idx >> 6, i = idx & 63; const float ang = (float)pos * INV_FREQ[i]; double sn, cs; sincos_d((double)ang, sn, cs);
            ropeC[idx] = (float)cs; ropeS[idx] = (float)sn; }
        if (gw < NGRP * NB) { GAS v4u* p = (GAS v4u*)(qkv + ((size_t)gw * KVR + 16) * 128);
#pragma unroll
            for (int j = 0; j < 12; ++j) p[64 * j + lane] = (v4u){0u, 0u, 0u, 0u}; }
    }
    SEAM(0);

    if (IN(1)) {
        LANE_IDS();
        const int r16 = lane & 15, q4 = lane >> 4;
        if (bx < 128) {
            const int m0 = 128 * bx + 16 * wave;
            const bf16* ap = h0b + (size_t)(m0 + r16) * DM + 8 * q4; const bf16* bp = wff + (size_t)r16 * DM + 8 * q4;
            f32x4 acc = {0.f, 0.f, 0.f, 0.f};
#pragma unroll 8
            for (int k0 = 0; k0 < DM; k0 += 32) acc = __builtin_amdgcn_mfma_f32_16x16x32_bf16(*(const bf16x8*)(ap + k0), *(const bf16x8*)(bp + k0), acc, 0, 0, 0);
#pragma unroll
            for (int rg = 0; rg < 4; ++rg) { const int m = m0 + 4 * q4 + rg, b = m >> 13, t = m & 8191; zf[((size_t)b * KVR + 64 + t) * 16 + r16] = acc[rg]; }
        } else if (bx < 128 + 48) {
            const int pn = bx - 128, s = 16 * wave + r16;
            const bf16* ap = hmeta + (size_t)r16 * DM + 8 * q4; const bf16* bp0 = Win + (size_t)(256 * pn + s) * DM + 8 * q4; const bf16* bp1 = bp0 + (size_t)128 * DM;
            f32x4 a0 = {0.f, 0.f, 0.f, 0.f}, a1 = {0.f, 0.f, 0.f, 0.f};
#pragma unroll 4
            for (int k0 = 0; k0 < DM; k0 += 32) { const bf16x8 av = *(const bf16x8*)(ap + k0);
                a0 = __builtin_amdgcn_mfma_f32_16x16x32_bf16(av, *(const bf16x8*)(bp0 + k0), a0, 0, 0, 0);
                a1 = __builtin_amdgcn_mfma_f32_16x16x32_bf16(av, *(const bf16x8*)(bp1 + k0), a1, 0, 0, 0); }
#pragma unroll
            for (int rg = 0; rg < 4; ++rg) { const int i = 4 * q4 + rg;
                if (pn < 16) { const int hh = s >> 6, dl = s & 63, g = 2 * pn + hh; const float c = ropeC[i * 64 + dl], sn = ropeS[i * 64 + dl];
                    const unsigned o1 = f2bf(a0[rg] * c - a1[rg] * sn), o2 = f2bf(a1[rg] * c + a0[rg] * sn);
#pragma unroll
                    for (int b = 0; b < NB; ++b) { bf16* p = qkv + ((size_t)(g * NB + b) * KVR + i) * 128 + dl; p[0] = (bf16)o1; p[64] = (bf16)o2; }
                } else {
#pragma unroll
                    for (int b = 0; b < NB; ++b) { qkv[((size_t)((2 * pn) * NB + b) * KVR + i) * 128 + s] = (bf16)f2bf(a0[rg]); qkv[((size_t)((2 * pn + 1) * NB + b) * KVR + i) * 128 + s] = (bf16)f2bf(a1[rg]); }
                } }
        } else if (bx == 176 && wave == 0) {
            const bf16* ap = hmeta + (size_t)r16 * DM + 8 * q4; const bf16* bp = wff + (size_t)r16 * DM + 8 * q4;
            f32x4 acc = {0.f, 0.f, 0.f, 0.f};
#pragma unroll 8
            for (int k0 = 0; k0 < DM; k0 += 32) acc = __builtin_amdgcn_mfma_f32_16x16x32_bf16(*(const bf16x8*)(ap + k0), *(const bf16x8*)(bp + k0), acc, 0, 0, 0);
#pragma unroll
            for (int rg = 0; rg < 4; ++rg) { const int i = 4 * q4 + rg; zf[((size_t)0 * KVR + i) * 16 + r16] = acc[rg]; zf[((size_t)1 * KVR + i) * 16 + r16] = acc[rg]; }
        }
        pg8::Gemm g{h0b, Win, MR, NPROJ, DM}; pg8::StaticOrder S; S.init(MR, NPROJ, G, bx);
        pg8::EpiProj E{qkv, ropeC, ropeS, KVR, NB};
        pg8::gemm_phase<pg8::EpiProj, pg8::StaticOrder, PG8_ALIGN, PG8_SP2>(lds + RING_OFF, g, S, E);
    }
    SEAM(1);

    if (IN(2)) {
        if (bx < NB * NFH) {
            LANE_IDS();
            const float* b_forget = karg_f(5);
            const int b = bx >> 4, h = bx & 15; const float bfg = b_forget[h];
            LAS double* sd = (LAS double*)(lds + RING_OFF);
            float lf[16]; float run = 0.f;
#pragma unroll
            for (int j = 0; j < 16; ++j) { run += log_sigmoid(zf[((size_t)b * KVR + 64 + 16 * tid + j) * 16 + h] + bfg); lf[j] = run; }
            double mt = 0.0;
#pragma unroll
            for (int i = 0; i < NMETA; ++i) { mt += (double)log_sigmoid(zf[((size_t)b * KVR + i) * 16 + h] + bfg); if (tid == 0) cums[(size_t)bx * KVR + i] = (float)mt; }
            if (tid >= 16 && tid < 64) cums[(size_t)bx * KVR + tid] = 0.f;
            int cur = 0; sd[tid] = (double)run; __syncthreads();
#pragma unroll 1
            for (int off = 1; off < NWAVES * 64; off <<= 1) { const double v = sd[cur * 512 + tid] + (tid >= off ? sd[cur * 512 + tid - off] : 0.0); sd[(cur ^ 1) * 512 + tid] = v; __syncthreads(); cur ^= 1; }
            const double base = mt + sd[cur * 512 + tid] - (double)run;
#pragma unroll
            for (int j = 0; j < 16; ++j) cums[(size_t)bx * KVR + 64 + 16 * tid + j] = (float)(base + (double)lf[j]);
            __syncthreads();
        }
    }
    SEAM(2);

    if (IN(3)) {
        const int xq = vcu >> 5, jq = vcu & 31;
        const att::bf16* Q0 = (const att::bf16*)qkv;
        {
            att::Seam<att::bf16> S; ABR cur = mkref_diff(0, xq, jq, Q0, (att::bf16*)part0, (att::bf16*)part1);
            att::causal_swa_prime<att::bf16, att::bf16, 0>(cur, 1 << 30, (char*)lds_raw, S);
#pragma unroll 1
            for (int n = 0; n < 8; ++n) { const ABR nxt = (n + 1 < 8) ? mkref_diff(n + 1, xq, jq, Q0, (att::bf16*)part0, (att::bf16*)part1) : cur;
                att::causal_swa_block<att::bf16, att::bf16, 0>(cur, nxt, KVR, 1 << 30, (char*)lds_raw, S); cur = nxt; }
        }
        {
            att::Seam<att::bf16> S; ABR cur = mkref_fox(0, xq, jq, Q0, (att::bf16*)mixb, cums);
            att::causal_swa_prime<att::bf16, att::bf16, 1>(cur, 1 << 30, (char*)lds_raw, S);
#pragma unroll 1
            for (int n = 0; n < 4; ++n) { const ABR nxt = (n + 1 < 4) ? mkref_fox(n + 1, xq, jq, Q0, (att::bf16*)mixb, cums) : cur;
                att::causal_swa_block<att::bf16, att::bf16, 1>(cur, nxt, KVR, 1 << 30, (char*)lds_raw, S); cur = nxt; }
        }
    }
    SEAM(3);

    if (IN(4)) {
        LANE_IDS();
        const float* lq1 = karg_f(6); const float* lk1 = karg_f(7); const float* lq2 = karg_f(8); const float* lk2 = karg_f(9); const float* subln_g = karg_f(10);
        const float s1 = wave_sum(lq1[lane] * lk1[lane] + lq1[lane + 64] * lk1[lane + 64]), s2 = wave_sum(lq2[lane] * lk2[lane] + lq2[lane + 64] * lk2[lane + 64]);
        const float lam = expf(s1) - expf(s2) + LAMBDA_INIT;
        const f32x4 gl = *(const f32x4*)(subln_g + 4 * lane) * (1.0f - LAMBDA_INIT);
        for (int m = gw; m < MR; m += NGW) {
#pragma unroll
            for (int h = 0; h < 8; ++h) {
                const unsigned long long u0 = *((const GAS unsigned long long*)(part0 + (size_t)m * 2048 + h * 256) + lane), u1 = *((const GAS unsigned long long*)(part1 + (size_t)m * 2048 + h * 256) + lane);
                f32x4 d; d.x = bf2f((unsigned)u0 & 0xffffu) - lam * bf2f((unsigned)u1 & 0xffffu); d.y = bf2f(((unsigned)u0 >> 16)) - lam * bf2f(((unsigned)u1 >> 16));
                d.z = bf2f((unsigned)(u0 >> 32) & 0xffffu) - lam * bf2f((unsigned)(u1 >> 32) & 0xffffu); d.w = bf2f((unsigned)(u0 >> 48)) - lam * bf2f((unsigned)(u1 >> 48));
                const float ss = wave_sum((d.x * d.x + d.y * d.y) + (d.z * d.z + d.w * d.w));
                const float r = 1.f / sqrtf(ss * (1.f / 256.f) + SUBLN_EPS);
                const f32x4 o = d * r * gl;
                *((GAS unsigned long long*)(mixb + (size_t)m * DM + h * 256) + lane) = (unsigned long long)pk2(o.x, o.y) | ((unsigned long long)pk2(o.z, o.w) << 32);
            }
        }
    }
    SEAM(4);

    if (IN(5)) {
        const float* x = karg_f(0); const float* ln_in_g = karg_f(2); const float* ln_in_b = karg_f(3);
        pg8::Gemm g{mixb, Wout, MR, DM, DM}; pg8::StaticOrder S; S.init(MR, DM, G, bx);
        pg8::EpiOut E{x, stats0, ln_in_g, ln_in_b, out, DM, DN_ALPHA};
        pg8::gemm_phase<pg8::EpiOut, pg8::StaticOrder, PG8_ALIGN, PG8_SP2>(lds + RING_OFF, g, S, E);
    }
    SEAM(5);

    if (IN(6)) { LANE_IDS(); const float* ln_attn_g = karg_f(12); const float* ln_attn_b = karg_f(13);
        for (int m = gw; m < MR; m += NGW) ln_row(out + (size_t)m * DM, ln_attn_g, ln_attn_b, lane, nullptr, h1b + (size_t)m * DM, stats1 + 2 * m); }
    SEAM(6);

    if (IN(7)) {
        pg8::Gemm g{h1b, Wup, MR, FFW, DM}; pg8::StaticOrder S; S.init(MR, FFW, G, bx);
        pg8::EpiUp E{actb, FFW};
        pg8::gemm_phase<pg8::EpiUp, pg8::StaticOrder, PG8_ALIGN, PG8_SP2>(lds + RING_OFF, g, S, E);
    }
    SEAM(7);

    if (IN(8)) {
        const float* ln_attn_g = karg_f(12); const float* ln_attn_b = karg_f(13);
        pg8::Gemm g{actb, Wdn, MR, DM, FFW}; pg8::StaticOrder S; S.init(MR, DM, G, bx);
        pg8::EpiDown E{out, stats1, ln_attn_g, ln_attn_b, DM, DN_ALPHA};
        pg8::gemm_phase<pg8::EpiDown, pg8::StaticOrder, PG8_ALIGN, PG8_SP2>(lds + RING_OFF, g, S, E);
    }
    SEAM(8);

    if (IN(9)) { LANE_IDS(); const float* ln_mlp_g = karg_f(16); const float* ln_mlp_b = karg_f(17);
        for (int m = gw; m < MR; m += NGW) ln_row(out + (size_t)m * DM, ln_mlp_g, ln_mlp_b, lane, out + (size_t)m * DM, nullptr, nullptr); }
#undef IN
#undef SEAM
}

extern "C" void kernel_launch(void* const* d_in, const int* in_sizes, int n_in, void* d_out, int out_size, void* d_ws, size_t ws_size, hipStream_t stream) {
    static int grid = 0;
    if (grid == 0) {
        if (n_in != 18 || in_sizes[0] != MR * DM || out_size != MR * DM || ws_size < WS_END) { fprintf(stderr, "kernel_launch: shape/workspace mismatch (n_in %d, in0 %d, out %d, ws %zu < %zu)\n", n_in, n_in > 0 ? in_sizes[0] : -1, out_size, ws_size, (size_t)WS_END); grid = -1; return; }
        if (hipFuncSetAttribute((const void*)mk_fwd, hipFuncAttributeMaxDynamicSharedMemorySize, LDS_BYTES) != hipSuccess) { fprintf(stderr, "kernel_launch: hipFuncSetAttribute failed\n"); grid = -1; return; }
        int per_cu = 0;
        if (hipOccupancyMaxActiveBlocksPerMultiprocessor(&per_cu, (const void*)mk_fwd, NWAVES * 64, LDS_BYTES) != hipSuccess || per_cu < 1) fprintf(stderr, "kernel_launch: occupancy query reports %d\n", per_cu);
        (void)hipGetLastError();
        grid = 256;
    }
    if (grid < 0) return;
    if (hipMemsetAsync((char*)d_ws + WS_CTL, 0, CTL_ZERO_BYTES, stream) != hipSuccess) { fprintf(stderr, "kernel_launch: memset failed\n"); return; }
    Args a{};
    for (int i = 0; i < 18; ++i) a.in[i] = (const float*)d_in[i];
    a.out = (float*)d_out; a.ws = (unsigned char*)d_ws;
#if MK_FUSED
    a.ph_lo = 0; a.ph_hi = N_PHASES;
    hipLaunchKernelGGL(mk_fwd, dim3(grid), dim3(NWAVES * 64), LDS_BYTES, stream, a);
#else
    for (int p = 0; p < N_PHASES; ++p) { a.ph_lo = p; a.ph_hi = p + 1; hipLaunchKernelGGL(mk_fwd, dim3(grid), dim3(NWAVES * 64), LDS_BYTES, stream, a); }
#endif
    const hipError_t le = hipPeekAtLastError();
    if (le != hipSuccess) fprintf(stderr, "kernel_launch: launch failed: %s\n", hipGetErrorName(le));
}
```

```cpp
#include <hip/hip_runtime.h>
#include <hip/hip_bf16.h>
#include <cstdio>
#include <cstdint>
#include <cmath>
#ifndef MK_FUSED
#define MK_FUSED 1
#endif
#ifndef REP_PHASE
#define REP_PHASE -1
#endif
#if 1
#endif
__device__ __forceinline__ int mk_lane_id() { return (int)__builtin_amdgcn_mbcnt_hi(~0u, __builtin_amdgcn_mbcnt_lo(~0u, 0u)); }
namespace pg8 {
#define PG8_LAS __attribute__((address_space(3)))
typedef unsigned short bf16_t;
typedef short bf16x8 __attribute__((ext_vector_type(8)));
typedef float f32x4 __attribute__((ext_vector_type(4)));
typedef unsigned u32x4 __attribute__((ext_vector_type(4)));
constexpr int BM = 256, BK = 64, HALF = 128, HTB = HALF * BK * 2  , STAGE_BYTES = 8 * HTB, NXCD = 8, WGM = 8;

__host__ __device__ __forceinline__ int lds_byte(int r, int c) { const int st = (r >> 4) * 2 + (c >> 5), rr = r & 15, cc = c & 31, ob = rr * 64 + cc * 2; return st * 1024 + (ob ^ (((ob >> 9) & 1) << 5)); }
__host__ __device__ __forceinline__ void stage_rc(int b, int& R, int& C) { const int st = b / 1024, sb = b % 1024, swz = sb ^ (((sb >> 9) & 1) << 5); R = (st >> 1) * 16 + swz / 64; C = (st & 1) * 32 + (swz % 64) / 2; }
__host__ __device__ __forceinline__ int perm32(int rho) { const int n = rho >> 4, i = rho & 15; return 8 * (i >> 2) + 4 * n + (i & 3); }

struct Unit { int pm, pn; };
struct Gemm { const bf16_t* A; const bf16_t* Bt; int M, N, K; int ashift; };

struct StaticOrder {
    int nM, nN, nwg, G, c;
    __host__ __device__ void init(int M, int N, int G_, int c_) { nM = M / BM; nN = N / BM; nwg = nM * nN; G = G_; c = c_; }
    __host__ __device__ bool next(int i, Unit& u) const {
        const long L = (long)i * G + c; if (L >= nwg) return false;
        int wgid = (int)L; { const int q = nwg / NXCD, r = nwg % NXCD, xcd = wgid % NXCD, off = wgid / NXCD; wgid = (xcd < r ? xcd * (q + 1) : r * (q + 1) + (xcd - r) * q) + off; }
        const int nig = WGM * nN, gid = wgid / nig, fm = gid * WGM, gsz = (nM - fm) < WGM ? (nM - fm) : WGM;
        u.pm = fm + ((wgid % nig) % gsz); u.pn = (wgid % nig) / gsz; return true;
    }
    __device__ __forceinline__ void a_ready(const Unit&) const {}
    __device__ __forceinline__ void done(const Unit&) const {}
};

__device__ __forceinline__ unsigned cvt_pk_bf16(float lo, float hi) { unsigned r; asm volatile("v_cvt_pk_bf16_f32 %0, %1, %2" : "=v"(r) : "v"(lo), "v"(hi)); return r; }
__device__ __forceinline__ u32x4 pack8bf(const f32x4 v0, const f32x4 v1) { u32x4 w; w.x = cvt_pk_bf16(v0[0], v0[1]); w.y = cvt_pk_bf16(v0[2], v0[3]); w.z = cvt_pk_bf16(v1[0], v1[1]); w.w = cvt_pk_bf16(v1[2], v1[3]); return w; }

struct EpiProj {
    static constexpr bool PERM = true, AFTER_DRAIN = false;
    bf16_t* QKV; const float* ropeC; const float* ropeS; int kvr, nb; unsigned* nrm;
    __device__ __forceinline__ void operator()(const f32x4 (&acc)[2][2][4][2], const Unit& u, int wr, int wc, int fr, int fq) const {
        const int m0 = u.pm * BM, b = m0 >> 13, t0 = (m0 & 8191) + wr * 64 + fr;
        if (u.pn < 16) {
            const int hh = wc >> 1, dl0 = 32 * (wc & 1) + 8 * fq, g = 2 * u.pn + hh;
            bf16_t* base = QKV + ((size_t)(g * nb + b) * kvr + 64) * 128 + dl0;
#pragma unroll
            for (int ai = 0; ai < 2; ++ai)
#pragma unroll
                for (int m = 0; m < 4; ++m) { const int t = t0 + ai * HALF + m * 16; const float* cp = ropeC + (size_t)(16 + t) * 64 + dl0; const float* sp = ropeS + (size_t)(16 + t) * 64 + dl0;
                    const f32x4 c0 = *(const f32x4*)cp, c1 = *(const f32x4*)(cp + 4), s0 = *(const f32x4*)sp, s1 = *(const f32x4*)(sp + 4);
                    const f32x4 x1a = acc[ai][0][m][0], x1b = acc[ai][0][m][1], x2a = acc[ai][1][m][0], x2b = acc[ai][1][m][1];
                    const f32x4 o1a = x1a * c0 - x2a * s0, o1b = x1b * c1 - x2b * s1, o2a = x2a * c0 + x1a * s0, o2b = x2b * c1 + x1b * s1;
                    bf16_t* rowp = base + (size_t)t * 128;
                    *(u32x4*)rowp = pack8bf(o1a, o1b); *(u32x4*)(rowp + 64) = pack8bf(o2a, o2b); }
        } else {
#pragma unroll
            for (int bj = 0; bj < 2; ++bj) { const int g = 2 * u.pn + bj; bf16_t* base = QKV + ((size_t)(g * nb + b) * kvr + 64) * 128 + 32 * wc + 8 * fq;
#pragma unroll
                for (int ai = 0; ai < 2; ++ai)
#pragma unroll
                    for (int m = 0; m < 4; ++m) { const int t = t0 + ai * HALF + m * 16; *(u32x4*)(base + (size_t)t * 128) = pack8bf(acc[ai][bj][m][0], acc[ai][bj][m][1]); } }
            if (u.pn >= 24 && u.pn < 40) {
#pragma unroll
                for (int bj = 0; bj < 2; ++bj) { float mx = 0.f;
#pragma unroll
                    for (int ai = 0; ai < 2; ++ai)
#pragma unroll
                        for (int m = 0; m < 4; ++m) { const f32x4 a = acc[ai][bj][m][0], c = acc[ai][bj][m][1];
                            float ss = (a[0] * a[0] + a[1] * a[1]) + (a[2] * a[2] + a[3] * a[3]) + (c[0] * c[0] + c[1] * c[1]) + (c[2] * c[2] + c[3] * c[3]);
                            ss += __shfl_xor(ss, 16); ss += __shfl_xor(ss, 32); mx = fmaxf(mx, ss); }
                    mx = fmaxf(mx, __shfl_xor(mx, 1)); mx = fmaxf(mx, __shfl_xor(mx, 2)); mx = fmaxf(mx, __shfl_xor(mx, 4)); mx = fmaxf(mx, __shfl_xor(mx, 8));
                    if (fr == 0 && fq == 0) atomicMax(nrm + ((2 * u.pn + bj - 48) * nb + b) * 16 + wc, __float_as_uint(mx * 1.02f)); }
            }
        }
    }
};
struct EpiOut {
    static constexpr bool PERM = false, AFTER_DRAIN = false;
    const float* X; const float* stats; const float* g; const float* bta; float* Y; int ldc; float alpha;
    __device__ __forceinline__ void operator()(const f32x4 (&acc)[2][2][4][2], const Unit& u, int wr, int wc, int fr, int fq) const {
        const int row0 = u.pm * BM + wr * 64 + fr, col0 = u.pn * BM + wc * 32 + 4 * fq;
        f32x4 gv[2][2], bv[2][2];
#pragma unroll
        for (int bj = 0; bj < 2; ++bj)
#pragma unroll
            for (int n = 0; n < 2; ++n) { gv[bj][n] = *(const f32x4*)(g + col0 + bj * HALF + n * 16); bv[bj][n] = *(const f32x4*)(bta + col0 + bj * HALF + n * 16); }
#pragma unroll
        for (int ai = 0; ai < 2; ++ai)
#pragma unroll
            for (int m = 0; m < 4; ++m) { const int r = row0 + ai * HALF + m * 16; const float mu = stats[2 * r], rs = stats[2 * r + 1] * alpha; const size_t off = (size_t)r * ldc + col0;
#pragma unroll
                for (int bj = 0; bj < 2; ++bj)
#pragma unroll
                    for (int n = 0; n < 2; ++n) { const f32x4 xv = *(const f32x4*)(X + off + bj * HALF + n * 16);
                        *(f32x4*)(Y + off + bj * HALF + n * 16) = (xv - mu) * rs * gv[bj][n] + bv[bj][n] * alpha + acc[ai][bj][m][n]; }
                if (m & 1) asm volatile("" ::: "memory"); }
    }
};
struct EpiUp {
    static constexpr bool PERM = true, AFTER_DRAIN = false;
    bf16_t* O; int ldc;
    __device__ __forceinline__ void operator()(const f32x4 (&acc)[2][2][4][2], const Unit& u, int wr, int wc, int fr, int fq) const {
        const int row0 = u.pm * BM + wr * 64 + fr, col0 = u.pn * BM + wc * 32 + 8 * fq;
#pragma unroll
        for (int ai = 0; ai < 2; ++ai)
#pragma unroll
            for (int m = 0; m < 4; ++m) { bf16_t* rowp = O + (size_t)(row0 + ai * HALF + m * 16) * ldc + col0;
#pragma unroll
                for (int bj = 0; bj < 2; ++bj) { f32x4 v0 = acc[ai][bj][m][0], v1 = acc[ai][bj][m][1];
#pragma unroll
                    for (int e = 0; e < 4; ++e) { const float a = fmaxf(v0[e], 0.f), c = fmaxf(v1[e], 0.f); v0[e] = a * a; v1[e] = c * c; }
                    *(u32x4*)(rowp + bj * HALF) = pack8bf(v0, v1); } }
    }
};
struct EpiDown {
    static constexpr bool PERM = false, AFTER_DRAIN = false;
    float* Y; const float* stats; const float* g; const float* bta; int ldc; float alpha;
    __device__ __forceinline__ void operator()(const f32x4 (&acc)[2][2][4][2], const Unit& u, int wr, int wc, int fr, int fq) const {
        const int row0 = u.pm * BM + wr * 64 + fr, col0 = u.pn * BM + wc * 32 + 4 * fq;
        f32x4 gv[2][2], bv[2][2];
#pragma unroll
        for (int bj = 0; bj < 2; ++bj)
#pragma unroll
            for (int n = 0; n < 2; ++n) { gv[bj][n] = *(const f32x4*)(g + col0 + bj * HALF + n * 16); bv[bj][n] = *(const f32x4*)(bta + col0 + bj * HALF + n * 16); }
#pragma unroll
        for (int ai = 0; ai < 2; ++ai)
#pragma unroll
            for (int m = 0; m < 4; ++m) { const int r = row0 + ai * HALF + m * 16; const float mu = stats[2 * r], rs = stats[2 * r + 1] * alpha; const size_t off = (size_t)r * ldc + col0;
#pragma unroll
                for (int bj = 0; bj < 2; ++bj)
#pragma unroll
                    for (int n = 0; n < 2; ++n) { float* p = Y + off + bj * HALF + n * 16; const f32x4 yv = *(const f32x4*)p;
                        *(f32x4*)p = (yv - mu) * rs * gv[bj][n] + bv[bj][n] * alpha + acc[ai][bj][m][n]; }
                if (m & 1) asm volatile("" ::: "memory"); }
    }
};

__device__ __forceinline__ void unpack8bf(const u32x4 w, f32x4& lo, f32x4& hi) {
    lo[0] = __builtin_bit_cast(float, w.x << 16); lo[1] = __builtin_bit_cast(float, w.x & 0xffff0000u); lo[2] = __builtin_bit_cast(float, w.y << 16); lo[3] = __builtin_bit_cast(float, w.y & 0xffff0000u);
    hi[0] = __builtin_bit_cast(float, w.z << 16); hi[1] = __builtin_bit_cast(float, w.z & 0xffff0000u); hi[2] = __builtin_bit_cast(float, w.w << 16); hi[3] = __builtin_bit_cast(float, w.w & 0xffff0000u);
}
struct EpiOutB {
    static constexpr bool PERM = true, AFTER_DRAIN = false;
    const float* X; const float* stats; const float* g; const float* bta; bf16_t* Yb; int ldc; float alpha;
    __device__ __forceinline__ void operator()(const f32x4 (&acc)[2][2][4][2], const Unit& u, int wr, int wc, int fr, int fq) const {
        const int row0 = u.pm * BM + wr * 64 + fr, col0 = u.pn * BM + wc * 32 + 8 * fq;
        f32x4 gv[2][2], bv[2][2];
#pragma unroll
        for (int bj = 0; bj < 2; ++bj)
#pragma unroll
            for (int n = 0; n < 2; ++n) { gv[bj][n] = *(const f32x4*)(g + col0 + bj * HALF + n * 4); bv[bj][n] = *(const f32x4*)(bta + col0 + bj * HALF + n * 4) * alpha; }
#pragma unroll
        for (int ai = 0; ai < 2; ++ai)
#pragma unroll
            for (int m = 0; m < 4; ++m) { const int r = row0 + ai * HALF + m * 16; const float mu = stats[2 * r], rs = stats[2 * r + 1] * alpha; const size_t off = (size_t)r * ldc + col0;
#pragma unroll
                for (int bj = 0; bj < 2; ++bj) { const f32x4 x0 = *(const f32x4*)(X + off + bj * HALF), x1 = *(const f32x4*)(X + off + bj * HALF + 4);
                    const f32x4 y0 = (x0 - mu) * rs * gv[bj][0] + bv[bj][0] + acc[ai][bj][m][0], y1 = (x1 - mu) * rs * gv[bj][1] + bv[bj][1] + acc[ai][bj][m][1];
                    *(u32x4*)(Yb + off + bj * HALF) = pack8bf(y0, y1); }
                if (m & 1) asm volatile("" ::: "memory"); }
    }
};
struct EpiOutS {
    static constexpr bool PERM = true, AFTER_DRAIN = false;
    const float* X; const float* stats; const float* g; const float* bta; bf16_t* Yb; int ldc; float alpha; float* rpart;
    __device__ __forceinline__ void operator()(const f32x4 (&acc)[2][2][4][2], const Unit& u, int wr, int wc, int fr, int fq) const {
        const int row0 = u.pm * BM + wr * 64 + fr, col0 = u.pn * BM + wc * 32 + 8 * fq, lane = fq * 16 + fr;
        f32x4 gv[2][2], bv[2][2];
#pragma unroll
        for (int bj = 0; bj < 2; ++bj)
#pragma unroll
            for (int n = 0; n < 2; ++n) { gv[bj][n] = *(const f32x4*)(g + col0 + bj * HALF + n * 4); bv[bj][n] = *(const f32x4*)(bta + col0 + bj * HALF + n * 4) * alpha; }
#pragma unroll
        for (int ai = 0; ai < 2; ++ai)
#pragma unroll
            for (int m = 0; m < 4; ++m) { const int r = row0 + ai * HALF + m * 16; const float mu = stats[2 * r], rs = stats[2 * r + 1] * alpha; const size_t off = (size_t)r * ldc + col0;
                float s1 = 0.f, s2 = 0.f;
#pragma unroll
                for (int bj = 0; bj < 2; ++bj) { const f32x4 x0 = *(const f32x4*)(X + off + bj * HALF), x1 = *(const f32x4*)(X + off + bj * HALF + 4);
                    const f32x4 y0 = (x0 - mu) * rs * gv[bj][0] + bv[bj][0] + acc[ai][bj][m][0], y1 = (x1 - mu) * rs * gv[bj][1] + bv[bj][1] + acc[ai][bj][m][1];
                    s1 += ((y0[0] + y0[1]) + (y0[2] + y0[3])) + ((y1[0] + y1[1]) + (y1[2] + y1[3]));
                    s2 += ((y0[0] * y0[0] + y0[1] * y0[1]) + (y0[2] * y0[2] + y0[3] * y0[3])) + ((y1[0] * y1[0] + y1[1] * y1[1]) + (y1[2] * y1[2] + y1[3] * y1[3]));
                    *(u32x4*)(Yb + off + bj * HALF) = pack8bf(y0, y1); }
#pragma unroll
                for (int x = 16; x < 64; x <<= 1) { s1 += __builtin_bit_cast(float, __builtin_amdgcn_ds_bpermute((lane ^ x) << 2, __builtin_bit_cast(int, s1))); s2 += __builtin_bit_cast(float, __builtin_amdgcn_ds_bpermute((lane ^ x) << 2, __builtin_bit_cast(int, s2))); }
                if (fq == 0) { typedef float f32x2v __attribute__((ext_vector_type(2))); *(f32x2v*)(rpart + ((size_t)r * 64 + u.pn * 4 + wc) * 2) = (f32x2v){s1, s2}; }
                if (m & 1) asm volatile("" ::: "memory"); }
    }
};
struct EpiUpS {
    static constexpr bool PERM = true, AFTER_DRAIN = false;
    bf16_t* O; int ldc; const float* ucol; const float* ccol; const PG8_LAS float* st;
    __device__ __forceinline__ void operator()(const f32x4 (&acc)[2][2][4][2], const Unit& u, int wr, int wc, int fr, int fq) const {
        typedef float f32x2v __attribute__((ext_vector_type(2)));
        const int rl0 = wr * 64 + fr, row0 = u.pm * BM + rl0, col0 = u.pn * BM + wc * 32 + 8 * fq;
        f32x4 uv[2][2], cv[2][2];
#pragma unroll
        for (int bj = 0; bj < 2; ++bj)
#pragma unroll
            for (int n = 0; n < 2; ++n) { uv[bj][n] = *(const f32x4*)(ucol + col0 + bj * HALF + n * 4); cv[bj][n] = *(const f32x4*)(ccol + col0 + bj * HALF + n * 4); }
#pragma unroll
        for (int ai = 0; ai < 2; ++ai)
#pragma unroll
            for (int m = 0; m < 4; ++m) { bf16_t* rowp = O + (size_t)(row0 + ai * HALF + m * 16) * ldc + col0; const f32x2v sr = *(const PG8_LAS f32x2v*)(st + 2 * (rl0 + ai * HALF + m * 16));
#pragma unroll
                for (int bj = 0; bj < 2; ++bj) { f32x4 v0 = (acc[ai][bj][m][0] - sr.x * uv[bj][0]) * sr.y + cv[bj][0], v1 = (acc[ai][bj][m][1] - sr.x * uv[bj][1]) * sr.y + cv[bj][1];
#pragma unroll
                    for (int e = 0; e < 4; ++e) { const float a = fmaxf(v0[e], 0.f), c = fmaxf(v1[e], 0.f); v0[e] = a * a; v1[e] = c * c; }
                    *(u32x4*)(rowp + bj * HALF) = pack8bf(v0, v1); } }
    }
};
struct EpiDownB {
    static constexpr bool PERM = true, AFTER_DRAIN = false;
    const bf16_t* Y1b; bf16_t* Y2b; const float* stats; const float* g; const float* bta; int ldc; float alpha; int ldy;
    __device__ __forceinline__ void operator()(const f32x4 (&acc)[2][2][4][2], const Unit& u, int wr, int wc, int fr, int fq) const {
        const int row0 = u.pm * BM + wr * 64 + fr, col0 = u.pn * BM + wc * 32 + 8 * fq;
        f32x4 gv[2][2], bv[2][2];
#pragma unroll
        for (int bj = 0; bj < 2; ++bj)
#pragma unroll
            for (int n = 0; n < 2; ++n) { gv[bj][n] = *(const f32x4*)(g + col0 + bj * HALF + n * 4); bv[bj][n] = *(const f32x4*)(bta + col0 + bj * HALF + n * 4) * alpha; }
#pragma unroll
        for (int ai = 0; ai < 2; ++ai)
#pragma unroll
            for (int m = 0; m < 4; ++m) { const int r = row0 + ai * HALF + m * 16; const float mu = stats[2 * r], rs = stats[2 * r + 1] * alpha; const size_t off = (size_t)r * ldc + col0;
#pragma unroll
                for (int bj = 0; bj < 2; ++bj) { f32x4 x0, x1; unpack8bf(*(const u32x4*)(Y1b + off + bj * HALF), x0, x1);
                    const f32x4 y0 = (x0 - mu) * rs * gv[bj][0] + bv[bj][0] + acc[ai][bj][m][0], y1 = (x1 - mu) * rs * gv[bj][1] + bv[bj][1] + acc[ai][bj][m][1];
                    *(u32x4*)(Y2b + (size_t)r * ldy + col0 + bj * HALF) = pack8bf(y0, y1); }
                if (m & 1) asm volatile("" ::: "memory"); }
    }
};

template <class Epi, class Sched, bool ALIGN_EPI = false, bool SP2 = false>
__device__ __forceinline__ void gemm_phase(PG8_LAS unsigned char* lds, const Gemm g, const Sched& S, const Epi& E, const int wv  ) {
    const int lane = mk_lane_id(), wid = wv, tid = wv * 64 + lane, wr = wid >> 2, wc = wid & 3, fr = lane & 15, fq = lane >> 4;
    const int K = g.K, nt = K / BK;
    unsigned voffA[2], voffB[2];
#pragma unroll
    for (int i = 0; i < 2; ++i) { int R, C; stage_rc(tid * 16 + i * 8192, R, C); const int Rb = Epi::PERM ? ((R & ~31) + perm32(R & 31)) : R;
        voffA[i] = (unsigned)(R * K + C) * 2u; voffB[i] = (unsigned)(Rb * K + C) * 2u; }
    const size_t kstep = (size_t)(BK * 2);
    const size_t hstep = (size_t)HALF * K * 2;
    const size_t tstep = 2 * hstep;
    const unsigned ldsw = (unsigned)wid * 1024u;
    const int aoff = lds_byte(wr * 64 + fr, fq * 8), boff = lds_byte(wc * 32 + fr, fq * 8);
#define PG8_SA(b, h) (((b) * 2 + (h)) * HTB)
#define PG8_SB(b, h) ((4 + (b) * 2 + (h)) * HTB)
#define PG8_STAGE(bufoff, gbase, voff) do { _Pragma("unroll") for (int _i = 0; _i < 2; ++_i) \
        __builtin_amdgcn_global_load_lds((const unsigned*)((const char*)(gbase) + (voff)[_i]), (PG8_LAS unsigned*)(lds + (bufoff) + ldsw + _i * 8192), 16, 0, 0); } while (0)
#define PG8_LDA(dst, b, h) do { _Pragma("unroll") for (int m = 0; m < 4; ++m) _Pragma("unroll") for (int k = 0; k < 2; ++k) dst[m][k] = *(const PG8_LAS bf16x8*)(lds + PG8_SA(b, h) + aoff + m * 2048 + k * 1024); } while (0)
#define PG8_LDB(dst, b, h) do { _Pragma("unroll") for (int n = 0; n < 2; ++n) _Pragma("unroll") for (int k = 0; k < 2; ++k) dst[n][k] = *(const PG8_LAS bf16x8*)(lds + PG8_SB(b, h) + boff + n * 2048 + k * 1024); } while (0)
#define PG8_MMA(ai, bj, At, Bt) do { __builtin_amdgcn_s_setprio(1); _Pragma("unroll") for (int m = 0; m < 4; ++m) _Pragma("unroll") for (int n = 0; n < 2; ++n) _Pragma("unroll") for (int k = 0; k < 2; ++k) \
        acc[ai][bj][m][n] = __builtin_amdgcn_mfma_f32_16x16x32_bf16(Bt[n][k], At[m][k], acc[ai][bj][m][n], 0, 0, 0); __builtin_amdgcn_s_setprio(0); } while (0)
#define PG8_WAIT_V(n) asm volatile("s_waitcnt vmcnt(" #n ")" ::: "memory")
#define PG8_WAIT_L(n) asm volatile("s_waitcnt lgkmcnt(" #n ")" ::: "memory")
#define PG8_BAR __builtin_amdgcn_s_barrier()
#define PG8_SCHED __builtin_amdgcn_sched_barrier(0)
    Unit cur, nxt; int ui = 0;
#if defined(PROBE_EPI)
    unsigned long long pe_acc = 0ull;
#endif
    if (!S.next(0, cur)) return;
    f32x4 acc[2][2][4][2];
#pragma unroll
    for (int a = 0; a < 2; ++a)
#pragma unroll
        for (int b = 0; b < 2; ++b)
#pragma unroll
            for (int m = 0; m < 4; ++m)
#pragma unroll
                for (int n = 0; n < 2; ++n) acc[a][b][m][n] = (f32x4){0.f, 0.f, 0.f, 0.f};
    bf16x8 At[4][2], B0[2][2], B1[2][2];
    const char* cA = (const char*)g.A + (((size_t)cur.pm * tstep) << g.ashift); const char* cB = (const char*)g.Bt + (size_t)cur.pn * tstep;
    S.a_ready(cur);
    if constexpr (SP2) {
        PG8_STAGE(PG8_SB(0, 0), cB, voffB); PG8_STAGE(PG8_SB(0, 1), cB + hstep, voffB); PG8_STAGE(PG8_SA(0, 0), cA, voffA); PG8_STAGE(PG8_SA(0, 1), cA + hstep, voffA);
        if (wr == 1) PG8_BAR;
        PG8_WAIT_V(2); PG8_BAR;
        PG8_STAGE(PG8_SB(1, 0), cB + kstep, voffB); PG8_STAGE(PG8_SA(1, 0), cA + kstep, voffA); PG8_STAGE(PG8_SB(1, 1), cB + hstep + kstep, voffB);
        PG8_WAIT_V(6); PG8_BAR;
    } else {
        PG8_STAGE(PG8_SB(0, 0), cB, voffB); PG8_STAGE(PG8_SA(0, 0), cA, voffA); PG8_STAGE(PG8_SB(0, 1), cB + hstep, voffB); PG8_STAGE(PG8_SA(0, 1), cA + hstep, voffA);
        if (wr == 1) PG8_BAR;
        PG8_WAIT_V(4); PG8_BAR;
        PG8_STAGE(PG8_SB(1, 0), cB + kstep, voffB); PG8_STAGE(PG8_SA(1, 0), cA + kstep, voffA); PG8_STAGE(PG8_SB(1, 1), cB + hstep + kstep, voffB);
        PG8_WAIT_V(6); PG8_BAR;
    }
    for (;;) {
        const bool has_next = S.next(ui + 1, nxt);
        const char* nA = has_next ? (const char*)g.A + (((size_t)nxt.pm * tstep) << g.ashift) : cA; const char* nB = has_next ? (const char*)g.Bt + (size_t)nxt.pn * tstep : cB;
        for (int t = 0; t < nt; t += 2) {
            const bool last = (t == nt - 2);
            const char* a1 = cA + (size_t)(t + 1) * kstep;
            const char* a2 = last ? nA : cA + (size_t)(t + 2) * kstep; const char* b2 = last ? nB : cB + (size_t)(t + 2) * kstep;
            const char* a3 = a2 + kstep; const char* b3 = b2 + kstep;
            if (last && has_next) S.a_ready(nxt);
            if constexpr (SP2) {
            PG8_LDB(B0, 0, 0); PG8_LDB(B1, 0, 1); PG8_SCHED; PG8_LDA(At, 0, 0); PG8_STAGE(PG8_SA(1, 1), a1 + hstep, voffA);
            PG8_WAIT_V(8); PG8_WAIT_L(0); PG8_BAR; PG8_MMA(0, 0, At, B0); PG8_MMA(0, 1, At, B1); PG8_BAR; PG8_SCHED;
            PG8_LDA(At, 0, 1); PG8_STAGE(PG8_SB(0, 0), b2, voffB); PG8_STAGE(PG8_SB(0, 1), b2 + hstep, voffB); PG8_STAGE(PG8_SA(0, 0), a2, voffA);
            PG8_WAIT_V(8); PG8_WAIT_L(0); PG8_BAR; PG8_MMA(1, 0, At, B0); PG8_MMA(1, 1, At, B1); PG8_BAR; PG8_SCHED;
            PG8_LDB(B0, 1, 0); PG8_LDB(B1, 1, 1); PG8_SCHED; PG8_LDA(At, 1, 0); PG8_STAGE(PG8_SA(0, 1), a2 + hstep, voffA);
            PG8_WAIT_V(8); PG8_WAIT_L(0); PG8_BAR; PG8_MMA(0, 0, At, B0); PG8_MMA(0, 1, At, B1); PG8_BAR; PG8_SCHED;
            PG8_LDA(At, 1, 1); PG8_STAGE(PG8_SB(1, 0), b3, voffB); PG8_STAGE(PG8_SB(1, 1), b3 + hstep, voffB); PG8_STAGE(PG8_SA(1, 0), a3, voffA);
            PG8_WAIT_V(8); PG8_WAIT_L(0); PG8_BAR; PG8_MMA(1, 0, At, B0); PG8_MMA(1, 1, At, B1); PG8_BAR; PG8_SCHED;
            } else {
            PG8_LDB(B0, 0, 0); PG8_SCHED; PG8_LDA(At, 0, 0); PG8_STAGE(PG8_SA(1, 1), a1 + hstep, voffA);
            PG8_WAIT_L(8); PG8_BAR; PG8_WAIT_L(0); PG8_MMA(0, 0, At, B0); PG8_BAR; PG8_SCHED;
            PG8_LDB(B1, 0, 1); PG8_STAGE(PG8_SB(0, 0), b2, voffB);
            PG8_BAR; PG8_WAIT_L(0); PG8_MMA(0, 1, At, B1); PG8_BAR;
            PG8_LDA(At, 0, 1); PG8_STAGE(PG8_SA(0, 0), a2, voffA);
            PG8_BAR; PG8_WAIT_L(0); PG8_MMA(1, 0, At, B0); PG8_BAR; PG8_SCHED;
            PG8_STAGE(PG8_SB(0, 1), b2 + hstep, voffB);
            PG8_WAIT_V(6); PG8_BAR; PG8_MMA(1, 1, At, B1); PG8_BAR;
            PG8_LDB(B0, 1, 0); PG8_SCHED; PG8_LDA(At, 1, 0); PG8_STAGE(PG8_SA(0, 1), a2 + hstep, voffA);
            PG8_WAIT_L(8); PG8_BAR; PG8_WAIT_L(0); PG8_MMA(0, 0, At, B0); PG8_BAR; PG8_SCHED;
            PG8_LDB(B1, 1, 1); PG8_STAGE(PG8_SB(1, 0), b3, voffB);
            PG8_BAR; PG8_WAIT_L(0); PG8_MMA(0, 1, At, B1); PG8_BAR;
            PG8_LDA(At, 1, 1); PG8_STAGE(PG8_SA(1, 0), a3, voffA);
            PG8_BAR; PG8_WAIT_L(0); PG8_MMA(1, 0, At, B0); PG8_BAR; PG8_SCHED;
            PG8_STAGE(PG8_SB(1, 1), b3 + hstep, voffB);
            PG8_WAIT_V(6); PG8_BAR; PG8_MMA(1, 1, At, B1); PG8_BAR;
            }
        }
        if constexpr (ALIGN_EPI) { if (wr == 0) PG8_BAR; }
#if defined(PROBE_EPI)
        { const unsigned long long pe0_ = __builtin_amdgcn_s_memrealtime(); if constexpr (!Epi::AFTER_DRAIN) { E(acc, cur, wr, wc, fr, fq); S.done(cur); } pe_acc += __builtin_amdgcn_s_memrealtime() - pe0_; }
#else
        if constexpr (!Epi::AFTER_DRAIN) { E(acc, cur, wr, wc, fr, fq); S.done(cur); }
#endif
        if (!has_next) break;
#pragma unroll
        for (int a = 0; a < 2; ++a)
#pragma unroll
            for (int b = 0; b < 2; ++b)
#pragma unroll
                for (int m = 0; m < 4; ++m)
#pragma unroll
                    for (int n = 0; n < 2; ++n) acc[a][b][m][n] = (f32x4){0.f, 0.f, 0.f, 0.f};
        cur = nxt; cA = nA; cB = nB; ++ui;
        if constexpr (ALIGN_EPI) { if (wr == 1) PG8_BAR; }
    }
    PG8_WAIT_V(0);
    if constexpr (!ALIGN_EPI) { if (wr == 0) PG8_BAR; }
    PG8_BAR;
    if constexpr (Epi::AFTER_DRAIN) { E.fused(acc, cur, wr, wc, fr, fq, lds, wid, lane); S.done(cur); }
#if defined(PROBE_EPI)
    if (blockIdx.x == 0 && tid == 0) *(volatile PG8_LAS unsigned long long*)(lds + 131072 + 1024 + 8 * 16) = pe_acc;
#endif
#undef PG8_SA
#undef PG8_SB
#undef PG8_STAGE
#undef PG8_LDA
#undef PG8_LDB
#undef PG8_MMA
#undef PG8_WAIT_V
#undef PG8_WAIT_L
#undef PG8_BAR
#undef PG8_SCHED
}
}

#ifndef PG8_SP2
#define PG8_SP2 true
#endif
#ifndef PG8_ALIGN
#define PG8_ALIGN true
#endif
#include <hip/hip_bf16.h>
namespace att {
__device__ __forceinline__ int fresh_lane() { int l; asm volatile("v_mbcnt_lo_u32_b32 %0, -1, 0\n\tv_mbcnt_hi_u32_b32 %0, -1, %0" : "=v"(l)); return l; }
__device__ __forceinline__ int fresh_tid(int wv) { return wv * 64 + fresh_lane(); }
constexpr int D = 128;
constexpr float THR = 8.f;
constexpr bool WSKIP = false;
constexpr float SCALE = 0.08838834764831845f;
constexpr float RSCALE = 11.313708498984761f;
constexpr int NW = 8, QBLK = 32, KVBLK = 64, QB = NW * QBLK;
constexpr int SHM_V = KVBLK * D * 2, SHM_K = KVBLK * D * 2;
constexpr int LDS_BIAS = 2 * SHM_V + 2 * SHM_K + NW * 64 * 4;
constexpr int LDS_OST = LDS_BIAS + 2 * 64 * 4;
constexpr int LDS_BYTES = LDS_OST + NW * 4096;

using bf16 = __hip_bfloat16;
typedef short bf16x8 __attribute__((ext_vector_type(8)));
typedef short s16x4 __attribute__((ext_vector_type(4)));
typedef float f32x16 __attribute__((ext_vector_type(16)));
typedef float f32x4 __attribute__((ext_vector_type(4)));
typedef unsigned u32x4 __attribute__((ext_vector_type(4)));
template <class A, class Bt> struct same_t { static constexpr bool v = false; };
template <class A> struct same_t<A, A> { static constexpr bool v = true; };

#define KSWZ(row, colB) ((row) * 256 + ((colB) ^ (((row) & 7) << 4)))
#define SBAR() __builtin_amdgcn_sched_barrier(0)
__device__ __forceinline__ int v_st(int k, int c) { const int kk = (k & ~0xC) | ((k & 4) << 1) | ((k & 8) >> 1); return ((kk >> 3) * 4 + (c >> 5)) * 512 + ((kk & 7) * 32 + (c & 31)) * 2; }
__device__ __forceinline__ int v_rd_base(int lane) { return ((lane & 3) << 3) | (((lane >> 2) & 3) << 6) | (((lane >> 4) & 1) << 5) | (((lane >> 5) & 1) << 8); }
constexpr int v_rd_off(int d0, int ks, int half) { return d0 * 512 + ks * 4096 + half * 2048; }
__device__ __forceinline__ int crow(int r, int hi) { return (r & 3) + 8 * (r >> 2) + 4 * hi; }
__device__ __forceinline__ unsigned cvtpk(float lo, float hi) {
    unsigned r; asm volatile("v_cvt_pk_bf16_f32 %0, %1, %2" : "=v"(r) : "v"(lo), "v"(hi)); return r;
}
__device__ __forceinline__ bf16x8 pack8(f32x4 a, f32x4 b) {
    u32x4 w = {cvtpk(a[0], a[1]), cvtpk(a[2], a[3]), cvtpk(b[0], b[1]), cvtpk(b[2], b[3])};
    return *reinterpret_cast<bf16x8*>(&w);
}
template <class T> __device__ __forceinline__ bf16x8 load8(const T* p) {
    if constexpr (same_t<T, float>::v) { return pack8(*(const f32x4*)p, *(const f32x4*)(p + 4)); }
    else { return *reinterpret_cast<const bf16x8*>(p); }
}
__device__ __forceinline__ void mask_tile(f32x16& p0, f32x16& p1, int dq, unsigned W) {
    const float NEG = -__builtin_inff();
#pragma unroll
    for (int r = 0; r < 16; ++r) {
        const int c = (r & 3) + 8 * (r >> 2);
        if ((unsigned)(dq - c) >= W) p0[r] = NEG;
        if ((unsigned)(dq - c - 32) >= W) p1[r] = NEG;
    }
}
__device__ __forceinline__ void partialSM(f32x16& p0, f32x16& p1, float& m_reg, float& mn, float& alpha) {
    float pmax = p0[0]; for (int r = 1; r < 16; ++r) pmax = fmaxf(pmax, p0[r]); for (int r = 0; r < 16; ++r) pmax = fmaxf(pmax, p1[r]);
    { auto rr = __builtin_amdgcn_permlane32_swap(__float_as_uint(pmax), __float_as_uint(pmax), false, false);
      pmax = fmaxf(__uint_as_float(rr[0]), __uint_as_float(rr[1])); }
    constexpr float C2 = 1.4426950408889634f * SCALE;
    if (__builtin_expect(__all((pmax - m_reg) * SCALE <= THR), 1)) { mn = m_reg; alpha = 1.f; }
    else { mn = fmaxf(m_reg, pmax); alpha = __builtin_amdgcn_exp2f((m_reg - mn) * C2); m_reg = mn; }
    const float mnL = -mn * C2;
    for (int r = 0; r < 16; ++r) p0[r] = fmaf(p0[r], C2, mnL); for (int r = 0; r < 16; ++r) p1[r] = fmaf(p1[r], C2, mnL);
    for (int r = 0; r < 16; ++r) p0[r] = __builtin_amdgcn_exp2f(p0[r]);
}
__device__ __forceinline__ void finishSM(f32x16& p0, f32x16& p1, float alpha, float& l_reg, bf16x8& pa0, bf16x8& pa1, bf16x8& pa2, bf16x8& pa3) {
    for (int r = 0; r < 16; ++r) p1[r] = __builtin_amdgcn_exp2f(p1[r]);
    float ps = 0; for (int r = 0; r < 16; ++r) ps += p0[r]; for (int r = 0; r < 16; ++r) ps += p1[r];
    { auto rr = __builtin_amdgcn_permlane32_swap(__float_as_uint(ps), __float_as_uint(ps), false, false);
      ps = __uint_as_float(rr[0]) + __uint_as_float(rr[1]); }
    l_reg = l_reg * alpha + ps;
#define PK4(P, B_, OUT) do { unsigned a0 = cvtpk(P[B_+0], P[B_+1]), a1 = cvtpk(P[B_+2], P[B_+3]);                          \
        unsigned b0 = cvtpk(P[B_+4], P[B_+5]), b1 = cvtpk(P[B_+6], P[B_+7]);                                             \
        auto r0 = __builtin_amdgcn_permlane32_swap(a0, b0, false, false); auto r1 = __builtin_amdgcn_permlane32_swap(a1, b1, false, false); \
        u32x4 w = {r0[0], r1[0], r0[1], r1[1]}; OUT = *reinterpret_cast<bf16x8*>(&w); } while (0)
    PK4(p0, 0, pa0); PK4(p0, 8, pa1); PK4(p1, 0, pa2); PK4(p1, 8, pa3);
#undef PK4
}
template <int KB, bool SK>
__device__ __forceinline__ void qkt(f32x16& p0, f32x16& p1, const char* K_lds, int r32, int hi, const bf16x8* qr, bool act) {
    if (SK && !act) { const float NEG = -__builtin_inff();
#pragma unroll
        for (int r = 0; r < 16; ++r) { p0[r] = NEG; p1[r] = NEG; } return; }
    p0 = f32x16{}; p1 = f32x16{};
    const char* kb[4];
#pragma unroll
    for (int dd = 0; dd < 4; ++dd) kb[dd] = K_lds + KB * SHM_K + KSWZ(r32, (dd * 16 + hi * 8) * 2);
#pragma unroll
    for (int d0 = 0; d0 < 8; ++d0) { const char* a = kb[d0 & 3] + (d0 >> 2) * 128;
        bf16x8 b0 = *reinterpret_cast<const bf16x8*>(a);
        bf16x8 b1 = *reinterpret_cast<const bf16x8*>(a + 32 * 256);
        p0 = __builtin_amdgcn_mfma_f32_32x32x16_bf16(b0, qr[d0], p0, 0, 0, 0);
        p1 = __builtin_amdgcn_mfma_f32_32x32x16_bf16(b1, qr[d0], p1, 0, 0, 0); }
}
template <int VB, bool SK>
__device__ __forceinline__ void pv_tile(f32x16* o, int vb0, bf16x8 pa0, bf16x8 pa1, bf16x8 pa2, bf16x8 pa3, bool act) {
    if (SK && !act) return;
#define TRRD(dst, off) asm volatile("ds_read_b64_tr_b16 %0, %1 offset:%2" : "=&v"(dst) : "v"(vb0), "i"(off) : "memory")
#define PV_D0(d0) do { s16x4 l0, l1, l2, l3, h0, h1, h2, h3; constexpr int b_ = VB * SHM_V + v_rd_off(d0, 0, 0);     \
        TRRD(l0, b_); TRRD(h0, b_ + 2048); TRRD(l1, b_ + 4096); TRRD(h1, b_ + 6144); TRRD(l2, b_ + 8192); TRRD(h2, b_ + 10240); TRRD(l3, b_ + 12288); TRRD(h3, b_ + 14336); \
        asm volatile("s_waitcnt lgkmcnt(0)" ::: "memory"); SBAR();                 \
        o[d0] = __builtin_amdgcn_mfma_f32_32x32x16_bf16(pa0, (bf16x8){l0[0], l0[1], l0[2], l0[3], h0[0], h0[1], h0[2], h0[3]}, o[d0], 0, 0, 0);   \
        o[d0] = __builtin_amdgcn_mfma_f32_32x32x16_bf16(pa1, (bf16x8){l1[0], l1[1], l1[2], l1[3], h1[0], h1[1], h1[2], h1[3]}, o[d0], 0, 0, 0);   \
        o[d0] = __builtin_amdgcn_mfma_f32_32x32x16_bf16(pa2, (bf16x8){l2[0], l2[1], l2[2], l2[3], h2[0], h2[1], h2[2], h2[3]}, o[d0], 0, 0, 0);   \
        o[d0] = __builtin_amdgcn_mfma_f32_32x32x16_bf16(pa3, (bf16x8){l3[0], l3[1], l3[2], l3[3], h3[0], h3[1], h3[2], h3[3]}, o[d0], 0, 0, 0); } while (0)
    PV_D0(0); PV_D0(1); PV_D0(2); PV_D0(3);
#undef PV_D0
#undef TRRD
}


template <int NB>
__device__ __forceinline__ void o_rows_store(const f32x16* o, const float (&rl)[16], char* stg, bf16* Ow, const int ldo, const int col0, const int r32, const int hi, const int lane) {
    constexpr int PITCH = NB * 64, CPR = PITCH / 16;
#pragma unroll
    for (int r = 0; r < 16; ++r) { char* rp = stg + crow(r, hi) * PITCH + r32 * 2;
#pragma unroll
        for (int b = 0; b < NB; ++b) { const float v = o[b][r] * rl[r]; *(unsigned short*)(rp + b * 64) = (unsigned short)cvtpk(v, v); } }
    asm volatile("s_waitcnt lgkmcnt(0)" ::: "memory");
#pragma unroll
    for (int k = 0; k < 2 * NB; ++k) { const int c = lane + 64 * k, row = c / CPR, ch = c % CPR;
        const u32x4 w = *(const u32x4*)(stg + c * 16);
        *(u32x4*)(Ow + (size_t)row * ldo + col0 + ch * 8) = w; }
}
template <class TIn, class TOut> struct BlockRef { unsigned qoff, koff, voff, ooff, coff; int P0; int ldo; int boff; int jlo; };
template <class TIn, class TOut> struct Bases { const TIn* qkv; TOut* o; const float* c; };
template <class TIn> struct Seam {
    bf16x8 qr[8];
    bf16x8 st_v0, st_v1, st_k0, st_k1; f32x4 sf0, sf1, sf2, sf3;
    f32x4 tq[16];
    float st_b;
};
__device__ __forceinline__ int swa_jlo(int P0, int W) { const int lowk = P0 - W + 1; return lowk > 0 ? lowk / KVBLK : 0; }
#define ROW(p, k0, rr) ((p) + (size_t)((k0) + (rr)) * D + sc)
#define VMW() asm volatile("s_waitcnt vmcnt(0)" ::: "memory")
#define VMWN(n) asm volatile("s_waitcnt vmcnt(%0)" :: "i"(n) : "memory")
#define SLOAD_H(Kp, Vp, Cp, k0) do { S.st_v0 = load8<TIn>(ROW(Vp, k0, sr)); S.st_v1 = load8<TIn>(ROW(Vp, k0, 32 + sr));              \
                         S.st_k0 = load8<TIn>(ROW(Kp, k0, sr)); S.st_k1 = load8<TIn>(ROW(Kp, k0, 32 + sr));                       \
                         if constexpr (MODE == 1) { if (tid < 64) S.st_b = (Cp)[(k0) + tid]; } } while (0)
#define SWRITE_HK(bf, cref) do { *(bf16x8*)(K_lds + (bf) * SHM_K + kws) = S.st_k0; *(bf16x8*)(K_lds + (bf) * SHM_K + kws + 32 * 256) = S.st_k1; \
                         if constexpr (MODE == 1) { if (tid < 64) bias_l[(bf) * 64 + tid] = ((cref) - S.st_b) * RSCALE; } } while (0)
#define SWRITE_HV(bf) do { *(bf16x8*)(V_lds + (bf) * SHM_V + vst0) = S.st_v0; *(bf16x8*)(V_lds + (bf) * SHM_V + vst1) = S.st_v1; } while (0)
#define SWRITE_H(bf, cref) do { SWRITE_HV(bf); SWRITE_HK(bf, cref); } while (0)
#define BIASADD(P0_, P1_, kb) do { if constexpr (MODE == 1) { const float* bp_ = bias_l + (kb) * 64 + 4 * hi;                    \
        _Pragma("unroll") for (int g_ = 0; g_ < 4; ++g_) { const f32x4 b0_ = *(const f32x4*)(bp_ + 8 * g_), b1_ = *(const f32x4*)(bp_ + 32 + 8 * g_); \
            _Pragma("unroll") for (int e_ = 0; e_ < 4; ++e_) { P0_[4 * g_ + e_] += b0_[e_]; P1_[4 * g_ + e_] += b1_[e_]; } } } } while (0)
#define PADMASK(P0_, P1_) do { const float NEG_ = -__builtin_inff(); _Pragma("unroll") for (int r_ = 0; r_ < 16; ++r_) { if (r_ >= 8) P0_[r_] = NEG_; P1_[r_] = NEG_; } } while (0)
#define SLOAD_F(p, k0) do { S.sf0 = *(const f32x4*)ROW(p, k0, sr); S.sf1 = *(const f32x4*)(ROW(p, k0, sr) + 4);                \
                            S.sf2 = *(const f32x4*)ROW(p, k0, 32 + sr); S.sf3 = *(const f32x4*)(ROW(p, k0, 32 + sr) + 4); } while (0)
#define SWRITE_KF(bf) do { *(bf16x8*)(K_lds + (bf) * SHM_K + kws) = pack8(S.sf0, S.sf1); *(bf16x8*)(K_lds + (bf) * SHM_K + kws + 32 * 256) = pack8(S.sf2, S.sf3); } while (0)
#define SWRITE_VF(bf) do { *(bf16x8*)(V_lds + (bf) * SHM_V + vst0) = pack8(S.sf0, S.sf1); *(bf16x8*)(V_lds + (bf) * SHM_V + vst1) = pack8(S.sf2, S.sf3); } while (0)
template <class TIn, class TOut, int MODE  , class Ref>
__device__ __forceinline__ void causal_swa_prime(const Ref& cur, const Bases<TIn, TOut>& B, int W, char* lds, Seam<TIn>& S, const int wv) {
    constexpr bool F32 = same_t<TIn, float>::v;
    const int tid = fresh_tid(wv), wid = wv, lane = tid & 63, r32 = lane & 31, hi = lane >> 5;
    const int sr = tid >> 4, sc = (tid & 15) * 8, kws = KSWZ(sr, sc * 2); char* K_lds = lds + 2 * SHM_V; float* bias_l = (float*)(lds + LDS_BIAS);
    float cref_cur = 0.f; if constexpr (MODE == 1) cref_cur = __uint_as_float(__builtin_amdgcn_readfirstlane(__float_as_uint(((const float*)(lds + cur.boff()))[(cur.P0() - 64) >> 7] + (B.c + cur.coff())[cur.P0()])));
    const int kb0 = cur.jlo() * KVBLK;
    if constexpr (MODE == 1) { if (kb0 >= 64) cref_cur -= __uint_as_float(__builtin_amdgcn_readfirstlane(__float_as_uint(((const float*)(lds + cur.boff()))[(kb0 - 64) >> 7]))); }
    for (int d0 = 0; d0 < 8; ++d0) S.qr[d0] = load8<TIn>(B.qkv + cur.qoff() + (size_t)(wid * QBLK + r32) * D + d0 * 16 + hi * 8);
    if constexpr (F32) { SLOAD_F((const float*)(B.qkv + cur.koff()), kb0); VMW(); SWRITE_KF(0); SBAR(); SLOAD_F((const float*)(B.qkv + cur.voff()), kb0); }
    else { SLOAD_H(B.qkv + cur.koff(), B.qkv + cur.voff(), B.c + cur.coff(), kb0); VMW(); SWRITE_HK(0, cref_cur); }
    __syncthreads();
}
template <class TIn, class TOut, int MODE, class Ref, class NxtFn>
__device__ __forceinline__ void causal_swa_block(const Ref& cur, NxtFn& nxtfn, const Bases<TIn, TOut>& B, int skv, int W, char* lds, Seam<TIn>& S, const int wv) {
    constexpr bool F32 = same_t<TIn, float>::v;
    const int tid = fresh_tid(wv), wid = wv, lane = tid & 63, r32 = lane & 31, hi = lane >> 5;
    const int j_lo = cur.jlo();
    int j_hi = (cur.P0() + QB - 1) / KVBLK + 1; if (j_hi > skv / KVBLK) j_hi = skv / KVBLK;
    const int NT = j_hi - j_lo;
    const int qlo_r = cur.P0() + wid * QBLK, qlo = (MODE == 0) ? (qlo_r | 63) : qlo_r, qm = (MODE == 0) ? (qlo - 4 * hi) : (qlo_r + r32 - 4 * hi);
    char* V_lds = lds; char* K_lds = lds + 2 * SHM_V; float* bias_l = (float*)(lds + LDS_BIAS);
    const float* base_l = (const float*)(lds + cur.boff());
    float cref_cur = 0.f; if constexpr (MODE == 1) { cref_cur = __uint_as_float(__builtin_amdgcn_readfirstlane(__float_as_uint(base_l[(cur.P0() - 64) >> 7] + (B.c + cur.coff())[cur.P0()]))); }
    const float* Ch = B.c + cur.coff();
#define CADJ(k0) ((MODE == 1) ? (cref_cur - (((k0) >= 64) ? __uint_as_float(__builtin_amdgcn_readfirstlane(__float_as_uint(base_l[((k0) - 64) >> 7]))) : 0.f)) : 0.f)
    float* ws = (float*)(lds + 2 * SHM_V + 2 * SHM_K) + wid * 64; float* li_l = ws, * al_l = ws + 32;
    float m_reg = -1e30f, l_reg = 0; f32x16 o[4] = {};
    const int sr = tid >> 4, sc = (tid & 15) * 8, vst0 = v_st(sr, sc), vst1 = v_st(32 + sr, sc), kws = KSWZ(sr, sc * 2);
    const int vb0 = (int)(uintptr_t)V_lds + v_rd_base(lane);
    const TIn* Kh = B.qkv + cur.koff(); const TIn* Vh = B.qkv + cur.voff();
#define RESC(a) do { if (__any((a) < 1.f)) { if (hi == 0) al_l[r32] = (a); asm volatile("s_waitcnt lgkmcnt(0)" ::: "memory");              \
                     for (int d_ = 0; d_ < 4; ++d_) for (int r = 0; r < 16; ++r) o[d_][r] *= al_l[crow(r, hi)]; } } while (0)
#define KBASE(t) ((j_lo + (t)) * KVBLK)
#define ACT(t) (KBASE(t) <= qlo + QBLK - 1 && KBASE(t) + KVBLK - 1 >= qlo - W + 1)
#define MASKT(P0_, P1_, t) do { const int kb_ = KBASE(t); if ((!SK || ACT(t)) && (kb_ + KVBLK - 1 > qlo || kb_ <= qlo + QBLK - 1 - W)) mask_tile(P0_, P1_, qm - kb_, (unsigned)W); } while (0)
    constexpr int NQL = F32 ? 16 : 8;
    constexpr bool SK = WSKIP && !F32;
#define SEAM_K0() do { VMWN(NQL); if constexpr (F32) { SWRITE_KF(0); SBAR(); SLOAD_F((const float*)(B.qkv + nxt.voff()), kbn); } else { SWRITE_HK(0, cref_nxt); } SBAR(); } while (0)
    f32x16 pA0, pA1, pB0, pB1; float mnA, mnB, alA, alB; bf16x8 pa0, pa1, pa2, pa3;
    if constexpr (F32) { VMW(); SWRITE_VF(0); SBAR(); } else { SWRITE_HV(0); SBAR(); }
    if (NT > 1) { if constexpr (F32) SLOAD_F((const float*)Kh, KBASE(1)); else SLOAD_H(Kh, Vh, Ch, KBASE(1)); }
    SBAR(); qkt<0, SK>(pA0, pA1, K_lds, r32, hi, S.qr, ACT(0));
    if constexpr (F32) { if (NT > 1) { VMW(); SWRITE_KF(1); SBAR(); SLOAD_F((const float*)Vh, KBASE(1)); } }
    BIASADD(pA0, pA1, 0); if (j_lo == 0) PADMASK(pA0, pA1); MASKT(pA0, pA1, 0); partialSM(pA0, pA1, m_reg, mnA, alA);
    if (NT > 1) { VMW(); if constexpr (F32) { SWRITE_VF(1); SBAR(); if (NT > 2) SLOAD_F((const float*)Kh, KBASE(2)); } else SWRITE_H(1, CADJ(KBASE(1))); }
    __syncthreads();
#define HALF_STEP(PX0, PX1, mnX, alX, PY0, PY1, alY, t, KB, VB, SB) do {                                                      \
        SBAR(); qkt<KB, SK>(PX0, PX1, K_lds, r32, hi, S.qr, ACT(t));                                             \
        finishSM(PY0, PY1, alY, l_reg, pa0, pa1, pa2, pa3); SBAR();                                                           \
        if ((t) + 1 < NT) { if constexpr (F32) { VMW(); SWRITE_KF(SB); SBAR(); SLOAD_F((const float*)Vh, KBASE((t) + 1)); }  \
                            else { SLOAD_H(Kh, Vh, Ch, KBASE((t) + 1)); } SBAR(); }                                               \
        pv_tile<VB, SK>(o, vb0, pa0, pa1, pa2, pa3, ACT((t) - 1)); BIASADD(PX0, PX1, KB); MASKT(PX0, PX1, (t)); partialSM(PX0, PX1, m_reg, mnX, alX);                                        \
        __syncthreads();                                                                                                      \
        if ((t) + 1 < NT) { VMW(); if constexpr (F32) { SWRITE_VF(SB); SBAR(); if ((t) + 2 < NT) SLOAD_F((const float*)Kh, KBASE((t) + 2)); } \
                            else { SWRITE_H(SB, CADJ(KBASE((t) + 1))); } }                                                                          \
        RESC(alX); __syncthreads(); } while (0)
    for (int t = 1; t + 1 < NT; t += 2) {
        nxtfn.early(t, NT);
        HALF_STEP(pB0, pB1, mnB, alB, pA0, pA1, alA, t, 1, 0, 0);
        HALF_STEP(pA0, pA1, mnA, alA, pB0, pB1, alB, t + 1, 0, 1, 1);
    }
    const Ref nxt = nxtfn();
    const int kbn = nxt.jlo() * KVBLK;
    float cref_nxt = 0.f; if constexpr (MODE == 1) { const float* bn_ = (const float*)(lds + nxt.boff());
        cref_nxt = __uint_as_float(__builtin_amdgcn_readfirstlane(__float_as_uint(bn_[(nxt.P0() - 64) >> 7] + (B.c + nxt.coff())[nxt.P0()] - ((kbn >= 64) ? bn_[(kbn - 64) >> 7] : 0.f)))); }
    const bool even = (NT & 1) == 0;
    if (even) { SBAR(); qkt<1, SK>(pB0, pB1, K_lds, r32, hi, S.qr, ACT(NT - 1)); SBAR(); }
#define QROW(e) (B.qkv + nxt.qoff() + (size_t)(wid * QBLK + r32) * D + ((e) >> 1) * 16 + hi * 8 + ((e) & 1) * 4)
    if constexpr (F32) { SLOAD_F((const float*)(B.qkv + nxt.koff()), kbn); SBAR();
#pragma unroll
        for (int e = 0; e < 8; ++e) S.tq[e] = *(const f32x4*)QROW(e); }
    else { SLOAD_H(B.qkv + nxt.koff(), B.qkv + nxt.voff(), B.c + nxt.coff(), kbn); SBAR();
#pragma unroll
        for (int d0 = 0; d0 < 8; ++d0) S.qr[d0] = load8<TIn>(B.qkv + nxt.qoff() + (size_t)(wid * QBLK + r32) * D + d0 * 16 + hi * 8); }
    SBAR();
    finishSM(pA0, pA1, alA, l_reg, pa0, pa1, pa2, pa3); SBAR();
    if constexpr (F32) {
#pragma unroll
        for (int e = 8; e < 16; ++e) S.tq[e] = *(const f32x4*)QROW(e); SBAR(); }
#undef QROW
    pv_tile<0, SK>(o, vb0, pa0, pa1, pa2, pa3, ACT(even ? NT - 2 : NT - 1));
    if (even) { BIASADD(pB0, pB1, 1); MASKT(pB0, pB1, NT - 1); partialSM(pB0, pB1, m_reg, mnB, alB); __syncthreads(); RESC(alB);
        finishSM(pB0, pB1, alB, l_reg, pa0, pa1, pa2, pa3); SBAR(); pv_tile<1, SK>(o, vb0, pa0, pa1, pa2, pa3, ACT(NT - 1)); }
    SBAR(); SEAM_K0();
    if (hi == 0) li_l[r32] = l_reg; asm volatile("s_waitcnt lgkmcnt(0)" ::: "memory");
    float rli[16];
#pragma unroll
    for (int r = 0; r < 16; ++r) rli[r] = __builtin_amdgcn_rcpf(li_l[crow(r, hi)]);
    TOut* Ow = B.o + cur.ooff() + (size_t)(wid * QBLK) * cur.ldo(); const int ldo = cur.ldo();
    if constexpr (same_t<TOut, float>::v) {
#pragma unroll
        for (int r = 0; r < 16; ++r) { const int orow = crow(r, hi);
#pragma unroll
            for (int d0 = 0; d0 < 4; ++d0) Ow[(size_t)orow * ldo + d0 * 32 + r32] = o[d0][r] * rli[r]; }
    } else {
        char* stg = lds + LDS_OST + wid * 4096;
        o_rows_store<2>(o, rli, stg, (bf16*)Ow, ldo, 0, r32, hi, lane);
        o_rows_store<2>(o + 2, rli, stg, (bf16*)Ow, ldo, 64, r32, hi, lane);
    }
    if constexpr (F32) {
#pragma unroll
        for (int d0 = 0; d0 < 8; ++d0) S.qr[d0] = pack8(S.tq[2 * d0], S.tq[2 * d0 + 1]); }
    __syncthreads();
#undef RESC
#undef CADJ
#undef KBASE
#undef ACT
#undef MASKT
#undef SEAM_K0
#undef HALF_STEP
}
#undef ROW
#undef VMW
#undef VMWN
#undef SLOAD_H
#undef SWRITE_HK
#undef SWRITE_HV
#undef SWRITE_H
#undef SLOAD_F
#undef SWRITE_KF
#undef SWRITE_VF
#undef BIASADD
#undef PADMASK


__device__ __forceinline__ void pv256(f32x16* o, int vb0, bf16x8 pa0, bf16x8 pa1, bf16x8 pa2, bf16x8 pa3) {
#define TRRD(dst, off) asm volatile("ds_read_b64_tr_b16 %0, %1 offset:%2" : "=&v"(dst) : "v"(vb0), "i"(off) : "memory")
#define RD8(S, g) do { constexpr int b_ = ((g) >> 2) * SHM_V + v_rd_off((g) & 3, 0, 0);                                                                   \
        TRRD(S##l0, b_); TRRD(S##h0, b_ + 2048); TRRD(S##l1, b_ + 4096); TRRD(S##h1, b_ + 6144); TRRD(S##l2, b_ + 8192); TRRD(S##h2, b_ + 10240); TRRD(S##l3, b_ + 12288); TRRD(S##h3, b_ + 14336); } while (0)
#define MM4(S, g) do {                                                                                                                                     \
        o[g] = __builtin_amdgcn_mfma_f32_32x32x16_bf16(pa0, (bf16x8){S##l0[0], S##l0[1], S##l0[2], S##l0[3], S##h0[0], S##h0[1], S##h0[2], S##h0[3]}, o[g], 0, 0, 0); \
        o[g] = __builtin_amdgcn_mfma_f32_32x32x16_bf16(pa1, (bf16x8){S##l1[0], S##l1[1], S##l1[2], S##l1[3], S##h1[0], S##h1[1], S##h1[2], S##h1[3]}, o[g], 0, 0, 0); \
        o[g] = __builtin_amdgcn_mfma_f32_32x32x16_bf16(pa2, (bf16x8){S##l2[0], S##l2[1], S##l2[2], S##l2[3], S##h2[0], S##h2[1], S##h2[2], S##h2[3]}, o[g], 0, 0, 0); \
        o[g] = __builtin_amdgcn_mfma_f32_32x32x16_bf16(pa3, (bf16x8){S##l3[0], S##l3[1], S##l3[2], S##l3[3], S##h3[0], S##h3[1], S##h3[2], S##h3[3]}, o[g], 0, 0, 0); } while (0)
#define LW() do { asm volatile("s_waitcnt lgkmcnt(0)" ::: "memory"); SBAR(); } while (0)
    s16x4 Al0, Al1, Al2, Al3, Ah0, Ah1, Ah2, Ah3, Bl0, Bl1, Bl2, Bl3, Bh0, Bh1, Bh2, Bh3;
    RD8(A, 0);
    LW(); RD8(B, 1); SBAR(); MM4(A, 0); SBAR();
    LW(); RD8(A, 2); SBAR(); MM4(B, 1); SBAR();
    LW(); RD8(B, 3); SBAR(); MM4(A, 2); SBAR();
    LW(); RD8(A, 4); SBAR(); MM4(B, 3); SBAR();
    LW(); RD8(B, 5); SBAR(); MM4(A, 4); SBAR();
    LW(); RD8(A, 6); SBAR(); MM4(B, 5); SBAR();
    LW(); RD8(B, 7); SBAR(); MM4(A, 6); SBAR();
    LW(); MM4(B, 7);
#undef TRRD
#undef RD8
#undef MM4
#undef LW
}

__device__ __forceinline__ void qk64(f32x16& p0, f32x16& p1, const char* K_lds, const char* Q_w, int r32, int hi) {
    p0 = f32x16{}; p1 = f32x16{};
    int ka[4], qa[4];
#pragma unroll
    for (int dd = 0; dd < 4; ++dd) { const int off = KSWZ(r32, (dd * 16 + hi * 8) * 2); ka[dd] = (int)(uintptr_t)K_lds + off; qa[dd] = (int)(uintptr_t)Q_w + off; }
#define LDR(dst, addr, off) asm volatile("ds_read_b128 %0, %1 offset:%2" : "=&v"(dst) : "v"(addr), "i"(off) : "memory")
#define RDS(S, d0) do { LDR(S##q, qa[(d0) & 3], ((d0) >> 2) * 128); LDR(S##a, ka[(d0) & 3], ((d0) >> 2) * 128); LDR(S##b, ka[(d0) & 3], ((d0) >> 2) * 128 + 32 * 256); } while (0)
#define MMS(S) do { p0 = __builtin_amdgcn_mfma_f32_32x32x16_bf16(S##a, S##q, p0, 0, 0, 0); p1 = __builtin_amdgcn_mfma_f32_32x32x16_bf16(S##b, S##q, p1, 0, 0, 0); } while (0)
#define LWN(n) do { asm volatile("s_waitcnt lgkmcnt(" #n ")" ::: "memory"); SBAR(); } while (0)
    bf16x8 Aq, Aa, Ab, Bq, Ba, Bb;
    RDS(A, 0); RDS(B, 1);
    LWN(3); MMS(A); SBAR(); RDS(A, 2);
    LWN(3); MMS(B); SBAR(); RDS(B, 3);
    LWN(3); MMS(A); SBAR(); RDS(A, 4);
    LWN(3); MMS(B); SBAR(); RDS(B, 5);
    LWN(3); MMS(A); SBAR(); RDS(A, 6);
    LWN(3); MMS(B); SBAR(); RDS(B, 7);
    LWN(3); MMS(A); SBAR();
    LWN(0); MMS(B);
#undef LDR
#undef RDS
#undef MMS
#undef LWN
}
constexpr int DLDS_K = 2 * SHM_V, DLDS_Q = DLDS_K + SHM_K, DLDS_WS = DLDS_Q + NW * 8192, DLDS_BYTES = DLDS_WS + NW * 64 * 4;
struct DiffRef { unsigned qoff, koff, v0off, v1off, ooff; int qb; };
__device__ __forceinline__ void diff_block(const DiffRef& R, const bf16* qkv, bf16* obase, int ldo, char* lds, const int wv) {
    const int tid = fresh_tid(wv), wid = wv, lane = tid & 63, r32 = lane & 31, hi = lane >> 5;
    char* V_lds = lds; char* K_lds = lds + DLDS_K; char* Q_lds = lds + DLDS_Q + wid * 8192;
    float* ws = (float*)(lds + DLDS_WS) + wid * 64; float* li_l = ws, * al_l = ws + 32;
    const int NT = 4 * R.qb + 5, myNT = 4 * R.qb + 2 + (wid >> 1);
    const int sr = tid >> 4, sc = (tid & 15) * 8, vst0 = v_st(sr, sc), vst1 = v_st(32 + sr, sc), kws = KSWZ(sr, sc * 2);
    const int vb0 = (int)(uintptr_t)V_lds + v_rd_base(lane);
    const bf16* Kh = qkv + R.koff; const bf16* V0h = qkv + R.v0off; const bf16* V1h = qkv + R.v1off;
    const int qsw = KSWZ(r32, hi * 16);
#define QCH(d0) (KSWZ(r32, ((d0) * 16 + hi * 8) * 2))
    {
        const bf16* Qp = qkv + R.qoff + (size_t)(wid * QBLK + r32) * D + hi * 8; bf16x8 q[8];
#pragma unroll
        for (int d0 = 0; d0 < 8; ++d0) q[d0] = load8<bf16>(Qp + d0 * 16);
#pragma unroll
        for (int d0 = 0; d0 < 8; ++d0) *(bf16x8*)(Q_lds + QCH(d0)) = q[d0];
    }
    (void)qsw;
    bf16x8 sk0, sk1, sv0, sv1, sv2, sv3;
    const unsigned lo0 = (unsigned)(sr * D + sc), lo1 = lo0 + 32u * D;
#define DLOAD(k0) do { const bf16* kp_ = Kh + (size_t)(k0) * D; const bf16* v0_ = V0h + (size_t)(k0) * D; const bf16* v1_ = V1h + (size_t)(k0) * D;          \
                       sk0 = load8<bf16>(kp_ + lo0); sk1 = load8<bf16>(kp_ + lo1); sv0 = load8<bf16>(v0_ + lo0); sv1 = load8<bf16>(v0_ + lo1);           \
                       sv2 = load8<bf16>(v1_ + lo0); sv3 = load8<bf16>(v1_ + lo1); } while (0)
#define DWRITE() do { *(bf16x8*)(K_lds + kws) = sk0; *(bf16x8*)(K_lds + kws + 32 * 256) = sk1;                                                 \
                      *(bf16x8*)(V_lds + vst0) = sv0; *(bf16x8*)(V_lds + vst1) = sv1; *(bf16x8*)(V_lds + SHM_V + vst0) = sv2; *(bf16x8*)(V_lds + SHM_V + vst1) = sv3; } while (0)
    DLOAD(0);
    float m_reg = -1e30f, l_reg = 0; f32x16 o[8] = {};
#pragma unroll 1
    for (int t = 0; t < NT; ++t) {
        asm volatile("s_waitcnt vmcnt(0)" ::: "memory");
        __syncthreads();
        DWRITE();
        __syncthreads();
        if (t + 1 < NT) DLOAD((t + 1) * KVBLK);
        SBAR();
        if (t < myNT) {
            f32x16 p0, p1; float mn, al; bf16x8 pa0, pa1, pa2, pa3;
            qk64(p0, p1, K_lds, Q_lds, r32, hi);
            if (t == 0) { const float NEG_ = -__builtin_inff();
#pragma unroll
                for (int r_ = 0; r_ < 16; ++r_) { if (r_ >= 8) p0[r_] = NEG_; p1[r_] = NEG_; } }
            partialSM(p0, p1, m_reg, mn, al);
            finishSM(p0, p1, al, l_reg, pa0, pa1, pa2, pa3);
            if (__any(al < 1.f)) { if (hi == 0) al_l[r32] = al; asm volatile("s_waitcnt lgkmcnt(0)" ::: "memory");
#pragma unroll
                for (int d_ = 0; d_ < 8; ++d_)
#pragma unroll
                    for (int r = 0; r < 16; ++r) o[d_][r] *= al_l[crow(r, hi)]; }
            SBAR();
            pv256(o, vb0, pa0, pa1, pa2, pa3);
        }
    }
    if (hi == 0) li_l[r32] = l_reg; asm volatile("s_waitcnt lgkmcnt(0)" ::: "memory");
    bf16* Ow = obase + R.ooff + (size_t)(wid * QBLK) * ldo;
    float rl[16];
#pragma unroll
    for (int r = 0; r < 16; ++r) rl[r] = __builtin_amdgcn_rcpf(li_l[crow(r, hi)]);
    o_rows_store<4>(o, rl, Q_lds, Ow, ldo, 0, r32, hi, lane);
    o_rows_store<4>(o + 4, rl, Q_lds, Ow, ldo, 128, r32, hi, lane);
#undef QCH
#undef DLOAD
#undef DWRITE
}

}


constexpr int NWAVES = 8;
constexpr int NB = 2, T = 8192, DM = 4096, NMETA = 16, LSEQ = NMETA + T;
constexpr int MR = NB * T;
constexpr int KVR = 64 + T;
constexpr int NPROJ = 12288, INW = 12304, FFW = 16384, NGRP = 96;
constexpr int NFH = 16;
constexpr float LN_EPS = 1e-5f, SUBLN_EPS = 1e-5f;
constexpr float DN_ALPHA = 1.189207115002721f;
constexpr float LAMBDA_INIT = 0.2f;

constexpr size_t MiB = 1u << 20;
constexpr size_t WS_CTL = 0, CTL_ZERO_BYTES = 1 * MiB;
constexpr size_t WS_STATS0 = 1 * MiB, WS_STATS1 = WS_STATS0 + 131072, WS_HMETA = WS_STATS1 + 131072, WS_WFF = WS_HMETA + 131072;
constexpr size_t WS_ZF = 2 * MiB;
constexpr size_t WS_CUMS = 4 * MiB;
constexpr size_t WS_ROPE = 6 * MiB;
constexpr size_t WS_WUP = 16 * MiB, WS_WDN = 144 * MiB, WS_WOUT = 272 * MiB, WS_WIN = 304 * MiB;
constexpr size_t WS_H0B = 400 * MiB;
constexpr size_t WS_QKV = 528 * MiB;
constexpr size_t WS_PART0 = 304 * MiB, WS_PART1 = 915 * MiB;
constexpr size_t WS_H1B = 304 * MiB;
constexpr size_t WS_ACT = 432 * MiB;
constexpr size_t WS_RPART = 980 * MiB;
constexpr size_t WS_UPART = 988 * MiB, WS_CPART = 992 * MiB;
constexpr size_t WS_UCOL = 996 * MiB, WS_CCOL = WS_UCOL + 65536;
constexpr size_t WS_END = 997 * MiB;
static_assert(WS_ZF + (size_t)NB * KVR * 16 * 4 <= WS_CUMS && WS_CUMS + (size_t)NB * 16 * KVR * 4 <= WS_ROPE && WS_ROPE + (size_t)2 * LSEQ * 64 * 4 <= WS_WUP, "small regions");
static_assert(WS_QKV + (size_t)NGRP * NB * KVR * 128 * 2 <= WS_PART1 && WS_PART1 + (size_t)MR * 2048 * 2 <= WS_END && WS_ACT + (size_t)MR * FFW * 2 <= WS_END, "big regions");
static_assert(WS_H1B + (size_t)MR * DM * 2 <= WS_ACT && WS_WIN + (size_t)NPROJ * DM * 2 <= WS_H0B && WS_PART0 + (size_t)MR * 2048 * 2 <= WS_H0B, "overlays");
constexpr int CW_TMO = 0, CW_CODE = 1;
constexpr int CW_BAR = 4096;
constexpr int CW_QUEUE = 64, CW_QUEUE2 = 128, CW_QUEUE3 = 1024;
constexpr int CW_UC = 13312;
constexpr int CW_FLAT = 13376;
constexpr int CONV_NB = 9;
constexpr int CW_GRP = 12800;
constexpr int CW_NRM = 8192;

constexpr int RING_OFF = 0, RING_BYTES = 131072;
constexpr int LDSCTL_OFF = RING_BYTES, MISC_OFF = LDSCTL_OFF + 320;
constexpr int LDS_BYTES = 147456;
static_assert(MISC_OFF + 128 <= LDS_BYTES, "LDS map");
static_assert(att::LDS_BYTES <= RING_BYTES && att::DLDS_BYTES <= RING_BYTES, "attention LDS");

#define GAS __attribute__((address_space(1)))
#define LAS __attribute__((address_space(3)))
typedef unsigned short bf16;
typedef unsigned v4u __attribute__((ext_vector_type(4)));
typedef float f32x4 __attribute__((ext_vector_type(4)));
typedef short bf16x8 __attribute__((ext_vector_type(8)));
typedef GAS unsigned gu32;
typedef GAS unsigned long long gu64;
#define RLX_AGENT __ATOMIC_RELAXED, __HIP_MEMORY_SCOPE_AGENT
#define LDS_WAIT() asm volatile("s_waitcnt lgkmcnt(0)" ::: "memory")
#define VM_WAIT() asm volatile("s_waitcnt vmcnt(0)" ::: "memory")
__device__ __forceinline__ unsigned long long rt() { return __builtin_amdgcn_s_memrealtime(); }
__device__ __forceinline__ unsigned f2bf(float f) { unsigned u = __builtin_bit_cast(unsigned, f); return (u + 0x7fffu + ((u >> 16) & 1u)) >> 16; }
__device__ __forceinline__ unsigned pk2(float lo, float hi) { return f2bf(lo) | (f2bf(hi) << 16); }

#define XB_TMO      128
#define XB_XCNT(j)  (256  + 64 * (j))
#define XB_XSUB(j)  (1280 + 64 * (j))
#define XB_XGEN(j)  (2304 + 64 * (j))
#define XB_TOP      3328
#define XB_TOPGEN   3392
#define XCD_BAR_WORDS 3456
#define XB_SPIN_CAP (1u << 18)

__device__ __forceinline__ unsigned xb_ld(unsigned* p)              { return __hip_atomic_load(p, __ATOMIC_RELAXED, __HIP_MEMORY_SCOPE_AGENT); }
__device__ __forceinline__ unsigned xb_add(unsigned* p, unsigned v) { return __hip_atomic_fetch_add(p, v, __ATOMIC_RELAXED, __HIP_MEMORY_SCOPE_AGENT); }
__device__ __forceinline__ unsigned xb_xcc_id() { return (unsigned)__builtin_amdgcn_s_getreg((3 << 11) | 20) & 0xFu; }
#define XB_SPIN(cond, bar) do { unsigned _sp = 0; while (cond) { __builtin_amdgcn_s_sleep(1); \
    if ((++_sp & 255u) == 0u) { if (xb_ld(&(bar)[XB_TMO])) break; if (_sp > XB_SPIN_CAP) { atomicAdd(&(bar)[XB_TMO], 1u); break; } } } } while (0)

struct XcdBarrier {
    unsigned* bar; unsigned x;
    volatile LAS unsigned* st;
};

__device__ __forceinline__ XcdBarrier xcd_barrier_post(unsigned* bar, volatile LAS unsigned* st, const bool t0  ) {
    XcdBarrier b; b.bar = bar; b.x = xb_xcc_id(); b.st = st;
    if (t0) (void)xb_add(&bar[XB_XCNT(b.x)], 1u);
    return b;
}
__device__ __forceinline__ void xcd_barrier_complete(unsigned* bar, unsigned x, unsigned& nloc, unsigned& nx) {
    const unsigned G = gridDim.x * gridDim.y * gridDim.z;
    unsigned sum, cnt, mine, sp = 0u;
    for (;;) {
        sum = 0u; cnt = 0u; mine = 0u;
#pragma unroll
        for (unsigned j = 0; j < 16; ++j) { const unsigned c = xb_ld(&bar[XB_XCNT(j)]); sum += c; cnt += (c > 0u) ? 1u : 0u; mine = (j == x) ? c : mine; }
        if (sum == G) break;
        __builtin_amdgcn_s_sleep(1);
        if ((++sp & 255u) == 0u) { if (xb_ld(&bar[XB_TMO])) break; if (sp > XB_SPIN_CAP) { atomicAdd(&bar[XB_TMO], 1u); break; } }
    }
    nloc = mine > 0u ? mine : 1u; nx = cnt > 0u ? cnt : 1u;
}

__device__ __forceinline__ void xcd_barrier(const XcdBarrier& b, const bool t0  ) {
    asm volatile("s_waitcnt vmcnt(0)" ::: "memory");
    __syncthreads();
    if (t0) {
        unsigned* bar = b.bar;
        __builtin_amdgcn_s_waitcnt(0);
        unsigned nloc = b.st[0], nx = b.st[1];
        if (nloc == 0u) { xcd_barrier_complete(bar, b.x, nloc, nx); b.st[0] = nloc; b.st[1] = nx; }
        const unsigned old = xb_add(&bar[XB_XSUB(b.x)], 1u);
        const unsigned gen = old / nloc;
        if (old + 1u == (gen + 1u) * nloc) {
            __builtin_amdgcn_fence(__ATOMIC_RELEASE, "agent");
            asm volatile("s_waitcnt vmcnt(0)" ::: "memory");
            const unsigned og = xb_add(&bar[XB_TOP], 1u);
            const unsigned tg = og / nx;
            if (og + 1u == (tg + 1u) * nx) xb_add(&bar[XB_TOPGEN], 1u);
            else XB_SPIN(xb_ld(&bar[XB_TOPGEN]) == tg, bar);
            __builtin_amdgcn_fence(__ATOMIC_ACQUIRE, "agent");
            xb_add(&bar[XB_XGEN(b.x)], 1u);
            asm volatile("s_waitcnt vmcnt(0)" ::: "memory");
        } else {
            XB_SPIN(xb_ld(&bar[XB_XGEN(b.x)]) == gen, bar);
            __builtin_amdgcn_fence(__ATOMIC_ACQUIRE, "agent");
            asm volatile("s_waitcnt vmcnt(0)" ::: "memory");
        }
    }
    __syncthreads();
}


__device__ __forceinline__ float lane_xor(float v, int k, int lane) { return __builtin_bit_cast(float, __builtin_amdgcn_ds_bpermute((lane ^ k) << 2, __builtin_bit_cast(int, v))); }
__device__ __forceinline__ float lane_up(float v, int o, int lane) { return __builtin_bit_cast(float, __builtin_amdgcn_ds_bpermute(((lane - o) & 63) << 2, __builtin_bit_cast(int, v))); }
__device__ __forceinline__ float wave_sum(float v, int lane) {
#pragma unroll
    for (int o = 1; o < 64; o <<= 1) v += lane_xor(v, o, lane);
    return v;
}
__device__ __forceinline__ float bf2f(unsigned h) { return __builtin_bit_cast(float, h << 16); }
__device__ __forceinline__ float log_sigmoid(float z) { return fminf(z, 0.f) - log1pf(expf(-fabsf(z))); }

__device__ __forceinline__ int p0_rowmap(int n, int mode) {
    if (mode == 1) return n < 4096 ? ((n & ~192) | ((n & 64) << 1) | ((n & 128) >> 1)) : n;
    if (mode == 2) return n - NPROJ;
    return n;
}
__device__ __forceinline__ void p0_transpose_item(const float* W, int ldw, int K, bf16* WT, LAS float* scr, int k0, int n0, int nvalid, int mode, int lane) {
    const int n4 = (lane & 7) * 4;
#pragma unroll
    for (int i = 0; i < 8; ++i) { const int kk = 8 * i + (lane >> 3); f32x4 v = {0.f, 0.f, 0.f, 0.f}; if (n4 < nvalid) v = *(const GAS f32x4*)(W + (size_t)(k0 + kk) * ldw + n0 + n4);
        LAS float* d = scr + kk * 33 + n4; d[0] = v.x; d[1] = v.y; d[2] = v.z; d[3] = v.w; }
    LDS_WAIT(); asm volatile("" ::: "memory");
    const int c = lane & 7;
#pragma unroll
    for (int j = 0; j < 4; ++j) { const int n = (lane >> 3) + 8 * j; const LAS float* s = scr + (8 * c) * 33 + n;
        v4u o; o.x = pk2(s[0 * 33], s[1 * 33]); o.y = pk2(s[2 * 33], s[3 * 33]); o.z = pk2(s[4 * 33], s[5 * 33]); o.w = pk2(s[6 * 33], s[7 * 33]);
        if (n < nvalid) *(GAS v4u*)(WT + (size_t)p0_rowmap(n0 + n, mode) * K + k0 + 8 * c) = o; }
    LDS_WAIT(); asm volatile("" ::: "memory");
}
__device__ __forceinline__ void ln_row(const float* src, const float* g, const float* bta, int lane, float* dstf, bf16* dstb, float* stats) {
    const GAS f32x4* xr = (const GAS f32x4*)src + lane;
    f32x4 v[16]; float s = 0.f;
#pragma unroll
    for (int j = 0; j < 16; ++j) { v[j] = xr[64 * j]; s += (v[j].x + v[j].y) + (v[j].z + v[j].w); }
    const float mean = wave_sum(s, lane) * (1.f / DM); float s2 = 0.f;
#pragma unroll
    for (int j = 0; j < 16; ++j) { v[j] = v[j] - mean; s2 += (v[j].x * v[j].x + v[j].y * v[j].y) + (v[j].z * v[j].z + v[j].w * v[j].w); }
    const float rstd = 1.f / sqrtf(wave_sum(s2, lane) * (1.f / DM) + LN_EPS);
    if (stats && lane == 0) { stats[0] = mean; stats[1] = rstd; }
    const GAS f32x4* g4 = (const GAS f32x4*)g + lane; const GAS f32x4* b4 = (const GAS f32x4*)bta + lane;
#pragma unroll
    for (int j = 0; j < 16; ++j) { const f32x4 o = v[j] * rstd * g4[64 * j] + b4[64 * j];
        if (dstf) ((GAS f32x4*)dstf + lane)[64 * j] = o;
        if (dstb) ((GAS unsigned long long*)dstb + lane)[64 * j] = (unsigned long long)pk2(o.x, o.y) | ((unsigned long long)pk2(o.z, o.w) << 32); }
}
template <int R> __device__ __forceinline__ void ln_rows(const float* src, size_t rstride, const float* g, const float* bta, int lane, float* dstf, bf16* dstb, float* stats, size_t sstride) {
    f32x4 v[R][16]; float s[R];
#pragma unroll
    for (int r = 0; r < R; ++r) { const GAS f32x4* xr = (const GAS f32x4*)(src + r * rstride) + lane; s[r] = 0.f;
#pragma unroll
        for (int j = 0; j < 16; ++j) { v[r][j] = xr[64 * j]; s[r] += (v[r][j].x + v[r][j].y) + (v[r][j].z + v[r][j].w); } }
    float rstd[R];
#pragma unroll
    for (int r = 0; r < R; ++r) { const float mean = wave_sum(s[r], lane) * (1.f / DM); float s2 = 0.f;
#pragma unroll
        for (int j = 0; j < 16; ++j) { v[r][j] = v[r][j] - mean; s2 += (v[r][j].x * v[r][j].x + v[r][j].y * v[r][j].y) + (v[r][j].z * v[r][j].z + v[r][j].w * v[r][j].w); }
        rstd[r] = 1.f / sqrtf(wave_sum(s2, lane) * (1.f / DM) + LN_EPS);
        if (stats && lane == 0) { stats[r * sstride] = mean; stats[r * sstride + 1] = rstd[r]; } }
    const GAS f32x4* g4 = (const GAS f32x4*)g + lane; const GAS f32x4* b4 = (const GAS f32x4*)bta + lane;
#pragma unroll
    for (int j = 0; j < 16; ++j) { const f32x4 gv = g4[64 * j], bv = b4[64 * j];
#pragma unroll
        for (int r = 0; r < R; ++r) { const f32x4 o = v[r][j] * rstd[r] * gv + bv;
            if (dstf) ((GAS f32x4*)(dstf + r * rstride) + lane)[64 * j] = o;
            if (dstb) ((GAS unsigned long long*)(dstb + r * rstride) + lane)[64 * j] = (unsigned long long)pk2(o.x, o.y) | ((unsigned long long)pk2(o.z, o.w) << 32); } }
}
__device__ __forceinline__ void late_conv_decode(int it, const float* w_out, const float* w_up, const float* w_down, bf16* Wout, bf16* Wup, bf16* Wdn,
                                                 const float*& W, int& ldw, int& K, bf16*& WT, int& k0, int& n0) {
    constexpr int I_OUT = 64 * 128, I_UP = 64 * 512;
    if (it < I_OUT) { W = w_out; ldw = DM; K = DM; WT = Wout; k0 = 64 * (it / 128); n0 = 32 * (it % 128); return; } it -= I_OUT;
    if (it < I_UP) { W = w_up; ldw = FFW; K = DM; WT = Wup; k0 = 64 * (it / 512); n0 = 32 * (it % 512); return; } it -= I_UP;
    W = w_down; ldw = DM; K = FFW; WT = Wdn; k0 = 64 * (it / 128); n0 = 32 * (it % 128);
}
__device__ __forceinline__ void late_weight_conv(const float* w_out, const float* w_up, const float* w_down, bf16* Wout, bf16* Wup, bf16* Wdn, LAS float* scr, int gw, int lane, const float* g1, const float* b1, float* upart, float* cpart, const int bt0, const int bt1) {
    constexpr int NIT = 64 * 128 + 64 * 512 + 256 * 128, NGW_ = 256 * NWAVES; static_assert(NIT == CONV_NB * 4 * NGW_, "whole batches of four items per wave");
    const int n4 = (lane & 7) * 4, c = lane & 7;
#pragma unroll 1
    for (int it0 = gw + bt0 * 4 * NGW_; it0 < gw + bt1 * 4 * NGW_; it0 += 4 * NGW_) {
        f32x4 v[4][8];
#pragma unroll
        for (int j = 0; j < 4; ++j) { const float* W; int ldw, K, k0, n0; bf16* WT; late_conv_decode(it0 + j * NGW_, w_out, w_up, w_down, Wout, Wup, Wdn, W, ldw, K, WT, k0, n0);
#pragma unroll
            for (int i = 0; i < 8; ++i) v[j][i] = *(const GAS f32x4*)(W + (size_t)(k0 + 8 * i + (lane >> 3)) * ldw + n0 + n4); }
#pragma unroll
        for (int j = 0; j < 4; ++j) { const float* W; int ldw, K, k0, n0; bf16* WT; late_conv_decode(it0 + j * NGW_, w_out, w_up, w_down, Wout, Wup, Wdn, W, ldw, K, WT, k0, n0);
#pragma unroll
            for (int i = 0; i < 8; ++i) { LAS float* d = scr + (8 * i + (lane >> 3)) * 33 + n4; d[0] = v[j][i].x; d[1] = v[j][i].y; d[2] = v[j][i].z; d[3] = v[j][i].w; }
            LDS_WAIT(); asm volatile("" ::: "memory");
            const int itj = it0 + j * NGW_;
            if (itj >= 64 * 128 && itj < 64 * 128 + 64 * 512) {
                const f32x4 ga = *(const GAS f32x4*)(g1 + k0 + 8 * c), gb = *(const GAS f32x4*)(g1 + k0 + 8 * c + 4), ba = *(const GAS f32x4*)(b1 + k0 + 8 * c), bb = *(const GAS f32x4*)(b1 + k0 + 8 * c + 4);
#pragma unroll
                for (int q = 0; q < 4; ++q) { const int n = (lane >> 3) + 8 * q; const LAS float* s = scr + (8 * c) * 33 + n;
                    const float w0 = s[0 * 33], w1 = s[1 * 33], w2 = s[2 * 33], w3 = s[3 * 33], w4 = s[4 * 33], w5 = s[5 * 33], w6 = s[6 * 33], w7 = s[7 * 33];
                    float cs = ((ba.x * w0 + ba.y * w1) + (ba.z * w2 + ba.w * w3)) + ((bb.x * w4 + bb.y * w5) + (bb.z * w6 + bb.w * w7));
                    v4u o; o.x = pk2(ga.x * w0, ga.y * w1); o.y = pk2(ga.z * w2, ga.w * w3); o.z = pk2(gb.x * w4, gb.y * w5); o.w = pk2(gb.z * w6, gb.w * w7);
                    *(GAS v4u*)(WT + (size_t)(n0 + n) * K + k0 + 8 * c) = o;
                    float us = ((bf2f(o.x & 0xffffu) + bf2f(o.x >> 16)) + (bf2f(o.y & 0xffffu) + bf2f(o.y >> 16))) + ((bf2f(o.z & 0xffffu) + bf2f(o.z >> 16)) + (bf2f(o.w & 0xffffu) + bf2f(o.w >> 16)));
#pragma unroll
                    for (int x = 1; x < 8; x <<= 1) { us += lane_xor(us, x, lane); cs += lane_xor(cs, x, lane); }
                    if (c == 0) { upart[(size_t)(k0 >> 6) * FFW + n0 + n] = us; cpart[(size_t)(k0 >> 6) * FFW + n0 + n] = cs; } }
            } else {
#pragma unroll
            for (int q = 0; q < 4; ++q) { const int n = (lane >> 3) + 8 * q; const LAS float* s = scr + (8 * c) * 33 + n;
                v4u o; o.x = pk2(s[0 * 33], s[1 * 33]); o.y = pk2(s[2 * 33], s[3 * 33]); o.z = pk2(s[4 * 33], s[5 * 33]); o.w = pk2(s[6 * 33], s[7 * 33]);
                *(GAS v4u*)(WT + (size_t)(n0 + n) * K + k0 + 8 * c) = o; }
            }
            LDS_WAIT(); asm volatile("" ::: "memory"); }
    }
}
template <int R> __device__ __forceinline__ void ln_rows_b(const bf16* src, size_t rstride, const float* g, const float* bta, int lane, float* dstf, bf16* dstb, float* stats, size_t sstride, size_t dstride) {
    f32x4 v[R][16]; float s[R];
#pragma unroll
    for (int r = 0; r < R; ++r) { const GAS unsigned long long* xr = (const GAS unsigned long long*)(src + r * rstride) + lane; s[r] = 0.f;
#pragma unroll
        for (int j = 0; j < 16; ++j) { const unsigned long long w = xr[64 * j]; const unsigned lo = (unsigned)w, hi = (unsigned)(w >> 32);
            v[r][j] = (f32x4){bf2f(lo & 0xffffu), bf2f(lo >> 16), bf2f(hi & 0xffffu), bf2f(hi >> 16)}; s[r] += (v[r][j].x + v[r][j].y) + (v[r][j].z + v[r][j].w); } }
    float rstd[R];
#pragma unroll
    for (int r = 0; r < R; ++r) { const float mean = wave_sum(s[r], lane) * (1.f / DM); float s2 = 0.f;
#pragma unroll
        for (int j = 0; j < 16; ++j) { v[r][j] = v[r][j] - mean; s2 += (v[r][j].x * v[r][j].x + v[r][j].y * v[r][j].y) + (v[r][j].z * v[r][j].z + v[r][j].w * v[r][j].w); }
        rstd[r] = 1.f / sqrtf(wave_sum(s2, lane) * (1.f / DM) + LN_EPS);
        if (stats && lane == 0) { stats[r * sstride] = mean; stats[r * sstride + 1] = rstd[r]; } }
    const GAS f32x4* g4 = (const GAS f32x4*)g + lane; const GAS f32x4* b4 = (const GAS f32x4*)bta + lane;
#pragma unroll
    for (int j = 0; j < 16; ++j) { const f32x4 gv = g4[64 * j], bv = b4[64 * j];
#pragma unroll
        for (int r = 0; r < R; ++r) { const f32x4 o = v[r][j] * rstd[r] * gv + bv;
            if (dstf) ((GAS f32x4*)(dstf + r * dstride) + lane)[64 * j] = o;
            if (dstb) ((GAS unsigned long long*)(dstb + r * dstride) + lane)[64 * j] = (unsigned long long)pk2(o.x, o.y) | ((unsigned long long)pk2(o.z, o.w) << 32); } }
}
__device__ __forceinline__ void grp_barrier(gu32* ctl, const int slot, const int bx, const bool t0) {
    asm volatile("s_waitcnt vmcnt(0)" ::: "memory");
    __syncthreads();
    if (t0) {
        unsigned* bar = (unsigned*)(ctl + CW_BAR);
        __builtin_amdgcn_s_waitcnt(0);
        __builtin_amdgcn_fence(__ATOMIC_RELEASE, "agent"); asm volatile("s_waitcnt vmcnt(0)" ::: "memory");
        unsigned* c = (unsigned*)(ctl + CW_GRP + slot * 64 + (bx & 63));
        (void)xb_add(c, 1u);
        XB_SPIN(xb_ld(c) < 4u, bar);
        __builtin_amdgcn_fence(__ATOMIC_ACQUIRE, "agent");
        asm volatile("s_waitcnt vmcnt(0)" ::: "memory");
    }
    __syncthreads();
}
__device__ __forceinline__ void sincos_d(double x, double& sn, double& cs) {
    const double kq = rint(x * 0.63661977236758134308);
    double r = fma(-kq, 1.57079632673412561417e+00, x); r = fma(-kq, 6.07710050630396597660e-11, r); r = fma(-kq, 2.02226624879595063154e-21, r);
    const int q = ((int)kq) & 3; const double z = r * r;
    const double sp = r + r * z * (-1.66666666666666324348e-01 + z * (8.33333333332248946124e-03 + z * (-1.98412698298579493134e-04 + z * (2.75573137070700676789e-06 + z * (-2.50507602534068634195e-08 + z * 1.58969099521155010221e-10)))));
    const double cp = 1.0 - 0.5 * z + z * z * (4.16666666666666019037e-02 + z * (-1.38888888888741095749e-03 + z * (2.48015872894767294178e-05 + z * (-2.75573143513906633035e-07 + z * (2.08757232129817482790e-09 + z * -1.13596475577881948265e-11)))));
    sn = (q == 0) ? sp : (q == 1) ? cp : (q == 2) ? -sp : -cp;
    cs = (q == 0) ? cp : (q == 1) ? -sp : (q == 2) ? -cp : sp;
}

#ifndef STAG_F32
#define STAG_F32 0
#endif
#ifndef STAG_BF
#define STAG_BF 0
#endif
__device__ __forceinline__ void xcd_stagger(unsigned ticks_per) {
    if (ticks_per == 0u) return;
    const unsigned long long t0 = __builtin_amdgcn_s_memrealtime(), w = (unsigned long long)(xb_xcc_id() & 7u) * ticks_per;
    while (__builtin_amdgcn_s_memrealtime() - t0 < w) __builtin_amdgcn_s_sleep(4);
}
struct Args { const float* in[18]; float* out; unsigned char* ws; int ph_lo, ph_hi; };
static_assert(sizeof(Args) == 18 * 8 + 8 + 8 + 8, "Args has padding");
__device__ const float INV_FREQ[64] = {0x1.0000000000000p+0f, 0x1.bb5fae0000000p-1f, 0x1.7ff2220000000p-1f, 0x1.4c7bc00000000p-1f, 0x1.1feb340000000p-1f, 0x1.f2a79e0000000p-2f, 0x1.afd1360000000p-2f, 0x1.75f0360000000p-2f, 0x1.43d1360000000p-2f, 0x1.186a080000000p-2f, 0x1.e5a8460000000p-3f, 0x1.a48fda0000000p-3f, 0x1.6c310e0000000p-3f, 0x1.3b60800000000p-3f, 0x1.111aee0000000p-3f, 0x1.d8ffac0000000p-4f, 0x1.99999a0000000p-4f, 0x1.62b2f00000000p-4f, 0x1.33281a0000000p-4f, 0x1.09fc9a0000000p-4f, 0x1.ccab840000000p-5f, 0x1.8eec7e0000000p-5f, 0x1.59742a0000000p-5f, 0x1.2b26900000000p-5f, 0x1.030dc60000000p-5f, 0x1.c0a9a40000000p-6f, 0x1.84869e0000000p-6f, 0x1.5073160000000p-6f, 0x1.235a720000000p-6f, 0x1.f89a660000000p-7f, 0x1.b4f7e40000000p-7f, 0x1.7a66220000000p-7f, 0x1.47ae140000000p-7f, 0x1.1bc25a0000000p-7f, 0x1.eb73600000000p-8f, 0x1.a9942a0000000p-8f, 0x1.7089380000000p-8f, 0x1.3f23980000000p-8f, 0x1.145cee0000000p-8f, 0x1.dea41c0000000p-9f, 0x1.9e7c700000000p-9f, 0x1.66ee1e0000000p-9f, 0x1.36d21a0000000p-9f, 0x1.0d28de0000000p-9f, 0x1.d22a500000000p-10f, 0x1.93aeb80000000p-10f, 0x1.5d931c0000000p-10f, 0x1.2eb81c0000000p-10f, 0x1.0624de0000000p-10f, 0x1.c603c40000000p-11f, 0x1.8929180000000p-11f, 0x1.5476880000000p-11f, 0x1.26d42c0000000p-11f, 0x1.fe9f580000000p-12f, 0x1.ba2e4a0000000p-12f, 0x1.7ee9ae0000000p-12f, 0x1.4b96c00000000p-12f, 0x1.1f24e40000000p-12f, 0x1.f1502a0000000p-13f, 0x1.aea7c80000000p-13f, 0x1.74eea60000000p-13f, 0x1.42f22c0000000p-13f, 0x1.17a8e40000000p-13f, 0x1.e459c40000000p-14f};
typedef att::BlockRef<att::bf16, att::bf16> ABR;
typedef att::Bases<att::bf16, att::bf16> ABS;
__device__ __forceinline__ att::DiffRef mkref_diff(int ph, int c, int qb) {
    const int b = ph >> 3, h = ph & 7; att::DiffRef r;
    r.qoff = (unsigned)((((2 * h + c) * NB + b) * KVR + 64 + 256 * qb) * 128); r.koff = (unsigned)(((16 + 2 * h + c) * NB + b) * KVR * 128);
    r.v0off = (unsigned)(((32 + 2 * h) * NB + b) * KVR * 128); r.v1off = (unsigned)(((33 + 2 * h) * NB + b) * KVR * 128);
    r.ooff = (unsigned)((c ? WS_PART1 : WS_PART0) / 2) + (unsigned)((b * T + 256 * qb) * 2048 + h * 256); r.qb = qb; return r;
}
__device__ __forceinline__ int fox_jlo(int idx, const float* cums, const LAS float* base_all, const LAS float* smax2_l, int lane) {
    asm volatile("" : "+v"(lane));
    const int qb = 31 - (idx >> 5), bh = idx & 31;
    const float* cb = cums + (size_t)bh * KVR; const LAS float* bl = base_all + bh * 64;
    const float cq = bl[2 * qb] + cb[64 + 256 * qb], thr = -112.5f - smax2_l[bh];
    int jlo = 0; bool found = false;
#pragma unroll
    for (int pass = 0; pass < 2; ++pass) { const int j = pass * 64 + lane; bool keep = true;
        if (j <= 4 * qb) { const float cend = (j == 0) ? cb[15] : bl[(j - 1) >> 1] + cb[64 * j + 63]; keep = !((cq - cend) <= thr); }
        const unsigned long long km = __ballot(keep);
        if (!found && km != 0ull) { jlo = pass * 64 + (int)__builtin_ctzll(km); found = true; } }
    return __builtin_amdgcn_readfirstlane(jlo);
}
struct FoxRef {
    int idx, jlo_;
    __device__ __forceinline__ int qb() const { return 31 - (idx >> 5); }
    __device__ __forceinline__ int bh() const { return idx & 31; }
    __device__ __forceinline__ unsigned qoff() const { const int h = idx & 15, b = (idx >> 4) & 1; return (unsigned)((((48 + h) * NB + b) * KVR + 64 + 256 * qb()) * 128); }
    __device__ __forceinline__ unsigned koff() const { const int h = idx & 15, b = (idx >> 4) & 1; return (unsigned)(((64 + h) * NB + b) * KVR * 128); }
    __device__ __forceinline__ unsigned voff() const { const int h = idx & 15, b = (idx >> 4) & 1; return (unsigned)(((80 + h) * NB + b) * KVR * 128); }
    __device__ __forceinline__ unsigned ooff() const { const int h = idx & 15, b = (idx >> 4) & 1; return (unsigned)((b * T + 256 * qb()) * (2 * DM) + 2048 + h * 128); }
    __device__ __forceinline__ unsigned coff() const { return (unsigned)(bh() * KVR); }
    __device__ __forceinline__ int P0() const { return 64 + 256 * qb(); }
    __device__ __forceinline__ int ldo() const { return DM; }
    __device__ __forceinline__ int boff() const { return LDSCTL_OFF + 4096 + bh() * 256; }
    __device__ __forceinline__ int jlo() const { return jlo_; }
};
struct FoxNext {
    int cidx, cjlo, nidx, njlo; bool pulled; int wv_, qx;
    unsigned* qh; volatile LAS int* slot; const float* cums; const LAS float* base_all; const LAS float* smax2_l;
    __device__ __forceinline__ void early(int t, int NT) { if (!pulled && t + 5 >= NT) { if (wv_ == 0 && att::fresh_lane() == 0) slot[0] = (int)atomicAdd(qh, 1u); pulled = true; } }
    __device__ __forceinline__ FoxRef operator()() { const int li = __builtin_amdgcn_readfirstlane(slot[0]); nidx = (li < 128) ? (((li >> 2) << 5) | (4 * qx + (li & 3))) : 1024; FoxRef r;
        if (nidx < 1024) { njlo = fox_jlo(nidx, cums, base_all, smax2_l, att::fresh_lane()); r.idx = nidx; r.jlo_ = njlo; } else { njlo = cjlo; r.idx = cidx; r.jlo_ = cjlo; }
        return r; }
};
constexpr int N_PHASES = 8;
#ifndef MK_FUSED
#define MK_FUSED 1
#endif

__device__ __forceinline__ const float* karg_f(int idx) {
    const char __attribute__((address_space(4)))* kb = (const char __attribute__((address_space(4)))*)__builtin_amdgcn_kernarg_segment_ptr();
    int off = 8 * idx; asm volatile("" : "+s"(off));
    return (const float*)(const __attribute__((address_space(1))) float*)*(const unsigned long long __attribute__((address_space(4)))*)(kb + off);
}
__global__ void __launch_bounds__(NWAVES * 64, 2) mk_fwd(Args args) {
    extern __shared__ __attribute__((aligned(16))) unsigned char lds_raw[];
    LAS unsigned char* lds = (LAS unsigned char*)lds_raw;
    volatile LAS unsigned* MISC = (volatile LAS unsigned*)(lds + MISC_OFF);
    const int wv = __builtin_amdgcn_readfirstlane((int)threadIdx.x >> 6);
    constexpr int G = 256;
    const int bx = blockIdx.x;
#define vcu ((bx % 8) * (G / 8) + bx / 8)
    constexpr int NGW = G * NWAVES;
#define LANE_IDS() const int tid = att::fresh_tid(wv), lane = tid & 63, wave = wv, gw = vcu * NWAVES + wave; (void)lane; (void)gw
#define T0() (wv == 0 && att::fresh_tid(0) == 0)
    unsigned char* ws = args.ws;
    gu32* ctl = (gu32*)(ws + WS_CTL);
    float* out = args.out;
    float* stats0 = (float*)(ws + WS_STATS0); float* stats1 = (float*)(ws + WS_STATS1);
    bf16* hmeta = (bf16*)(ws + WS_HMETA); bf16* wff = (bf16*)(ws + WS_WFF);
    float* ftot = (float*)(ws + WS_ZF); float* fmeta = ftot + NB * 64 * 16; float* cums = (float*)(ws + WS_CUMS);
    float* ropeC = (float*)(ws + WS_ROPE); float* ropeS = ropeC + (size_t)LSEQ * 64;
    bf16* Wup = (bf16*)(ws + WS_WUP); bf16* Wdn = (bf16*)(ws + WS_WDN); bf16* Wout = (bf16*)(ws + WS_WOUT); bf16* Win = (bf16*)(ws + WS_WIN);
    bf16* h0b = (bf16*)(ws + WS_H0B); bf16* mixb = (bf16*)out;     bf16* qkv = (bf16*)(ws + WS_QKV);
    bf16* part0 = (bf16*)(ws + WS_PART0); bf16* part1 = (bf16*)(ws + WS_PART1);
    bf16* h1b = (bf16*)(ws + WS_H1B); bf16* actb = (bf16*)(ws + WS_ACT);
    float* rpart = (float*)(ws + WS_RPART); float* upart = (float*)(ws + WS_UPART); float* cpart = (float*)(ws + WS_CPART); float* ucol = (float*)(ws + WS_UCOL); float* ccol = (float*)(ws + WS_CCOL);

    for (int u = threadIdx.x; u < (LDS_BYTES - LDSCTL_OFF) / 4; u += NWAVES * 64) ((LAS unsigned*)(lds + LDSCTL_OFF))[u] = 0u;
    __syncthreads();
#if MK_FUSED
#define OPQ1() ({ int one_; asm volatile("s_mov_b32 %0, 1" : "=s"(one_)); one_ != 0; })
    constexpr int lo = 0, hi = N_PHASES;
#else
    const int lo = args.ph_lo, hi = args.ph_hi;
#define OPQ1() true
#endif
    if (hi - lo > 1) (void)xcd_barrier_post((unsigned*)(ctl + CW_BAR), MISC + 8, T0());
#define MKBAR() XcdBarrier bar_; bar_.bar = (unsigned*)(ctl + CW_BAR); bar_.x = xb_xcc_id(); bar_.st = MISC + 8
#ifndef REP_PHASE
#define REP_PHASE (-1)
#endif
#define IN(k) (lo <= (k) && (k) < hi && OPQ1())
#if defined(PROBE_SPIN)
    volatile LAS unsigned long long* PW = (volatile LAS unsigned long long*)(lds + LDSCTL_OFF + 1024);
    if (bx == 0 && T0()) PW[31] = __builtin_amdgcn_s_memrealtime();
#ifndef PROBE_PH
#define PROBE_PH (-9)
#endif
#define PSTAMP(k) do { if constexpr (PROBE_PH < 0 || (k) == PROBE_PH || (k) == PROBE_PH - 1) { if (bx == 0 && T0()) { const unsigned long long n_ = __builtin_amdgcn_s_memrealtime(); PW[k] = n_ - PW[31]; PW[31] = n_; } } } while (0)
#if defined(PROBE_EPI)
#define PCOPY(j) do { if (bx == 0 && T0()) PW[j] = PW[16]; } while (0)
#else
#define PCOPY(j) do { } while (0)
#endif
#if defined(PROBE_CLK)
#define PCLK0() do { if (bx == 0 && T0()) { PW[29] = __builtin_amdgcn_s_memtime(); PW[30] = __builtin_amdgcn_s_memrealtime(); } } while (0)
#define PCLK1(j) do { if (bx == 0 && T0()) { PW[j] = (__builtin_amdgcn_s_memtime() - PW[29]) * 1000ull / (__builtin_amdgcn_s_memrealtime() - PW[30]); } } while (0)
#else
#define PCLK0() do { } while (0)
#define PCLK1(j) do { } while (0)
#endif
#else
#define PSTAMP(k) do { } while (0)
#define PCOPY(j) do { } while (0)
#define PCLK0() do { } while (0)
#define PCLK1(j) do { } while (0)
#endif
#define NREP(k) ((REP_PHASE == (k)) ? 2 : 1)
#if defined(PROBE_SPIN) && defined(PROBE_SPREAD)
#define SEAM(k) do { if (IN(k) && IN((k) + 1)) { MKBAR(); if ((k) == PROBE_SPREAD && T0()) { const unsigned long long v_ = (__builtin_amdgcn_s_memrealtime() << 10) | (unsigned long long)bx; \
            atomicMax((unsigned long long*)(ctl + 2052), v_); atomicMax((unsigned long long*)(ctl + 2054), (1ull << 62) - v_); } xcd_barrier(bar_, T0()); } } while (0)
#elif defined(PROBE_SPIN) && defined(PROBE_SEAM)
#ifndef PROBE_BLK
#define PROBE_BLK 0
#endif
#define SEAM(k) do { if (IN(k) && IN((k) + 1)) { MKBAR(); unsigned long long sb_ = 0; if ((k) == PROBE_SEAM && bx == PROBE_BLK && T0()) sb_ = __builtin_amdgcn_s_memrealtime(); xcd_barrier(bar_, T0()); \
        if ((k) == PROBE_SEAM && bx == PROBE_BLK && T0()) atomicExch((unsigned*)(ctl + 2048), (unsigned)(__builtin_amdgcn_s_memrealtime() - sb_)); } } while (0)
#else
#define SEAM(k) do { if (IN(k) && IN((k) + 1)) { MKBAR(); xcd_barrier(bar_, T0()); } } while (0)
#endif

    if (IN(0)) {
        LANE_IDS();
        const float* x = karg_f(0); const float* meta_tok = karg_f(1); const float* ln_in_g = karg_f(2); const float* ln_in_b = karg_f(3);
        const float* w_in = karg_f(4);
        LAS float* scr = (LAS float*)(lds + RING_OFF + wave * 16384);
        constexpr int I_IN = 64 * 385;
        for (int it = gw; it < I_IN; it += NGW) { const int kb = it / 385, nb = it % 385;
            if (nb < 384) p0_transpose_item(w_in, INW, DM, Win, scr, 64 * kb, 32 * nb, 32, 1, lane);
            else p0_transpose_item(w_in, INW, DM, wff, scr, 64 * kb, NPROJ, 16, 2, lane);
        }
        for (int m = 2 * gw; m < MR; m += 2 * NGW) ln_rows<2>(x + (size_t)m * DM, DM, ln_in_g, ln_in_b, lane, nullptr, h0b + (size_t)m * DM, stats0 + 2 * m, 2);
        if (gw < NMETA) ln_row(meta_tok + (size_t)gw * DM, ln_in_g, ln_in_b, lane, nullptr, hmeta + (size_t)gw * DM, nullptr);
        for (int idx = bx * (NWAVES * 64) + tid; idx < LSEQ * 64; idx += G * NWAVES * 64) {
            const int pos = idx >> 6, i = idx & 63; const float ang = (float)pos * INV_FREQ[i]; double sn, cs; sincos_d((double)ang, sn, cs);
            ropeC[idx] = (float)cs; ropeS[idx] = (float)sn; }
        if (gw < NGRP * NB) { GAS v4u* p = (GAS v4u*)(qkv + ((size_t)gw * KVR + 16) * 128);
#pragma unroll
            for (int j = 0; j < 12; ++j) p[64 * j + lane] = (v4u){0u, 0u, 0u, 0u}; }
    }
    SEAM(0); PSTAMP(0);

    if (IN(1)) {
        LANE_IDS();
        const int r16 = lane & 15, q4 = lane >> 4;
        if (bx < 128) {
            const float* b_forget = karg_f(5);
            LAS float* wt = (LAS float*)(lds + LDSCTL_OFF + 2048);
            const int m0 = 128 * bx + 16 * wave;
            const bf16* ap = h0b + (size_t)(m0 + r16) * DM + 8 * q4; const bf16* bp = wff + (size_t)r16 * DM + 8 * q4;
            f32x4 acc = {0.f, 0.f, 0.f, 0.f};
            for (int k0 = 0; k0 < DM; k0 += 512) {
                bf16x8 av[16], bv[16];
#pragma unroll
                for (int j = 0; j < 16; ++j) { av[j] = *(const bf16x8*)(ap + k0 + 32 * j); bv[j] = *(const bf16x8*)(bp + k0 + 32 * j); }
                __builtin_amdgcn_sched_barrier(0);
#pragma unroll
                for (int j = 0; j < 16; ++j) acc = __builtin_amdgcn_mfma_f32_16x16x32_bf16(av[j], bv[j], acc, 0, 0, 0);
                __builtin_amdgcn_sched_barrier(0); }
            const float bfg = b_forget[r16];
            const float lf0 = log_sigmoid(acc[0] + bfg), lf1 = lf0 + log_sigmoid(acc[1] + bfg), lf2 = lf1 + log_sigmoid(acc[2] + bfg), lf3 = lf2 + log_sigmoid(acc[3] + bfg);
            float s = lf3; { const float u = lane_up(s, 16, lane); if (q4 >= 1) s += u; } { const float u = lane_up(s, 32, lane); if (q4 >= 2) s += u; }
            const float exg = s - lf3;
            if (q4 == 3) wt[wave * 16 + r16] = s;
            __syncthreads();
            float wex = 0.f, wall = 0.f;
#pragma unroll
            for (int w2 = 0; w2 < NWAVES; ++w2) { const float v = wt[w2 * 16 + r16]; wall += v; if (w2 < wave) wex += v; }
            const int b = m0 >> 13, t0 = (m0 & 8191) + 4 * q4; float* cp = cums + (size_t)(b * NFH + r16) * KVR + 64 + t0; const float o = wex + exg;
            cp[0] = o + lf0; cp[1] = o + lf1; cp[2] = o + lf2; cp[3] = o + lf3;
            if (wave == 0 && q4 == 0) ftot[(size_t)(b * 64 + (bx & 63)) * 16 + r16] = wall;
        } else if (bx < 128 + 96) {
            const int pn = (bx - 128) >> 1, hh = (bx - 128) & 1, wq = wave & 3, kh = wave >> 2, s = 64 * hh + 16 * wq + r16;
            const bf16* ap = hmeta + (size_t)r16 * DM + 8 * q4 + 2048 * kh; const bf16* bp0 = Win + (size_t)(256 * pn + s) * DM + 8 * q4 + 2048 * kh; const bf16* bp1 = bp0 + (size_t)128 * DM;
            f32x4 a0 = {0.f, 0.f, 0.f, 0.f}, a1 = {0.f, 0.f, 0.f, 0.f};
            for (int k0 = 0; k0 < DM / 2; k0 += 512) {
                bf16x8 av[16], b0v[16], b1v[16];
#pragma unroll
                for (int j = 0; j < 16; ++j) { av[j] = *(const bf16x8*)(ap + k0 + 32 * j); b0v[j] = *(const bf16x8*)(bp0 + k0 + 32 * j); b1v[j] = *(const bf16x8*)(bp1 + k0 + 32 * j); }
                __builtin_amdgcn_sched_barrier(0);
#pragma unroll
                for (int j = 0; j < 16; ++j) { a0 = __builtin_amdgcn_mfma_f32_16x16x32_bf16(av[j], b0v[j], a0, 0, 0, 0); a1 = __builtin_amdgcn_mfma_f32_16x16x32_bf16(av[j], b1v[j], a1, 0, 0, 0); }
                __builtin_amdgcn_sched_barrier(0); }
            { LAS f32x4* xch = (LAS f32x4*)(lds + RING_OFF) + (wq * 64 + lane) * 2;
              if (kh == 1) { xch[0] = a0; xch[1] = a1; }
              __syncthreads();
              if (kh == 0) { a0 = a0 + xch[0]; a1 = a1 + xch[1]; } }
            if (kh == 0) {
#pragma unroll
            for (int rg = 0; rg < 4; ++rg) { const int i = 4 * q4 + rg;
                if (pn < 16) { const int hh = s >> 6, dl = s & 63, g = 2 * pn + hh; const float c = ropeC[i * 64 + dl], sn = ropeS[i * 64 + dl];
                    const unsigned o1 = f2bf(a0[rg] * c - a1[rg] * sn), o2 = f2bf(a1[rg] * c + a0[rg] * sn);
#pragma unroll
                    for (int b = 0; b < NB; ++b) { bf16* p = qkv + ((size_t)(g * NB + b) * KVR + i) * 128 + dl; p[0] = (bf16)o1; p[64] = (bf16)o2; }
                } else {
#pragma unroll
                    for (int b = 0; b < NB; ++b) { qkv[((size_t)((2 * pn) * NB + b) * KVR + i) * 128 + s] = (bf16)f2bf(a0[rg]); qkv[((size_t)((2 * pn + 1) * NB + b) * KVR + i) * 128 + s] = (bf16)f2bf(a1[rg]); }
                } }
            if (pn >= 32 && pn < 40) {
                float m0 = 0.f, m1 = 0.f;
#pragma unroll
                for (int rg = 0; rg < 4; ++rg) { float s0 = a0[rg] * a0[rg], s1 = a1[rg] * a1[rg];
#pragma unroll
                    for (int o = 1; o < 16; o <<= 1) { s0 += lane_xor(s0, o, lane); s1 += lane_xor(s1, o, lane); }
                    m0 = fmaxf(m0, s0); m1 = fmaxf(m1, s1); }
                m0 = fmaxf(m0, lane_xor(m0, 16, lane)); m0 = fmaxf(m0, lane_xor(m0, 32, lane)); m1 = fmaxf(m1, lane_xor(m1, 16, lane)); m1 = fmaxf(m1, lane_xor(m1, 32, lane));
                if (lane == 0) { gu32* nrm = ctl + CW_NRM;
#pragma unroll
                    for (int b = 0; b < NB; ++b) { atomicMax((unsigned*)nrm + ((2 * pn - 48) * NB + b) * 16 + 4 + 4 * hh + wq, __float_as_uint(m0 * 1.02f)); atomicMax((unsigned*)nrm + ((2 * pn + 1 - 48) * NB + b) * 16 + 4 + 4 * hh + wq, __float_as_uint(m1 * 1.02f)); } }
            }
            }
            __syncthreads();
        } else if (bx == 224) {
            const float* b_forget = karg_f(5);
            const bf16* ap = hmeta + (size_t)r16 * DM + 8 * q4 + 512 * wave; const bf16* bp = wff + (size_t)r16 * DM + 8 * q4 + 512 * wave;
            f32x4 acc = {0.f, 0.f, 0.f, 0.f};
            {   bf16x8 av[16], bv[16];
#pragma unroll
                for (int j = 0; j < 16; ++j) { av[j] = *(const bf16x8*)(ap + 32 * j); bv[j] = *(const bf16x8*)(bp + 32 * j); }
                __builtin_amdgcn_sched_barrier(0);
#pragma unroll
                for (int j = 0; j < 16; ++j) acc = __builtin_amdgcn_mfma_f32_16x16x32_bf16(av[j], bv[j], acc, 0, 0, 0);
                __builtin_amdgcn_sched_barrier(0); }
            LAS f32x4* xch = (LAS f32x4*)(lds + RING_OFF);
            xch[wave * 64 + lane] = acc;
            __syncthreads();
            if (wave == 0) {
#pragma unroll
                for (int w2 = 1; w2 < NWAVES; ++w2) acc = acc + xch[w2 * 64 + lane];
                const float bfg = b_forget[r16];
                const float lf0 = log_sigmoid(acc[0] + bfg), lf1 = lf0 + log_sigmoid(acc[1] + bfg), lf2 = lf1 + log_sigmoid(acc[2] + bfg), lf3 = lf2 + log_sigmoid(acc[3] + bfg);
                float s = lf3; { const float u = lane_up(s, 16, lane); if (q4 >= 1) s += u; } { const float u = lane_up(s, 32, lane); if (q4 >= 2) s += u; }
                const float exg = s - lf3;
#pragma unroll
                for (int b = 0; b < NB; ++b) { float* cp = cums + (size_t)(b * NFH + r16) * KVR + 4 * q4; cp[0] = exg + lf0; cp[1] = exg + lf1; cp[2] = exg + lf2; cp[3] = exg + lf3; }
                if (q4 == 3) fmeta[r16] = s;
            }
            __syncthreads();
        }
        pg8::Gemm g{h0b, Win, MR, NPROJ, DM}; pg8::StaticOrder S; S.init(MR, NPROJ, G, bx);
        pg8::EpiProj E{qkv, ropeC, ropeS, KVR, NB, (unsigned*)(ctl + CW_NRM)};
        xcd_stagger(STAG_BF);
        pg8::gemm_phase<pg8::EpiProj, pg8::StaticOrder, PG8_ALIGN, PG8_SP2>(lds + RING_OFF, g, S, E, wv); PCOPY(17);
    }
    if (IN(1) && IN(2)) {
        LANE_IDS();
        asm volatile("s_waitcnt vmcnt(0)" ::: "memory"); __syncthreads();
        if (T0()) { __builtin_amdgcn_s_waitcnt(0); __builtin_amdgcn_fence(__ATOMIC_RELEASE, "agent"); asm volatile("s_waitcnt vmcnt(0)" ::: "memory"); (void)xb_add((unsigned*)(ctl + CW_FLAT), 1u); }
        int nbd = 0;
        for (;;) {
            if (T0()) MISC[13] = (xb_ld((unsigned*)(ctl + CW_FLAT)) >= 256u) ? 1u : 0u;
            __syncthreads(); const unsigned arrived = MISC[13]; __syncthreads();
            if (arrived || nbd == CONV_NB) break;
            late_weight_conv(karg_f(11), karg_f(14), karg_f(15), Wout, Wup, Wdn, (LAS float*)(lds + RING_OFF + wave * 16384), gw, lane, karg_f(12), karg_f(13), upart, cpart, nbd, nbd + 1); ++nbd;
        }
        if (T0()) { unsigned* bar = (unsigned*)(ctl + CW_BAR); XB_SPIN(xb_ld((unsigned*)(ctl + CW_FLAT)) < 256u, bar); __builtin_amdgcn_fence(__ATOMIC_ACQUIRE, "agent"); asm volatile("s_waitcnt vmcnt(0)" ::: "memory"); MISC[12] = (unsigned)nbd; }
        __syncthreads();
    }
    PSTAMP(1);

    if (IN(2)) {
        PCLK0();
        const ABS AB{(const att::bf16*)qkv, (att::bf16*)out, cums};
        LAS float* base_all = (LAS float*)(lds + LDSCTL_OFF + 4096);
        LAS float* smax2_l = (LAS float*)(lds + LDSCTL_OFF + 12288);
        volatile LAS int* qslot = (volatile LAS int*)(lds + LDSCTL_OFF + 12288 + 128);
#define QSLOT() ({ int qo_ = LDSCTL_OFF + 12288 + 128; asm volatile("" : "+s"(qo_)); (volatile LAS int*)(lds + qo_); })
        gu32* qh = ctl + CW_QUEUE;
        if (((bx >> 3) & 1) == 0) { LANE_IDS(); late_weight_conv(karg_f(11), karg_f(14), karg_f(15), Wout, Wup, Wdn, (LAS float*)(lds + RING_OFF + wave * 16384), gw, lane, karg_f(12), karg_f(13), upart, cpart, (IN(1) ? (int)MISC[12] : 0), CONV_NB); __syncthreads(); }
        int ci = 0;
        {   LANE_IDS();
#pragma unroll
            for (int k = 0; k < 4; ++k) { const int bh = wave * 4 + k, b = bh >> 4, h = bh & 15;
                const float v = ftot[(size_t)(b * 64 + lane) * 16 + h]; float s = v;
#pragma unroll
                for (int o = 1; o < 64; o <<= 1) { const float u = lane_up(s, o, lane); if (lane >= o) s += u; }
                base_all[bh * 64 + lane] = fmeta[h] + (s - v); }
            if (tid < 32) { const int b = tid >> 4, h = tid & 15; const gu32* nq = ctl + CW_NRM + (h * NB + b) * 16; const gu32* nk = ctl + CW_NRM + ((16 + h) * NB + b) * 16;
                float q2 = 0.f, k2 = 0.f, km2 = 0.f;
#pragma unroll
                for (int s = 0; s < 4; ++s) { q2 += __uint_as_float(nq[s]); k2 += __uint_as_float(nk[s]); }
#pragma unroll
                for (int s = 4; s < 12; ++s) km2 += __uint_as_float(nk[s]);
                smax2_l[tid] = 2.f * sqrtf(q2 * fmaxf(k2, km2)) * att::SCALE; }
            __syncthreads();
        }
#define XCC() ((int)(xb_xcc_id() & 7u))
#pragma unroll 1
        for (int kq = 0; kq < 8; ++kq) {
          const int qx = (XCC() + kq) & 7;
#pragma unroll 1
          for (;;) {
            __syncthreads();
            if (T0()) qslot[0] = (int)atomicAdd((unsigned*)(ctl + CW_QUEUE2 + 64 * qx), 1u);
            __syncthreads();
            ci = qslot[0];
            if (ci >= 64) break;
            const int qb = 31 - (ci >> 1), rr = 2 * qx + (ci & 1);
#pragma unroll 1
            for (int c = 0; c < 2; ++c) { const att::DiffRef R = mkref_diff(rr, c, qb); att::diff_block(R, (const att::bf16*)qkv, (att::bf16*)ws, 2048, (char*)lds_raw, wv); }
            asm volatile("s_waitcnt vmcnt(0)" ::: "memory"); __syncthreads();
            {   LANE_IDS();
                const float* lq1 = karg_f(6); const float* lk1 = karg_f(7); const float* lq2 = karg_f(8); const float* lk2 = karg_f(9); const float* subln_g = karg_f(10);
                const float s1 = wave_sum(lq1[lane] * lk1[lane] + lq1[lane + 64] * lk1[lane + 64], lane), s2 = wave_sum(lq2[lane] * lk2[lane] + lq2[lane + 64] * lk2[lane + 64], lane);
                const float lam = expf(s1) - expf(s2) + LAMBDA_INIT;
                const f32x4 gl = *(const f32x4*)(subln_g + 4 * lane) * (1.0f - LAMBDA_INIT);
                const int b = rr >> 3, h = rr & 7; const size_t m0 = (size_t)b * T + 256 * qb + 32 * wave;
#pragma unroll 4
                for (int r = 0; r < 32; ++r) { const size_t m = m0 + r;
                    const unsigned long long u0 = *((const GAS unsigned long long*)(part0 + m * 2048 + h * 256) + lane), u1 = *((const GAS unsigned long long*)(part1 + m * 2048 + h * 256) + lane);
                    f32x4 d; d.x = bf2f((unsigned)u0 & 0xffffu) - lam * bf2f((unsigned)u1 & 0xffffu); d.y = bf2f(((unsigned)u0 >> 16)) - lam * bf2f(((unsigned)u1 >> 16));
                    d.z = bf2f((unsigned)(u0 >> 32) & 0xffffu) - lam * bf2f((unsigned)(u1 >> 32) & 0xffffu); d.w = bf2f((unsigned)(u0 >> 48)) - lam * bf2f((unsigned)(u1 >> 48));
                    const float ss = wave_sum((d.x * d.x + d.y * d.y) + (d.z * d.z + d.w * d.w), lane);
                    const float rq = 1.f / sqrtf(ss * (1.f / 256.f) + SUBLN_EPS);
                    const f32x4 o = d * rq * gl;
                    *((GAS unsigned long long*)(mixb + ((m >> 8) * 512 + (m & 255)) * DM + h * 256) + lane) = (unsigned long long)pk2(o.x, o.y) | ((unsigned long long)pk2(o.z, o.w) << 32); }
            }
          }
        }
        if (((bx >> 3) & 1) == 1) { __syncthreads(); LANE_IDS(); late_weight_conv(karg_f(11), karg_f(14), karg_f(15), Wout, Wup, Wdn, (LAS float*)(lds + RING_OFF + wave * 16384), gw, lane, karg_f(12), karg_f(13), upart, cpart, (IN(1) ? (int)MISC[12] : 0), CONV_NB); __syncthreads(); }
#pragma unroll 1
        for (int kf = 0; kf < 8; ++kf) {
            const int qxf = ((int)(xb_xcc_id() & 7u) + kf) & 7;
            __syncthreads();
            if (T0()) QSLOT()[0] = (int)atomicAdd((unsigned*)(ctl + CW_QUEUE3 + 64 * qxf), 1u);
            __syncthreads();
            const int li0 = QSLOT()[0];
            if (li0 >= 128) continue;
            ci = ((li0 >> 2) << 5) | (4 * qxf + (li0 & 3));
            att::Seam<att::bf16> S; S.st_b = 0.f; int cj = fox_jlo(ci, cums, base_all, smax2_l, att::fresh_lane());
            { FoxRef cur; cur.idx = ci; cur.jlo_ = cj; att::causal_swa_prime<att::bf16, att::bf16, 1, FoxRef>(cur, AB, 1 << 30, (char*)lds_raw, S, wv); }
#pragma unroll 1
            for (;;) {
                FoxNext nf; nf.cidx = ci; nf.cjlo = cj; nf.nidx = 1024; nf.njlo = 0; nf.pulled = false; nf.wv_ = wv; nf.qx = qxf; nf.qh = (unsigned*)(ctl + CW_QUEUE3 + 64 * qxf); nf.slot = qslot; nf.cums = cums; nf.base_all = base_all; nf.smax2_l = smax2_l;
                { FoxRef cur; cur.idx = ci; cur.jlo_ = cj; att::causal_swa_block<att::bf16, att::bf16, 1, FoxRef, FoxNext>(cur, nf, AB, KVR, 1 << 30, (char*)lds_raw, S, wv); }
                if (nf.nidx >= 1024) break;
                ci = nf.nidx; cj = nf.njlo;
            }
        }
    }
    PCLK1(22);
    SEAM(2); PSTAMP(2);

    if (IN(3)) {
        {   LANE_IDS();
            LAS float* red = (LAS float*)(lds + LDSCTL_OFF + 4096);
            const int nl = tid & 63, ch = tid >> 6, n = bx * 64 + nl; float us = 0.f, cs = 0.f;
#pragma unroll
            for (int kb = 0; kb < 8; ++kb) { us += upart[(size_t)(8 * ch + kb) * FFW + n]; cs += cpart[(size_t)(8 * ch + kb) * FFW + n]; }
            red[ch * 64 + nl] = us; red[512 + ch * 64 + nl] = cs;
            __syncthreads();
            if (tid < 128) { const LAS float* r = red + (tid >> 6) * 512 + nl; float a = 0.f;
#pragma unroll
                for (int k2 = 0; k2 < 8; ++k2) a += r[k2 * 64];
                __hip_atomic_store((tid < 64 ? ucol : ccol) + n, a, RLX_AGENT); }
            asm volatile("s_waitcnt vmcnt(0)" ::: "memory"); __syncthreads();
            if (T0()) (void)xb_add((unsigned*)(ctl + CW_UC), 1u); }
        const float* x = karg_f(0); const float* ln_in_g = karg_f(2); const float* ln_in_b = karg_f(3);
        pg8::Gemm g{mixb, Wout, MR, DM, DM, 1}; pg8::StaticOrder S; S.init(MR, DM, G, bx);
        pg8::EpiOutS E{x, stats0, ln_in_g, ln_in_b, h1b, DM, DN_ALPHA, rpart};
        pg8::gemm_phase<pg8::EpiOutS, pg8::StaticOrder, PG8_ALIGN, PG8_SP2>(lds + RING_OFF, g, S, E, wv); PCOPY(18);
    }
    if (IN(3) && IN(5)) grp_barrier(ctl, 2, bx, T0());
    PSTAMP(3);

    PSTAMP(4);

    if (IN(5)) {
        pg8::Gemm g{h1b, Wup, MR, FFW, DM}; pg8::StaticOrder S; S.init(MR, FFW, G, bx);
        LAS float* st1 = (LAS float*)(lds + LDSCTL_OFF + 4096);
        {   LANE_IDS(); pg8::Unit u0; S.next(0, u0);
            const int rl = tid >> 1, hf = tid & 1, row = u0.pm * 256 + rl; const GAS f32x4* p = (const GAS f32x4*)(rpart + (size_t)row * 128 + 64 * hf);
            float s1 = 0.f, s2 = 0.f;
#pragma unroll
            for (int i = 0; i < 16; ++i) { const f32x4 v = p[i]; s1 += v.x + v.z; s2 += v.y + v.w; }
            s1 += lane_xor(s1, 1, lane); s2 += lane_xor(s2, 1, lane);
            const float mean = s1 * (1.f / DM), var = fmaxf(s2 * (1.f / DM) - mean * mean, 0.f), rstd = 1.f / sqrtf(var + LN_EPS);
            if (hf == 0) { st1[2 * rl] = mean; st1[2 * rl + 1] = rstd; if (bx < 64) { stats1[2 * row] = mean; stats1[2 * row + 1] = rstd; } }
            if (T0()) { unsigned* bar = (unsigned*)(ctl + CW_BAR); XB_SPIN(xb_ld((unsigned*)(ctl + CW_UC)) < 256u, bar); __builtin_amdgcn_fence(__ATOMIC_ACQUIRE, "agent"); asm volatile("s_waitcnt vmcnt(0)" ::: "memory"); }
            __syncthreads(); }
        pg8::EpiUpS E{actb, FFW, ucol, ccol, st1};
        xcd_stagger(STAG_BF);
        PCLK0();
        pg8::gemm_phase<pg8::EpiUpS, pg8::StaticOrder, PG8_ALIGN, PG8_SP2>(lds + RING_OFF, g, S, E, wv); PCOPY(19); PCLK1(21);
    }
    if (IN(5) && IN(6)) grp_barrier(ctl, 0, bx, T0());
    PSTAMP(5);

    if (IN(6)) {
        const float* ln_attn_g = karg_f(12); const float* ln_attn_b = karg_f(13);
        pg8::Gemm g{actb, Wdn, MR, DM, FFW}; pg8::StaticOrder S; S.init(MR, DM, G, bx);
        pg8::EpiDownB E{h1b, (bf16*)out + DM, stats1, ln_attn_g, ln_attn_b, DM, DN_ALPHA, 2 * DM};
        pg8::gemm_phase<pg8::EpiDownB, pg8::StaticOrder, PG8_ALIGN, PG8_SP2>(lds + RING_OFF, g, S, E, wv); PCOPY(20);
    }
    if (IN(6) && IN(7)) grp_barrier(ctl, 1, bx, T0());
    PSTAMP(6);

    if (IN(7)) { PCLK0(); LANE_IDS(); const float* ln_mlp_g = karg_f(16); const float* ln_mlp_b = karg_f(17);
        const int m0 = (8 * (bx & 7) + ((bx >> 3) & 7)) * 256 + 64 * (bx >> 6) + 8 * wave;
#pragma unroll 1
        for (int m = m0; m < m0 + 8; m += 2) ln_rows_b<2>((const bf16*)out + (size_t)m * (2 * DM) + DM, 2 * DM, ln_mlp_g, ln_mlp_b, lane, out + (size_t)m * DM, nullptr, nullptr, 0, DM); }
    PCLK1(23); PSTAMP(7);
#if defined(PROBE_SPIN)
#ifndef PROBE_MUL
#define PROBE_MUL 1
#endif
#ifndef PROBE_DIV
#define PROBE_DIV 1
#endif
    const unsigned PSEAM = __hip_atomic_load((unsigned*)(ctl + 2048), __ATOMIC_RELAXED, __HIP_MEMORY_SCOPE_AGENT); (void)PSEAM;
    const unsigned long long PMAXV = __hip_atomic_load((unsigned long long*)(ctl + 2052), __ATOMIC_RELAXED, __HIP_MEMORY_SCOPE_AGENT), PMINV = (1ull << 62) - __hip_atomic_load((unsigned long long*)(ctl + 2054), __ATOMIC_RELAXED, __HIP_MEMORY_SCOPE_AGENT);
    const unsigned long long PSPREAD = (PMAXV >> 10) - (PMINV >> 10), PLASTBLK = PMAXV & 1023ull, PFIRSTBLK = PMINV & 1023ull; (void)PSPREAD; (void)PLASTBLK; (void)PFIRSTBLK;
    if (bx == 0 && T0()) { const unsigned long long w = (unsigned long long)(PROBE_SPIN) * PROBE_MUL / PROBE_DIV, t0 = __builtin_amdgcn_s_memrealtime();
        while (__builtin_amdgcn_s_memrealtime() - t0 < w) __builtin_amdgcn_s_sleep(8); }
#endif
#undef IN
#undef SEAM
}

extern "C" void kernel_launch(void* const* d_in, const int* in_sizes, int n_in, void* d_out, int out_size, void* d_ws, size_t ws_size, hipStream_t stream) {
    static int grid = 0;
    if (grid == 0) {
        if (n_in != 18 || in_sizes[0] != MR * DM || out_size != MR * DM || ws_size < WS_END) { fprintf(stderr, "kernel_launch: shape/workspace mismatch (n_in %d, in0 %d, out %d, ws %zu < %zu)\n", n_in, n_in > 0 ? in_sizes[0] : -1, out_size, ws_size, (size_t)WS_END); grid = -1; return; }
        if (hipFuncSetAttribute((const void*)mk_fwd, hipFuncAttributeMaxDynamicSharedMemorySize, LDS_BYTES) != hipSuccess) { fprintf(stderr, "kernel_launch: hipFuncSetAttribute failed\n"); grid = -1; return; }
        int per_cu = 0;
        if (hipOccupancyMaxActiveBlocksPerMultiprocessor(&per_cu, (const void*)mk_fwd, NWAVES * 64, LDS_BYTES) != hipSuccess || per_cu < 1) fprintf(stderr, "kernel_launch: occupancy query reports %d\n", per_cu);
        (void)hipGetLastError();
        grid = 256;
    }
    if (grid < 0) return;
    if (hipMemsetAsync((char*)d_ws + WS_CTL, 0, CTL_ZERO_BYTES, stream) != hipSuccess) { fprintf(stderr, "kernel_launch: memset failed\n"); return; }
    Args a{};
    for (int i = 0; i < 18; ++i) a.in[i] = (const float*)d_in[i];
    a.out = (float*)d_out; a.ws = (unsigned char*)d_ws;
#if MK_FUSED
    a.ph_lo = 0; a.ph_hi = N_PHASES;
    hipLaunchKernelGGL(mk_fwd, dim3(grid), dim3(NWAVES * 64), LDS_BYTES, stream, a);
#else
    for (int p = 0; p < N_PHASES; ++p) { a.ph_lo = p; a.ph_hi = p + 1;
        for (int r = 0; r < ((p == REP_PHASE) ? 2 : 1); ++r) hipLaunchKernelGGL(mk_fwd, dim3(grid), dim3(NWAVES * 64), LDS_BYTES, stream, a); }
#endif
    const hipError_t le = hipPeekAtLastError();
    if (le != hipSuccess) fprintf(stderr, "kernel_launch: launch failed: %s\n", hipGetErrorName(le));
}
```

```cpp
#include <hip/hip_runtime.h>
#include <hip/hip_bf16.h>
#include <cstdio>
#include <cstdint>
#include <cmath>
#ifndef MK_FUSED
#define MK_FUSED 1
#endif
#ifndef REP_PHASE
#define REP_PHASE -1
#endif
#if 1
#endif
__device__ __forceinline__ int mk_lane_id() { return (int)__builtin_amdgcn_mbcnt_hi(~0u, __builtin_amdgcn_mbcnt_lo(~0u, 0u)); }
namespace pg8 {
#define PG8_LAS __attribute__((address_space(3)))
typedef unsigned short bf16_t;
typedef short bf16x8 __attribute__((ext_vector_type(8)));
typedef float f32x4 __attribute__((ext_vector_type(4)));
typedef unsigned u32x4 __attribute__((ext_vector_type(4)));
constexpr int BM = 256, BK = 64, HALF = 128, HTB = HALF * BK * 2  , STAGE_BYTES = 8 * HTB, NXCD = 8, WGM = 8;

__host__ __device__ __forceinline__ int lds_byte(int r, int c) { const int st = (r >> 4) * 2 + (c >> 5), rr = r & 15, cc = c & 31, ob = rr * 64 + cc * 2; return st * 1024 + (ob ^ (((ob >> 9) & 1) << 5)); }
__host__ __device__ __forceinline__ void stage_rc(int b, int& R, int& C) { const int st = b / 1024, sb = b % 1024, swz = sb ^ (((sb >> 9) & 1) << 5); R = (st >> 1) * 16 + swz / 64; C = (st & 1) * 32 + (swz % 64) / 2; }
__host__ __device__ __forceinline__ int perm32(int rho) { const int n = rho >> 4, i = rho & 15; return 8 * (i >> 2) + 4 * n + (i & 3); }

struct Unit { int pm, pn; };
struct Gemm { const bf16_t* A; const bf16_t* Bt; int M, N, K; int ashift; };

struct StaticOrder {
    int nM, nN, nwg, G, c;
    __host__ __device__ void init(int M, int N, int G_, int c_) { nM = M / BM; nN = N / BM; nwg = nM * nN; G = G_; c = c_; }
    __host__ __device__ bool next(int i, Unit& u) const {
        const long L = (long)i * G + c; if (L >= nwg) return false;
        int wgid = (int)L; { const int q = nwg / NXCD, r = nwg % NXCD, xcd = wgid % NXCD, off = wgid / NXCD; wgid = (xcd < r ? xcd * (q + 1) : r * (q + 1) + (xcd - r) * q) + off; }
        const int nig = WGM * nN, gid = wgid / nig, fm = gid * WGM, gsz = (nM - fm) < WGM ? (nM - fm) : WGM;
        u.pm = fm + ((wgid % nig) % gsz); u.pn = (wgid % nig) / gsz; return true;
    }
    __device__ __forceinline__ void a_ready(const Unit&) const {}
    __device__ __forceinline__ void done(const Unit&) const {}
};

__device__ __forceinline__ unsigned cvt_pk_bf16(float lo, float hi) { unsigned r; asm volatile("v_cvt_pk_bf16_f32 %0, %1, %2" : "=v"(r) : "v"(lo), "v"(hi)); return r; }
__device__ __forceinline__ u32x4 pack8bf(const f32x4 v0, const f32x4 v1) { u32x4 w; w.x = cvt_pk_bf16(v0[0], v0[1]); w.y = cvt_pk_bf16(v0[2], v0[3]); w.z = cvt_pk_bf16(v1[0], v1[1]); w.w = cvt_pk_bf16(v1[2], v1[3]); return w; }

struct EpiProj {
    static constexpr bool PERM = true, AFTER_DRAIN = false, PREFETCH = false;
    bf16_t* QKV; const float* ropeC; const float* ropeS; int kvr, nb; unsigned* nrm;
    __device__ __forceinline__ void operator()(const f32x4 (&acc)[2][2][4][2], const Unit& u, int wr, int wc, int fr, int fq) const {
        const int m0 = u.pm * BM, b = m0 >> 13, t0 = (m0 & 8191) + wr * 64 + fr;
        if (u.pn < 16) {
            const int hh = wc >> 1, dl0 = 32 * (wc & 1) + 8 * fq, g = 2 * u.pn + hh;
            bf16_t* base = QKV + ((size_t)(g * nb + b) * kvr + 64) * 128 + dl0;
#pragma unroll
            for (int ai = 0; ai < 2; ++ai)
#pragma unroll
                for (int m = 0; m < 4; ++m) { const int t = t0 + ai * HALF + m * 16; const float* cp = ropeC + (size_t)(16 + t) * 64 + dl0; const float* sp = ropeS + (size_t)(16 + t) * 64 + dl0;
                    const f32x4 c0 = *(const f32x4*)cp, c1 = *(const f32x4*)(cp + 4), s0 = *(const f32x4*)sp, s1 = *(const f32x4*)(sp + 4);
                    const f32x4 x1a = acc[ai][0][m][0], x1b = acc[ai][0][m][1], x2a = acc[ai][1][m][0], x2b = acc[ai][1][m][1];
                    const f32x4 o1a = x1a * c0 - x2a * s0, o1b = x1b * c1 - x2b * s1, o2a = x2a * c0 + x1a * s0, o2b = x2b * c1 + x1b * s1;
                    bf16_t* rowp = base + (size_t)t * 128;
                    *(u32x4*)rowp = pack8bf(o1a, o1b); *(u32x4*)(rowp + 64) = pack8bf(o2a, o2b); }
        } else {
#pragma unroll
            for (int bj = 0; bj < 2; ++bj) { const int g = 2 * u.pn + bj; bf16_t* base = QKV + ((size_t)(g * nb + b) * kvr + 64) * 128 + 32 * wc + 8 * fq;
#pragma unroll
                for (int ai = 0; ai < 2; ++ai)
#pragma unroll
                    for (int m = 0; m < 4; ++m) { const int t = t0 + ai * HALF + m * 16; *(u32x4*)(base + (size_t)t * 128) = pack8bf(acc[ai][bj][m][0], acc[ai][bj][m][1]); } }
            if (u.pn >= 24 && u.pn < 40) {
#pragma unroll
                for (int bj = 0; bj < 2; ++bj) { float mx = 0.f;
#pragma unroll
                    for (int ai = 0; ai < 2; ++ai)
#pragma unroll
                        for (int m = 0; m < 4; ++m) { const f32x4 a = acc[ai][bj][m][0], c = acc[ai][bj][m][1];
                            float ss = (a[0] * a[0] + a[1] * a[1]) + (a[2] * a[2] + a[3] * a[3]) + (c[0] * c[0] + c[1] * c[1]) + (c[2] * c[2] + c[3] * c[3]);
                            ss += __shfl_xor(ss, 16); ss += __shfl_xor(ss, 32); mx = fmaxf(mx, ss); }
                    mx = fmaxf(mx, __shfl_xor(mx, 1)); mx = fmaxf(mx, __shfl_xor(mx, 2)); mx = fmaxf(mx, __shfl_xor(mx, 4)); mx = fmaxf(mx, __shfl_xor(mx, 8));
                    if (fr == 0 && fq == 0) atomicMax(nrm + ((2 * u.pn + bj - 48) * nb + b) * 16 + wc, __float_as_uint(mx * 1.02f)); }
            }
        }
    }
};
struct EpiOut {
    static constexpr bool PERM = false, AFTER_DRAIN = false;
    const float* X; const float* stats; const float* g; const float* bta; float* Y; int ldc; float alpha;
    __device__ __forceinline__ void operator()(const f32x4 (&acc)[2][2][4][2], const Unit& u, int wr, int wc, int fr, int fq) const {
        const int row0 = u.pm * BM + wr * 64 + fr, col0 = u.pn * BM + wc * 32 + 4 * fq;
        f32x4 gv[2][2], bv[2][2];
#pragma unroll
        for (int bj = 0; bj < 2; ++bj)
#pragma unroll
            for (int n = 0; n < 2; ++n) { gv[bj][n] = *(const f32x4*)(g + col0 + bj * HALF + n * 16); bv[bj][n] = *(const f32x4*)(bta + col0 + bj * HALF + n * 16); }
#pragma unroll
        for (int ai = 0; ai < 2; ++ai)
#pragma unroll
            for (int m = 0; m < 4; ++m) { const int r = row0 + ai * HALF + m * 16; const float mu = stats[2 * r], rs = stats[2 * r + 1] * alpha; const size_t off = (size_t)r * ldc + col0;
#pragma unroll
                for (int bj = 0; bj < 2; ++bj)
#pragma unroll
                    for (int n = 0; n < 2; ++n) { const f32x4 xv = *(const f32x4*)(X + off + bj * HALF + n * 16);
                        *(f32x4*)(Y + off + bj * HALF + n * 16) = (xv - mu) * rs * gv[bj][n] + bv[bj][n] * alpha + acc[ai][bj][m][n]; }
                if (m & 1) asm volatile("" ::: "memory"); }
    }
};
struct EpiUp {
    static constexpr bool PERM = true, AFTER_DRAIN = false;
    bf16_t* O; int ldc;
    __device__ __forceinline__ void operator()(const f32x4 (&acc)[2][2][4][2], const Unit& u, int wr, int wc, int fr, int fq) const {
        const int row0 = u.pm * BM + wr * 64 + fr, col0 = u.pn * BM + wc * 32 + 8 * fq;
#pragma unroll
        for (int ai = 0; ai < 2; ++ai)
#pragma unroll
            for (int m = 0; m < 4; ++m) { bf16_t* rowp = O + (size_t)(row0 + ai * HALF + m * 16) * ldc + col0;
#pragma unroll
                for (int bj = 0; bj < 2; ++bj) { f32x4 v0 = acc[ai][bj][m][0], v1 = acc[ai][bj][m][1];
#pragma unroll
                    for (int e = 0; e < 4; ++e) { const float a = fmaxf(v0[e], 0.f), c = fmaxf(v1[e], 0.f); v0[e] = a * a; v1[e] = c * c; }
                    *(u32x4*)(rowp + bj * HALF) = pack8bf(v0, v1); } }
    }
};
struct EpiDown {
    static constexpr bool PERM = false, AFTER_DRAIN = false;
    float* Y; const float* stats; const float* g; const float* bta; int ldc; float alpha;
    __device__ __forceinline__ void operator()(const f32x4 (&acc)[2][2][4][2], const Unit& u, int wr, int wc, int fr, int fq) const {
        const int row0 = u.pm * BM + wr * 64 + fr, col0 = u.pn * BM + wc * 32 + 4 * fq;
        f32x4 gv[2][2], bv[2][2];
#pragma unroll
        for (int bj = 0; bj < 2; ++bj)
#pragma unroll
            for (int n = 0; n < 2; ++n) { gv[bj][n] = *(const f32x4*)(g + col0 + bj * HALF + n * 16); bv[bj][n] = *(const f32x4*)(bta + col0 + bj * HALF + n * 16); }
#pragma unroll
        for (int ai = 0; ai < 2; ++ai)
#pragma unroll
            for (int m = 0; m < 4; ++m) { const int r = row0 + ai * HALF + m * 16; const float mu = stats[2 * r], rs = stats[2 * r + 1] * alpha; const size_t off = (size_t)r * ldc + col0;
#pragma unroll
                for (int bj = 0; bj < 2; ++bj)
#pragma unroll
                    for (int n = 0; n < 2; ++n) { float* p = Y + off + bj * HALF + n * 16; const f32x4 yv = *(const f32x4*)p;
                        *(f32x4*)p = (yv - mu) * rs * gv[bj][n] + bv[bj][n] * alpha + acc[ai][bj][m][n]; }
                if (m & 1) asm volatile("" ::: "memory"); }
    }
};

__device__ __forceinline__ void unpack8bf(const u32x4 w, f32x4& lo, f32x4& hi) {
    lo[0] = __builtin_bit_cast(float, w.x << 16); lo[1] = __builtin_bit_cast(float, w.x & 0xffff0000u); lo[2] = __builtin_bit_cast(float, w.y << 16); lo[3] = __builtin_bit_cast(float, w.y & 0xffff0000u);
    hi[0] = __builtin_bit_cast(float, w.z << 16); hi[1] = __builtin_bit_cast(float, w.z & 0xffff0000u); hi[2] = __builtin_bit_cast(float, w.w << 16); hi[3] = __builtin_bit_cast(float, w.w & 0xffff0000u);
}
struct EpiOutB {
    static constexpr bool PERM = true, AFTER_DRAIN = false;
    const float* X; const float* stats; const float* g; const float* bta; bf16_t* Yb; int ldc; float alpha;
    __device__ __forceinline__ void operator()(const f32x4 (&acc)[2][2][4][2], const Unit& u, int wr, int wc, int fr, int fq) const {
        const int row0 = u.pm * BM + wr * 64 + fr, col0 = u.pn * BM + wc * 32 + 8 * fq;
        f32x4 gv[2][2], bv[2][2];
#pragma unroll
        for (int bj = 0; bj < 2; ++bj)
#pragma unroll
            for (int n = 0; n < 2; ++n) { gv[bj][n] = *(const f32x4*)(g + col0 + bj * HALF + n * 4); bv[bj][n] = *(const f32x4*)(bta + col0 + bj * HALF + n * 4) * alpha; }
#pragma unroll
        for (int ai = 0; ai < 2; ++ai)
#pragma unroll
            for (int m = 0; m < 4; ++m) { const int r = row0 + ai * HALF + m * 16; const float mu = stats[2 * r], rs = stats[2 * r + 1] * alpha; const size_t off = (size_t)r * ldc + col0;
#pragma unroll
                for (int bj = 0; bj < 2; ++bj) { const f32x4 x0 = *(const f32x4*)(X + off + bj * HALF), x1 = *(const f32x4*)(X + off + bj * HALF + 4);
                    const f32x4 y0 = (x0 - mu) * rs * gv[bj][0] + bv[bj][0] + acc[ai][bj][m][0], y1 = (x1 - mu) * rs * gv[bj][1] + bv[bj][1] + acc[ai][bj][m][1];
                    *(u32x4*)(Yb + off + bj * HALF) = pack8bf(y0, y1); }
                if (m & 1) asm volatile("" ::: "memory"); }
    }
};
struct EpiOutS {
    static constexpr bool PERM = true, AFTER_DRAIN = false, PREFETCH = true;
    const float* X; const float* stats; const float* g; const float* bta; bf16_t* Yb; int ldc; float alpha; float* rpart;
    __device__ __forceinline__ void prefetch(const Unit& u, PG8_LAS unsigned char* sink, int tid) const {
        const char* base = (const char*)(X + (size_t)u.pm * BM * ldc + u.pn * BM);
#pragma unroll
        for (int i = 0; i < 4; ++i) { const int L = i * 512 + tid, row = L >> 3, seg = L & 7;
            __builtin_amdgcn_global_load_lds((const unsigned*)(base + ((size_t)row * ldc + seg * 32) * 4), (PG8_LAS unsigned*)sink, 4, 0, 0); }
    }
    __device__ __forceinline__ void operator()(const f32x4 (&acc)[2][2][4][2], const Unit& u, int wr, int wc, int fr, int fq) const {
        const int row0 = u.pm * BM + wr * 64 + fr, col0 = u.pn * BM + wc * 32 + 8 * fq, lane = fq * 16 + fr;
        f32x4 gv[2][2], bv[2][2];
#pragma unroll
        for (int bj = 0; bj < 2; ++bj)
#pragma unroll
            for (int n = 0; n < 2; ++n) { gv[bj][n] = *(const f32x4*)(g + col0 + bj * HALF + n * 4); bv[bj][n] = *(const f32x4*)(bta + col0 + bj * HALF + n * 4) * alpha; }
#pragma unroll
        for (int ai = 0; ai < 2; ++ai)
#pragma unroll
            for (int m = 0; m < 4; ++m) { const int r = row0 + ai * HALF + m * 16; const float mu = stats[2 * r], rs = stats[2 * r + 1] * alpha; const size_t off = (size_t)r * ldc + col0;
                float s1 = 0.f, s2 = 0.f;
#pragma unroll
                for (int bj = 0; bj < 2; ++bj) { const f32x4 x0 = *(const f32x4*)(X + off + bj * HALF), x1 = *(const f32x4*)(X + off + bj * HALF + 4);
                    const f32x4 y0 = (x0 - mu) * rs * gv[bj][0] + bv[bj][0] + acc[ai][bj][m][0], y1 = (x1 - mu) * rs * gv[bj][1] + bv[bj][1] + acc[ai][bj][m][1];
                    s1 += ((y0[0] + y0[1]) + (y0[2] + y0[3])) + ((y1[0] + y1[1]) + (y1[2] + y1[3]));
                    s2 += ((y0[0] * y0[0] + y0[1] * y0[1]) + (y0[2] * y0[2] + y0[3] * y0[3])) + ((y1[0] * y1[0] + y1[1] * y1[1]) + (y1[2] * y1[2] + y1[3] * y1[3]));
                    *(u32x4*)(Yb + off + bj * HALF) = pack8bf(y0, y1); }
#pragma unroll
                for (int x = 16; x < 64; x <<= 1) { s1 += __builtin_bit_cast(float, __builtin_amdgcn_ds_bpermute((lane ^ x) << 2, __builtin_bit_cast(int, s1))); s2 += __builtin_bit_cast(float, __builtin_amdgcn_ds_bpermute((lane ^ x) << 2, __builtin_bit_cast(int, s2))); }
                if (fq == 0) { typedef float f32x2v __attribute__((ext_vector_type(2))); *(f32x2v*)(rpart + ((size_t)r * 64 + u.pn * 4 + wc) * 2) = (f32x2v){s1, s2}; }
                if (m == 3) asm volatile("" ::: "memory");     }
    }
};
struct EpiUpS {
    static constexpr bool PERM = true, AFTER_DRAIN = false, PREFETCH = false;
    bf16_t* O; int ldc; const float* ucol; const float* ccol; const PG8_LAS float* st;
    __device__ __forceinline__ void operator()(const f32x4 (&acc)[2][2][4][2], const Unit& u, int wr, int wc, int fr, int fq) const {
        typedef float f32x2v __attribute__((ext_vector_type(2)));
        const int rl0 = wr * 64 + fr, row0 = u.pm * BM + rl0, col0 = u.pn * BM + wc * 32 + 8 * fq;
        f32x4 uv[2][2], cv[2][2];
#pragma unroll
        for (int bj = 0; bj < 2; ++bj)
#pragma unroll
            for (int n = 0; n < 2; ++n) { uv[bj][n] = *(const f32x4*)(ucol + col0 + bj * HALF + n * 4); cv[bj][n] = *(const f32x4*)(ccol + col0 + bj * HALF + n * 4); }
#pragma unroll
        for (int ai = 0; ai < 2; ++ai)
#pragma unroll
            for (int m = 0; m < 4; ++m) { bf16_t* rowp = O + (size_t)(row0 + ai * HALF + m * 16) * ldc + col0; const f32x2v sr = *(const PG8_LAS f32x2v*)(st + 2 * (rl0 + ai * HALF + m * 16));
#pragma unroll
                for (int bj = 0; bj < 2; ++bj) { f32x4 v0 = (acc[ai][bj][m][0] - sr.x * uv[bj][0]) * sr.y + cv[bj][0], v1 = (acc[ai][bj][m][1] - sr.x * uv[bj][1]) * sr.y + cv[bj][1];
#pragma unroll
                    for (int e = 0; e < 4; ++e) { const float a = fmaxf(v0[e], 0.f), c = fmaxf(v1[e], 0.f); v0[e] = a * a; v1[e] = c * c; }
                    *(u32x4*)(rowp + bj * HALF) = pack8bf(v0, v1); } }
    }
};
struct EpiDownB {
    static constexpr bool PERM = true, AFTER_DRAIN = false, PREFETCH = true;
    const bf16_t* Y1b; bf16_t* Y2b; const float* stats; const float* g; const float* bta; int ldc; float alpha; int ldy;
    __device__ __forceinline__ void prefetch(const Unit& u, PG8_LAS unsigned char* sink, int tid) const {
        const char* base = (const char*)(Y1b + (size_t)u.pm * BM * ldc + u.pn * BM);
#pragma unroll
        for (int i = 0; i < 2; ++i) { const int L = i * 512 + tid, row = L >> 2, seg = L & 3;
            __builtin_amdgcn_global_load_lds((const unsigned*)(base + ((size_t)row * ldc + seg * 64) * 2), (PG8_LAS unsigned*)sink, 4, 0, 0); }
    }
    __device__ __forceinline__ void operator()(const f32x4 (&acc)[2][2][4][2], const Unit& u, int wr, int wc, int fr, int fq) const {
        const int row0 = u.pm * BM + wr * 64 + fr, col0 = u.pn * BM + wc * 32 + 8 * fq;
        f32x4 gv[2][2], bv[2][2];
#pragma unroll
        for (int bj = 0; bj < 2; ++bj)
#pragma unroll
            for (int n = 0; n < 2; ++n) { gv[bj][n] = *(const f32x4*)(g + col0 + bj * HALF + n * 4); bv[bj][n] = *(const f32x4*)(bta + col0 + bj * HALF + n * 4) * alpha; }
#pragma unroll
        for (int ai = 0; ai < 2; ++ai)
#pragma unroll
            for (int m = 0; m < 4; ++m) { const int r = row0 + ai * HALF + m * 16; const float mu = stats[2 * r], rs = stats[2 * r + 1] * alpha; const size_t off = (size_t)r * ldc + col0;
#pragma unroll
                for (int bj = 0; bj < 2; ++bj) { f32x4 x0, x1; unpack8bf(*(const u32x4*)(Y1b + off + bj * HALF), x0, x1);
                    const f32x4 y0 = (x0 - mu) * rs * gv[bj][0] + bv[bj][0] + acc[ai][bj][m][0], y1 = (x1 - mu) * rs * gv[bj][1] + bv[bj][1] + acc[ai][bj][m][1];
                    *(u32x4*)(Y2b + (size_t)r * ldy + col0 + bj * HALF) = pack8bf(y0, y1); }
                if (m == 3) asm volatile("" ::: "memory"); }
    }
};

template <class Epi, class Sched, bool ALIGN_EPI = false, bool SP2 = false>
__device__ __forceinline__ void gemm_phase(PG8_LAS unsigned char* lds, const Gemm g, const Sched& S, const Epi& E, const int wv  ) {
    const int lane = mk_lane_id(), wid = wv, tid = wv * 64 + lane, wr = wid >> 2, wc = wid & 3, fr = lane & 15, fq = lane >> 4;
    const int K = g.K, nt = K / BK;
    unsigned voffA[2], voffB[2];
#pragma unroll
    for (int i = 0; i < 2; ++i) { int R, C; stage_rc(tid * 16 + i * 8192, R, C); const int Rb = Epi::PERM ? ((R & ~31) + perm32(R & 31)) : R;
        voffA[i] = (unsigned)(R * K + C) * 2u; voffB[i] = (unsigned)(Rb * K + C) * 2u; }
    const size_t kstep = (size_t)(BK * 2);
    const size_t hstep = (size_t)HALF * K * 2;
    const size_t tstep = 2 * hstep;
    const unsigned ldsw = (unsigned)wid * 1024u;
    const int aoff = lds_byte(wr * 64 + fr, fq * 8), boff = lds_byte(wc * 32 + fr, fq * 8);
#define PG8_SA(b, h) (((b) * 2 + (h)) * HTB)
#define PG8_SB(b, h) ((4 + (b) * 2 + (h)) * HTB)
#define PG8_STAGE(bufoff, gbase, voff) do { _Pragma("unroll") for (int _i = 0; _i < 2; ++_i) \
        __builtin_amdgcn_global_load_lds((const unsigned*)((const char*)(gbase) + (voff)[_i]), (PG8_LAS unsigned*)(lds + (bufoff) + ldsw + _i * 8192), 16, 0, 0); } while (0)
#define PG8_LDA(dst, b, h) do { _Pragma("unroll") for (int m = 0; m < 4; ++m) _Pragma("unroll") for (int k = 0; k < 2; ++k) dst[m][k] = *(const PG8_LAS bf16x8*)(lds + PG8_SA(b, h) + aoff + m * 2048 + k * 1024); } while (0)
#define PG8_LDB(dst, b, h) do { _Pragma("unroll") for (int n = 0; n < 2; ++n) _Pragma("unroll") for (int k = 0; k < 2; ++k) dst[n][k] = *(const PG8_LAS bf16x8*)(lds + PG8_SB(b, h) + boff + n * 2048 + k * 1024); } while (0)
#define PG8_MMA(ai, bj, At, Bt) do { __builtin_amdgcn_s_setprio(1); _Pragma("unroll") for (int m = 0; m < 4; ++m) _Pragma("unroll") for (int n = 0; n < 2; ++n) _Pragma("unroll") for (int k = 0; k < 2; ++k) \
        acc[ai][bj][m][n] = __builtin_amdgcn_mfma_f32_16x16x32_bf16(Bt[n][k], At[m][k], acc[ai][bj][m][n], 0, 0, 0); __builtin_amdgcn_s_setprio(0); } while (0)
#define PG8_WAIT_V(n) asm volatile("s_waitcnt vmcnt(" #n ")" ::: "memory")
#define PG8_WAIT_L(n) asm volatile("s_waitcnt lgkmcnt(" #n ")" ::: "memory")
#define PG8_BAR __builtin_amdgcn_s_barrier()
#define PG8_SCHED __builtin_amdgcn_sched_barrier(0)
    Unit cur, nxt; int ui = 0;
#if defined(PROBE_EPI)
    unsigned long long pe_acc = 0ull;
#endif
    if (!S.next(0, cur)) return;
    f32x4 acc[2][2][4][2];
#pragma unroll
    for (int a = 0; a < 2; ++a)
#pragma unroll
        for (int b = 0; b < 2; ++b)
#pragma unroll
            for (int m = 0; m < 4; ++m)
#pragma unroll
                for (int n = 0; n < 2; ++n) acc[a][b][m][n] = (f32x4){0.f, 0.f, 0.f, 0.f};
    bf16x8 At[4][2], B0[2][2], B1[2][2];
    const char* cA = (const char*)g.A + (((size_t)cur.pm * tstep) << g.ashift); const char* cB = (const char*)g.Bt + (size_t)cur.pn * tstep;
    S.a_ready(cur);
    if constexpr (SP2) {
        PG8_STAGE(PG8_SB(0, 0), cB, voffB); PG8_STAGE(PG8_SB(0, 1), cB + hstep, voffB); PG8_STAGE(PG8_SA(0, 0), cA, voffA); PG8_STAGE(PG8_SA(0, 1), cA + hstep, voffA);
        if (wr == 1) PG8_BAR;
        PG8_WAIT_V(2); PG8_BAR;
        PG8_STAGE(PG8_SB(1, 0), cB + kstep, voffB); PG8_STAGE(PG8_SA(1, 0), cA + kstep, voffA); PG8_STAGE(PG8_SB(1, 1), cB + hstep + kstep, voffB);
        PG8_WAIT_V(6); PG8_BAR;
    } else {
        PG8_STAGE(PG8_SB(0, 0), cB, voffB); PG8_STAGE(PG8_SA(0, 0), cA, voffA); PG8_STAGE(PG8_SB(0, 1), cB + hstep, voffB); PG8_STAGE(PG8_SA(0, 1), cA + hstep, voffA);
        if (wr == 1) PG8_BAR;
        PG8_WAIT_V(4); PG8_BAR;
        PG8_STAGE(PG8_SB(1, 0), cB + kstep, voffB); PG8_STAGE(PG8_SA(1, 0), cA + kstep, voffA); PG8_STAGE(PG8_SB(1, 1), cB + hstep + kstep, voffB);
        PG8_WAIT_V(6); PG8_BAR;
    }
    for (;;) {
        const bool has_next = S.next(ui + 1, nxt);
        const char* nA = has_next ? (const char*)g.A + (((size_t)nxt.pm * tstep) << g.ashift) : cA; const char* nB = has_next ? (const char*)g.Bt + (size_t)nxt.pn * tstep : cB;
        for (int t = 0; t < nt; t += 2) {
            const bool last = (t == nt - 2);
            if constexpr (Epi::PREFETCH) { if (t == nt - 12) E.prefetch(cur, lds + 131072 + 4096 + wid * 256, tid); }
            const char* a1 = cA + (size_t)(t + 1) * kstep;
            const char* a2 = last ? nA : cA + (size_t)(t + 2) * kstep; const char* b2 = last ? nB : cB + (size_t)(t + 2) * kstep;
            const char* a3 = a2 + kstep; const char* b3 = b2 + kstep;
            if (last && has_next) S.a_ready(nxt);
            if constexpr (SP2) {
            PG8_LDB(B0, 0, 0); PG8_LDB(B1, 0, 1); PG8_SCHED; PG8_LDA(At, 0, 0); PG8_STAGE(PG8_SA(1, 1), a1 + hstep, voffA);
            PG8_WAIT_V(8); PG8_WAIT_L(0); PG8_BAR; PG8_MMA(0, 0, At, B0); PG8_MMA(0, 1, At, B1); PG8_BAR; PG8_SCHED;
            PG8_LDA(At, 0, 1); PG8_STAGE(PG8_SB(0, 0), b2, voffB); PG8_STAGE(PG8_SB(0, 1), b2 + hstep, voffB); PG8_STAGE(PG8_SA(0, 0), a2, voffA);
            PG8_WAIT_V(8); PG8_WAIT_L(0); PG8_BAR; PG8_MMA(1, 0, At, B0); PG8_MMA(1, 1, At, B1); PG8_BAR; PG8_SCHED;
            PG8_LDB(B0, 1, 0); PG8_LDB(B1, 1, 1); PG8_SCHED; PG8_LDA(At, 1, 0); PG8_STAGE(PG8_SA(0, 1), a2 + hstep, voffA);
            PG8_WAIT_V(8); PG8_WAIT_L(0); PG8_BAR; PG8_MMA(0, 0, At, B0); PG8_MMA(0, 1, At, B1); PG8_BAR; PG8_SCHED;
            PG8_LDA(At, 1, 1); PG8_STAGE(PG8_SB(1, 0), b3, voffB); PG8_STAGE(PG8_SB(1, 1), b3 + hstep, voffB); PG8_STAGE(PG8_SA(1, 0), a3, voffA);
            PG8_WAIT_V(8); PG8_WAIT_L(0); PG8_BAR; PG8_MMA(1, 0, At, B0); PG8_MMA(1, 1, At, B1); PG8_BAR; PG8_SCHED;
            } else {
            PG8_LDB(B0, 0, 0); PG8_SCHED; PG8_LDA(At, 0, 0); PG8_STAGE(PG8_SA(1, 1), a1 + hstep, voffA);
            PG8_WAIT_L(8); PG8_BAR; PG8_WAIT_L(0); PG8_MMA(0, 0, At, B0); PG8_BAR; PG8_SCHED;
            PG8_LDB(B1, 0, 1); PG8_STAGE(PG8_SB(0, 0), b2, voffB);
            PG8_BAR; PG8_WAIT_L(0); PG8_MMA(0, 1, At, B1); PG8_BAR;
            PG8_LDA(At, 0, 1); PG8_STAGE(PG8_SA(0, 0), a2, voffA);
            PG8_BAR; PG8_WAIT_L(0); PG8_MMA(1, 0, At, B0); PG8_BAR; PG8_SCHED;
            PG8_STAGE(PG8_SB(0, 1), b2 + hstep, voffB);
            PG8_WAIT_V(6); PG8_BAR; PG8_MMA(1, 1, At, B1); PG8_BAR;
            PG8_LDB(B0, 1, 0); PG8_SCHED; PG8_LDA(At, 1, 0); PG8_STAGE(PG8_SA(0, 1), a2 + hstep, voffA);
            PG8_WAIT_L(8); PG8_BAR; PG8_WAIT_L(0); PG8_MMA(0, 0, At, B0); PG8_BAR; PG8_SCHED;
            PG8_LDB(B1, 1, 1); PG8_STAGE(PG8_SB(1, 0), b3, voffB);
            PG8_BAR; PG8_WAIT_L(0); PG8_MMA(0, 1, At, B1); PG8_BAR;
            PG8_LDA(At, 1, 1); PG8_STAGE(PG8_SA(1, 0), a3, voffA);
            PG8_BAR; PG8_WAIT_L(0); PG8_MMA(1, 0, At, B0); PG8_BAR; PG8_SCHED;
            PG8_STAGE(PG8_SB(1, 1), b3 + hstep, voffB);
            PG8_WAIT_V(6); PG8_BAR; PG8_MMA(1, 1, At, B1); PG8_BAR;
            }
        }
        if constexpr (ALIGN_EPI) { if (wr == 0) PG8_BAR; }
#if defined(PROBE_EPI)
        { const unsigned long long pe0_ = __builtin_amdgcn_s_memrealtime(); if constexpr (!Epi::AFTER_DRAIN) { E(acc, cur, wr, wc, fr, fq); S.done(cur); } pe_acc += __builtin_amdgcn_s_memrealtime() - pe0_; }
#else
        if constexpr (!Epi::AFTER_DRAIN) { E(acc, cur, wr, wc, fr, fq); S.done(cur); }
#endif
        if (!has_next) break;
#pragma unroll
        for (int a = 0; a < 2; ++a)
#pragma unroll
            for (int b = 0; b < 2; ++b)
#pragma unroll
                for (int m = 0; m < 4; ++m)
#pragma unroll
                    for (int n = 0; n < 2; ++n) acc[a][b][m][n] = (f32x4){0.f, 0.f, 0.f, 0.f};
        cur = nxt; cA = nA; cB = nB; ++ui;
        if constexpr (ALIGN_EPI) { if (wr == 1) PG8_BAR; }
    }
    PG8_WAIT_V(0);
    if constexpr (!ALIGN_EPI) { if (wr == 0) PG8_BAR; }
    PG8_BAR;
    if constexpr (Epi::AFTER_DRAIN) { E.fused(acc, cur, wr, wc, fr, fq, lds, wid, lane); S.done(cur); }
#if defined(PROBE_EPI)
    if (blockIdx.x == 0 && tid == 0) *(volatile PG8_LAS unsigned long long*)(lds + 131072 + 1024 + 8 * 16) = pe_acc;
#endif
#undef PG8_SA
#undef PG8_SB
#undef PG8_STAGE
#undef PG8_LDA
#undef PG8_LDB
#undef PG8_MMA
#undef PG8_WAIT_V
#undef PG8_WAIT_L
#undef PG8_BAR
#undef PG8_SCHED
}
}

#ifndef PG8_SP2
#define PG8_SP2 true
#endif
#ifndef PG8_ALIGN
#define PG8_ALIGN true
#endif
#include <hip/hip_bf16.h>
namespace att {
__device__ __forceinline__ int fresh_lane() { int l; asm volatile("v_mbcnt_lo_u32_b32 %0, -1, 0\n\tv_mbcnt_hi_u32_b32 %0, -1, %0" : "=v"(l)); return l; }
__device__ __forceinline__ int fresh_tid(int wv) { return wv * 64 + fresh_lane(); }
constexpr int D = 128;
constexpr float THR = 8.f;
constexpr bool WSKIP = false;
constexpr float SCALE = 0.08838834764831845f;
constexpr float RSCALE = 11.313708498984761f;
constexpr int NW = 8, QBLK = 32, KVBLK = 64, QB = NW * QBLK;
constexpr int SHM_V = KVBLK * D * 2, SHM_K = KVBLK * D * 2;
constexpr int LDS_BIAS = 2 * SHM_V + 2 * SHM_K + NW * 64 * 4;
constexpr int LDS_OST = LDS_BIAS + 2 * 64 * 4;
constexpr int LDS_BYTES = LDS_OST + NW * 4096;

using bf16 = __hip_bfloat16;
typedef short bf16x8 __attribute__((ext_vector_type(8)));
typedef short s16x4 __attribute__((ext_vector_type(4)));
typedef float f32x16 __attribute__((ext_vector_type(16)));
typedef float f32x4 __attribute__((ext_vector_type(4)));
typedef unsigned u32x4 __attribute__((ext_vector_type(4)));
template <class A, class Bt> struct same_t { static constexpr bool v = false; };
template <class A> struct same_t<A, A> { static constexpr bool v = true; };

#define KSWZ(row, colB) ((row) * 256 + ((colB) ^ (((row) & 7) << 4)))
#define SBAR() __builtin_amdgcn_sched_barrier(0)
__device__ __forceinline__ int v_st(int k, int c) { const int kk = (k & ~0xC) | ((k & 4) << 1) | ((k & 8) >> 1); return ((kk >> 3) * 4 + (c >> 5)) * 512 + ((kk & 7) * 32 + (c & 31)) * 2; }
__device__ __forceinline__ int v_rd_base(int lane) { return ((lane & 3) << 3) | (((lane >> 2) & 3) << 6) | (((lane >> 4) & 1) << 5) | (((lane >> 5) & 1) << 8); }
constexpr int v_rd_off(int d0, int ks, int half) { return d0 * 512 + ks * 4096 + half * 2048; }
__device__ __forceinline__ int crow(int r, int hi) { return (r & 3) + 8 * (r >> 2) + 4 * hi; }
__device__ __forceinline__ unsigned cvtpk(float lo, float hi) {
    unsigned r; asm volatile("v_cvt_pk_bf16_f32 %0, %1, %2" : "=v"(r) : "v"(lo), "v"(hi)); return r;
}
__device__ __forceinline__ bf16x8 pack8(f32x4 a, f32x4 b) {
    u32x4 w = {cvtpk(a[0], a[1]), cvtpk(a[2], a[3]), cvtpk(b[0], b[1]), cvtpk(b[2], b[3])};
    return *reinterpret_cast<bf16x8*>(&w);
}
template <class T> __device__ __forceinline__ bf16x8 load8(const T* p) {
    if constexpr (same_t<T, float>::v) { return pack8(*(const f32x4*)p, *(const f32x4*)(p + 4)); }
    else { return *reinterpret_cast<const bf16x8*>(p); }
}
__device__ __forceinline__ void mask_tile(f32x16& p0, f32x16& p1, int dq, unsigned W) {
    const float NEG = -__builtin_inff();
#pragma unroll
    for (int r = 0; r < 16; ++r) {
        const int c = (r & 3) + 8 * (r >> 2);
        if ((unsigned)(dq - c) >= W) p0[r] = NEG;
        if ((unsigned)(dq - c - 32) >= W) p1[r] = NEG;
    }
}
__device__ __forceinline__ void partialSM(f32x16& p0, f32x16& p1, float& m_reg, float& mn, float& alpha) {
    float pmax = p0[0]; for (int r = 1; r < 16; ++r) pmax = fmaxf(pmax, p0[r]); for (int r = 0; r < 16; ++r) pmax = fmaxf(pmax, p1[r]);
    { auto rr = __builtin_amdgcn_permlane32_swap(__float_as_uint(pmax), __float_as_uint(pmax), false, false);
      pmax = fmaxf(__uint_as_float(rr[0]), __uint_as_float(rr[1])); }
    constexpr float C2 = 1.4426950408889634f * SCALE;
    if (__builtin_expect(__all((pmax - m_reg) * SCALE <= THR), 1)) { mn = m_reg; alpha = 1.f; }
    else { mn = fmaxf(m_reg, pmax); alpha = __builtin_amdgcn_exp2f((m_reg - mn) * C2); m_reg = mn; }
    const float mnL = -mn * C2;
    for (int r = 0; r < 16; ++r) p0[r] = fmaf(p0[r], C2, mnL); for (int r = 0; r < 16; ++r) p1[r] = fmaf(p1[r], C2, mnL);
    for (int r = 0; r < 16; ++r) p0[r] = __builtin_amdgcn_exp2f(p0[r]);
}
__device__ __forceinline__ void finishSM(f32x16& p0, f32x16& p1, float alpha, float& l_reg, bf16x8& pa0, bf16x8& pa1, bf16x8& pa2, bf16x8& pa3) {
    for (int r = 0; r < 16; ++r) p1[r] = __builtin_amdgcn_exp2f(p1[r]);
    float ps = 0; for (int r = 0; r < 16; ++r) ps += p0[r]; for (int r = 0; r < 16; ++r) ps += p1[r];
    { auto rr = __builtin_amdgcn_permlane32_swap(__float_as_uint(ps), __float_as_uint(ps), false, false);
      ps = __uint_as_float(rr[0]) + __uint_as_float(rr[1]); }
    l_reg = l_reg * alpha + ps;
#define PK4(P, B_, OUT) do { unsigned a0 = cvtpk(P[B_+0], P[B_+1]), a1 = cvtpk(P[B_+2], P[B_+3]);                          \
        unsigned b0 = cvtpk(P[B_+4], P[B_+5]), b1 = cvtpk(P[B_+6], P[B_+7]);                                             \
        auto r0 = __builtin_amdgcn_permlane32_swap(a0, b0, false, false); auto r1 = __builtin_amdgcn_permlane32_swap(a1, b1, false, false); \
        u32x4 w = {r0[0], r1[0], r0[1], r1[1]}; OUT = *reinterpret_cast<bf16x8*>(&w); } while (0)
    PK4(p0, 0, pa0); PK4(p0, 8, pa1); PK4(p1, 0, pa2); PK4(p1, 8, pa3);
#undef PK4
}
template <int KB, bool SK>
__device__ __forceinline__ void qkt(f32x16& p0, f32x16& p1, const char* K_lds, int r32, int hi, const bf16x8* qr, bool act) {
    if (SK && !act) { const float NEG = -__builtin_inff();
#pragma unroll
        for (int r = 0; r < 16; ++r) { p0[r] = NEG; p1[r] = NEG; } return; }
    p0 = f32x16{}; p1 = f32x16{};
    const char* kb[4];
#pragma unroll
    for (int dd = 0; dd < 4; ++dd) kb[dd] = K_lds + KB * SHM_K + KSWZ(r32, (dd * 16 + hi * 8) * 2);
#pragma unroll
    for (int d0 = 0; d0 < 8; ++d0) { const char* a = kb[d0 & 3] + (d0 >> 2) * 128;
        bf16x8 b0 = *reinterpret_cast<const bf16x8*>(a);
        bf16x8 b1 = *reinterpret_cast<const bf16x8*>(a + 32 * 256);
        p0 = __builtin_amdgcn_mfma_f32_32x32x16_bf16(b0, qr[d0], p0, 0, 0, 0);
        p1 = __builtin_amdgcn_mfma_f32_32x32x16_bf16(b1, qr[d0], p1, 0, 0, 0); }
}
template <int VB, bool SK>
__device__ __forceinline__ void pv_tile(f32x16* o, int vb0, bf16x8 pa0, bf16x8 pa1, bf16x8 pa2, bf16x8 pa3, bool act) {
    if (SK && !act) return;
#define TRRD(dst, off) asm volatile("ds_read_b64_tr_b16 %0, %1 offset:%2" : "=&v"(dst) : "v"(vb0), "i"(off) : "memory")
#define PV_D0(d0) do { s16x4 l0, l1, l2, l3, h0, h1, h2, h3; constexpr int b_ = VB * SHM_V + v_rd_off(d0, 0, 0);     \
        TRRD(l0, b_); TRRD(h0, b_ + 2048); TRRD(l1, b_ + 4096); TRRD(h1, b_ + 6144); TRRD(l2, b_ + 8192); TRRD(h2, b_ + 10240); TRRD(l3, b_ + 12288); TRRD(h3, b_ + 14336); \
        asm volatile("s_waitcnt lgkmcnt(0)" ::: "memory"); SBAR();                 \
        o[d0] = __builtin_amdgcn_mfma_f32_32x32x16_bf16(pa0, (bf16x8){l0[0], l0[1], l0[2], l0[3], h0[0], h0[1], h0[2], h0[3]}, o[d0], 0, 0, 0);   \
        o[d0] = __builtin_amdgcn_mfma_f32_32x32x16_bf16(pa1, (bf16x8){l1[0], l1[1], l1[2], l1[3], h1[0], h1[1], h1[2], h1[3]}, o[d0], 0, 0, 0);   \
        o[d0] = __builtin_amdgcn_mfma_f32_32x32x16_bf16(pa2, (bf16x8){l2[0], l2[1], l2[2], l2[3], h2[0], h2[1], h2[2], h2[3]}, o[d0], 0, 0, 0);   \
        o[d0] = __builtin_amdgcn_mfma_f32_32x32x16_bf16(pa3, (bf16x8){l3[0], l3[1], l3[2], l3[3], h3[0], h3[1], h3[2], h3[3]}, o[d0], 0, 0, 0); } while (0)
    PV_D0(0); PV_D0(1); PV_D0(2); PV_D0(3);
#undef PV_D0
#undef TRRD
}


template <int NB>
__device__ __forceinline__ void o_rows_store(const f32x16* o, const float (&rl)[16], char* stg, bf16* Ow, const int ldo, const int col0, const int r32, const int hi, const int lane) {
    constexpr int PITCH = NB * 64, CPR = PITCH / 16;
#pragma unroll
    for (int r = 0; r < 16; ++r) { char* rp = stg + crow(r, hi) * PITCH + r32 * 2;
#pragma unroll
        for (int b = 0; b < NB; ++b) { const float v = o[b][r] * rl[r]; *(unsigned short*)(rp + b * 64) = (unsigned short)cvtpk(v, v); } }
    asm volatile("s_waitcnt lgkmcnt(0)" ::: "memory");
#pragma unroll
    for (int k = 0; k < 2 * NB; ++k) { const int c = lane + 64 * k, row = c / CPR, ch = c % CPR;
        const u32x4 w = *(const u32x4*)(stg + c * 16);
        *(u32x4*)(Ow + (size_t)row * ldo + col0 + ch * 8) = w; }
}
template <class TIn, class TOut> struct BlockRef { unsigned qoff, koff, voff, ooff, coff; int P0; int ldo; int boff; int jlo; };
template <class TIn, class TOut> struct Bases { const TIn* qkv; TOut* o; const float* c; };
template <class TIn> struct Seam {
    bf16x8 qr[8];
    bf16x8 st_v0, st_v1, st_k0, st_k1; f32x4 sf0, sf1, sf2, sf3;
    f32x4 tq[16];
    float st_b;
};
__device__ __forceinline__ int swa_jlo(int P0, int W) { const int lowk = P0 - W + 1; return lowk > 0 ? lowk / KVBLK : 0; }
#define ROW(p, k0, rr) ((p) + (size_t)((k0) + (rr)) * D + sc)
#define VMW() asm volatile("s_waitcnt vmcnt(0)" ::: "memory")
#define VMWN(n) asm volatile("s_waitcnt vmcnt(%0)" :: "i"(n) : "memory")
#define SLOAD_H(Kp, Vp, Cp, k0) do { S.st_v0 = load8<TIn>(ROW(Vp, k0, sr)); S.st_v1 = load8<TIn>(ROW(Vp, k0, 32 + sr));              \
                         S.st_k0 = load8<TIn>(ROW(Kp, k0, sr)); S.st_k1 = load8<TIn>(ROW(Kp, k0, 32 + sr));                       \
                         if constexpr (MODE == 1) { if (tid < 64) S.st_b = (Cp)[(k0) + tid]; } } while (0)
#define SWRITE_HK(bf, cref) do { *(bf16x8*)(K_lds + (bf) * SHM_K + kws) = S.st_k0; *(bf16x8*)(K_lds + (bf) * SHM_K + kws + 32 * 256) = S.st_k1; \
                         if constexpr (MODE == 1) { if (tid < 64) bias_l[(bf) * 64 + tid] = ((cref) - S.st_b) * RSCALE; } } while (0)
#define SWRITE_HV(bf) do { *(bf16x8*)(V_lds + (bf) * SHM_V + vst0) = S.st_v0; *(bf16x8*)(V_lds + (bf) * SHM_V + vst1) = S.st_v1; } while (0)
#define SWRITE_H(bf, cref) do { SWRITE_HV(bf); SWRITE_HK(bf, cref); } while (0)
#define BIASADD(P0_, P1_, kb) do { if constexpr (MODE == 1) { const float* bp_ = bias_l + (kb) * 64 + 4 * hi;                    \
        _Pragma("unroll") for (int g_ = 0; g_ < 4; ++g_) { const f32x4 b0_ = *(const f32x4*)(bp_ + 8 * g_), b1_ = *(const f32x4*)(bp_ + 32 + 8 * g_); \
            _Pragma("unroll") for (int e_ = 0; e_ < 4; ++e_) { P0_[4 * g_ + e_] += b0_[e_]; P1_[4 * g_ + e_] += b1_[e_]; } } } } while (0)
#define PADMASK(P0_, P1_) do { const float NEG_ = -__builtin_inff(); _Pragma("unroll") for (int r_ = 0; r_ < 16; ++r_) { if (r_ >= 8) P0_[r_] = NEG_; P1_[r_] = NEG_; } } while (0)
#define SLOAD_F(p, k0) do { S.sf0 = *(const f32x4*)ROW(p, k0, sr); S.sf1 = *(const f32x4*)(ROW(p, k0, sr) + 4);                \
                            S.sf2 = *(const f32x4*)ROW(p, k0, 32 + sr); S.sf3 = *(const f32x4*)(ROW(p, k0, 32 + sr) + 4); } while (0)
#define SWRITE_KF(bf) do { *(bf16x8*)(K_lds + (bf) * SHM_K + kws) = pack8(S.sf0, S.sf1); *(bf16x8*)(K_lds + (bf) * SHM_K + kws + 32 * 256) = pack8(S.sf2, S.sf3); } while (0)
#define SWRITE_VF(bf) do { *(bf16x8*)(V_lds + (bf) * SHM_V + vst0) = pack8(S.sf0, S.sf1); *(bf16x8*)(V_lds + (bf) * SHM_V + vst1) = pack8(S.sf2, S.sf3); } while (0)
template <class TIn, class TOut, int MODE  , class Ref>
__device__ __forceinline__ void causal_swa_prime(const Ref& cur, const Bases<TIn, TOut>& B, int W, char* lds, Seam<TIn>& S, const int wv) {
    constexpr bool F32 = same_t<TIn, float>::v;
    const int tid = fresh_tid(wv), wid = wv, lane = tid & 63, r32 = lane & 31, hi = lane >> 5;
    const int sr = tid >> 4, sc = (tid & 15) * 8, kws = KSWZ(sr, sc * 2); char* K_lds = lds + 2 * SHM_V; float* bias_l = (float*)(lds + LDS_BIAS);
    float cref_cur = 0.f; if constexpr (MODE == 1) cref_cur = __uint_as_float(__builtin_amdgcn_readfirstlane(__float_as_uint(((const float*)(lds + cur.boff()))[(cur.P0() - 64) >> 7] + (B.c + cur.coff())[cur.P0()])));
    const int kb0 = cur.jlo() * KVBLK;
    if constexpr (MODE == 1) { if (kb0 >= 64) cref_cur -= __uint_as_float(__builtin_amdgcn_readfirstlane(__float_as_uint(((const float*)(lds + cur.boff()))[(kb0 - 64) >> 7]))); }
    for (int d0 = 0; d0 < 8; ++d0) S.qr[d0] = load8<TIn>(B.qkv + cur.qoff() + (size_t)(wid * QBLK + r32) * D + d0 * 16 + hi * 8);
    if constexpr (F32) { SLOAD_F((const float*)(B.qkv + cur.koff()), kb0); VMW(); SWRITE_KF(0); SBAR(); SLOAD_F((const float*)(B.qkv + cur.voff()), kb0); }
    else { SLOAD_H(B.qkv + cur.koff(), B.qkv + cur.voff(), B.c + cur.coff(), kb0); VMW(); SWRITE_HK(0, cref_cur); }
    __syncthreads();
}
template <class TIn, class TOut, int MODE, class Ref, class NxtFn>
__device__ __forceinline__ void causal_swa_block(const Ref& cur, NxtFn& nxtfn, const Bases<TIn, TOut>& B, int skv, int W, char* lds, Seam<TIn>& S, const int wv) {
    constexpr bool F32 = same_t<TIn, float>::v;
    const int tid = fresh_tid(wv), wid = wv, lane = tid & 63, r32 = lane & 31, hi = lane >> 5;
    const int j_lo = cur.jlo();
    int j_hi = (cur.P0() + QB - 1) / KVBLK + 1; if (j_hi > skv / KVBLK) j_hi = skv / KVBLK;
    const int NT = j_hi - j_lo;
    const int qlo_r = cur.P0() + wid * QBLK, qlo = (MODE == 0) ? (qlo_r | 63) : qlo_r, qm = (MODE == 0) ? (qlo - 4 * hi) : (qlo_r + r32 - 4 * hi);
    char* V_lds = lds; char* K_lds = lds + 2 * SHM_V; float* bias_l = (float*)(lds + LDS_BIAS);
    const float* base_l = (const float*)(lds + cur.boff());
    float cref_cur = 0.f; if constexpr (MODE == 1) { cref_cur = __uint_as_float(__builtin_amdgcn_readfirstlane(__float_as_uint(base_l[(cur.P0() - 64) >> 7] + (B.c + cur.coff())[cur.P0()]))); }
    const float* Ch = B.c + cur.coff();
#define CADJ(k0) ((MODE == 1) ? (cref_cur - (((k0) >= 64) ? __uint_as_float(__builtin_amdgcn_readfirstlane(__float_as_uint(base_l[((k0) - 64) >> 7]))) : 0.f)) : 0.f)
    float* ws = (float*)(lds + 2 * SHM_V + 2 * SHM_K) + wid * 64; float* li_l = ws, * al_l = ws + 32;
    float m_reg = -1e30f, l_reg = 0; f32x16 o[4] = {};
    const int sr = tid >> 4, sc = (tid & 15) * 8, vst0 = v_st(sr, sc), vst1 = v_st(32 + sr, sc), kws = KSWZ(sr, sc * 2);
    const int vb0 = (int)(uintptr_t)V_lds + v_rd_base(lane);
    const TIn* Kh = B.qkv + cur.koff(); const TIn* Vh = B.qkv + cur.voff();
#define RESC(a) do { if (__any((a) < 1.f)) { if (hi == 0) al_l[r32] = (a); asm volatile("s_waitcnt lgkmcnt(0)" ::: "memory");              \
                     for (int d_ = 0; d_ < 4; ++d_) for (int r = 0; r < 16; ++r) o[d_][r] *= al_l[crow(r, hi)]; } } while (0)
#define KBASE(t) ((j_lo + (t)) * KVBLK)
#define ACT(t) (KBASE(t) <= qlo + QBLK - 1 && KBASE(t) + KVBLK - 1 >= qlo - W + 1)
#define MASKT(P0_, P1_, t) do { const int kb_ = KBASE(t); if ((!SK || ACT(t)) && (kb_ + KVBLK - 1 > qlo || kb_ <= qlo + QBLK - 1 - W)) mask_tile(P0_, P1_, qm - kb_, (unsigned)W); } while (0)
    constexpr int NQL = F32 ? 16 : 8;
    constexpr bool SK = WSKIP && !F32;
#define SEAM_K0() do { VMWN(NQL); if constexpr (F32) { SWRITE_KF(0); SBAR(); SLOAD_F((const float*)(B.qkv + nxt.voff()), kbn); } else { SWRITE_HK(0, cref_nxt); } SBAR(); } while (0)
    f32x16 pA0, pA1, pB0, pB1; float mnA, mnB, alA, alB; bf16x8 pa0, pa1, pa2, pa3;
    if constexpr (F32) { VMW(); SWRITE_VF(0); SBAR(); } else { SWRITE_HV(0); SBAR(); }
    if (NT > 1) { if constexpr (F32) SLOAD_F((const float*)Kh, KBASE(1)); else SLOAD_H(Kh, Vh, Ch, KBASE(1)); }
    SBAR(); qkt<0, SK>(pA0, pA1, K_lds, r32, hi, S.qr, ACT(0));
    if constexpr (F32) { if (NT > 1) { VMW(); SWRITE_KF(1); SBAR(); SLOAD_F((const float*)Vh, KBASE(1)); } }
    BIASADD(pA0, pA1, 0); if (j_lo == 0) PADMASK(pA0, pA1); MASKT(pA0, pA1, 0); partialSM(pA0, pA1, m_reg, mnA, alA);
    if (NT > 1) { VMW(); if constexpr (F32) { SWRITE_VF(1); SBAR(); if (NT > 2) SLOAD_F((const float*)Kh, KBASE(2)); } else SWRITE_H(1, CADJ(KBASE(1))); }
    __syncthreads();
#define HALF_STEP(PX0, PX1, mnX, alX, PY0, PY1, alY, t, KB, VB, SB) do {                                                      \
        SBAR(); qkt<KB, SK>(PX0, PX1, K_lds, r32, hi, S.qr, ACT(t));                                             \
        finishSM(PY0, PY1, alY, l_reg, pa0, pa1, pa2, pa3); SBAR();                                                           \
        if ((t) + 1 < NT) { if constexpr (F32) { VMW(); SWRITE_KF(SB); SBAR(); SLOAD_F((const float*)Vh, KBASE((t) + 1)); }  \
                            else { SLOAD_H(Kh, Vh, Ch, KBASE((t) + 1)); } SBAR(); }                                               \
        pv_tile<VB, SK>(o, vb0, pa0, pa1, pa2, pa3, ACT((t) - 1)); BIASADD(PX0, PX1, KB); MASKT(PX0, PX1, (t)); partialSM(PX0, PX1, m_reg, mnX, alX);                                        \
        __syncthreads();                                                                                                      \
        if ((t) + 1 < NT) { VMW(); if constexpr (F32) { SWRITE_VF(SB); SBAR(); if ((t) + 2 < NT) SLOAD_F((const float*)Kh, KBASE((t) + 2)); } \
                            else { SWRITE_H(SB, CADJ(KBASE((t) + 1))); } }                                                                          \
        RESC(alX); __syncthreads(); } while (0)
    for (int t = 1; t + 1 < NT; t += 2) {
        nxtfn.early(t, NT);
        HALF_STEP(pB0, pB1, mnB, alB, pA0, pA1, alA, t, 1, 0, 0);
        HALF_STEP(pA0, pA1, mnA, alA, pB0, pB1, alB, t + 1, 0, 1, 1);
    }
    const Ref nxt = nxtfn();
    const int kbn = nxt.jlo() * KVBLK;
    float cref_nxt = 0.f; if constexpr (MODE == 1) { const float* bn_ = (const float*)(lds + nxt.boff());
        cref_nxt = __uint_as_float(__builtin_amdgcn_readfirstlane(__float_as_uint(bn_[(nxt.P0() - 64) >> 7] + (B.c + nxt.coff())[nxt.P0()] - ((kbn >= 64) ? bn_[(kbn - 64) >> 7] : 0.f)))); }
    const bool even = (NT & 1) == 0;
    if (even) { SBAR(); qkt<1, SK>(pB0, pB1, K_lds, r32, hi, S.qr, ACT(NT - 1)); SBAR(); }
#define QROW(e) (B.qkv + nxt.qoff() + (size_t)(wid * QBLK + r32) * D + ((e) >> 1) * 16 + hi * 8 + ((e) & 1) * 4)
    if constexpr (F32) { SLOAD_F((const float*)(B.qkv + nxt.koff()), kbn); SBAR();
#pragma unroll
        for (int e = 0; e < 8; ++e) S.tq[e] = *(const f32x4*)QROW(e); }
    else { SLOAD_H(B.qkv + nxt.koff(), B.qkv + nxt.voff(), B.c + nxt.coff(), kbn); SBAR();
#pragma unroll
        for (int d0 = 0; d0 < 8; ++d0) S.qr[d0] = load8<TIn>(B.qkv + nxt.qoff() + (size_t)(wid * QBLK + r32) * D + d0 * 16 + hi * 8); }
    SBAR();
    finishSM(pA0, pA1, alA, l_reg, pa0, pa1, pa2, pa3); SBAR();
    if constexpr (F32) {
#pragma unroll
        for (int e = 8; e < 16; ++e) S.tq[e] = *(const f32x4*)QROW(e); SBAR(); }
#undef QROW
    pv_tile<0, SK>(o, vb0, pa0, pa1, pa2, pa3, ACT(even ? NT - 2 : NT - 1));
    if (even) { BIASADD(pB0, pB1, 1); MASKT(pB0, pB1, NT - 1); partialSM(pB0, pB1, m_reg, mnB, alB); __syncthreads(); RESC(alB);
        finishSM(pB0, pB1, alB, l_reg, pa0, pa1, pa2, pa3); SBAR(); pv_tile<1, SK>(o, vb0, pa0, pa1, pa2, pa3, ACT(NT - 1)); }
    SBAR(); SEAM_K0();
    if (hi == 0) li_l[r32] = l_reg; asm volatile("s_waitcnt lgkmcnt(0)" ::: "memory");
    float rli[16];
#pragma unroll
    for (int r = 0; r < 16; ++r) rli[r] = __builtin_amdgcn_rcpf(li_l[crow(r, hi)]);
    TOut* Ow = B.o + cur.ooff() + (size_t)(wid * QBLK) * cur.ldo(); const int ldo = cur.ldo();
    if constexpr (same_t<TOut, float>::v) {
#pragma unroll
        for (int r = 0; r < 16; ++r) { const int orow = crow(r, hi);
#pragma unroll
            for (int d0 = 0; d0 < 4; ++d0) Ow[(size_t)orow * ldo + d0 * 32 + r32] = o[d0][r] * rli[r]; }
    } else {
        char* stg = lds + LDS_OST + wid * 4096;
        o_rows_store<2>(o, rli, stg, (bf16*)Ow, ldo, 0, r32, hi, lane);
        o_rows_store<2>(o + 2, rli, stg, (bf16*)Ow, ldo, 64, r32, hi, lane);
    }
    if constexpr (F32) {
#pragma unroll
        for (int d0 = 0; d0 < 8; ++d0) S.qr[d0] = pack8(S.tq[2 * d0], S.tq[2 * d0 + 1]); }
    __syncthreads();
#undef RESC
#undef CADJ
#undef KBASE
#undef ACT
#undef MASKT
#undef SEAM_K0
#undef HALF_STEP
}
#undef ROW
#undef VMW
#undef VMWN
#undef SLOAD_H
#undef SWRITE_HK
#undef SWRITE_HV
#undef SWRITE_H
#undef SLOAD_F
#undef SWRITE_KF
#undef SWRITE_VF
#undef BIASADD
#undef PADMASK


__device__ __forceinline__ void pv256(f32x16* o, int vb0, bf16x8 pa0, bf16x8 pa1, bf16x8 pa2, bf16x8 pa3) {
#define TRRD(dst, off) asm volatile("ds_read_b64_tr_b16 %0, %1 offset:%2" : "=&v"(dst) : "v"(vb0), "i"(off) : "memory")
#define RD8(S, g) do { constexpr int b_ = ((g) >> 2) * SHM_V + v_rd_off((g) & 3, 0, 0);                                                                   \
        TRRD(S##l0, b_); TRRD(S##h0, b_ + 2048); TRRD(S##l1, b_ + 4096); TRRD(S##h1, b_ + 6144); TRRD(S##l2, b_ + 8192); TRRD(S##h2, b_ + 10240); TRRD(S##l3, b_ + 12288); TRRD(S##h3, b_ + 14336); } while (0)
#define MM4(S, g) do {                                                                                                                                     \
        o[g] = __builtin_amdgcn_mfma_f32_32x32x16_bf16(pa0, (bf16x8){S##l0[0], S##l0[1], S##l0[2], S##l0[3], S##h0[0], S##h0[1], S##h0[2], S##h0[3]}, o[g], 0, 0, 0); \
        o[g] = __builtin_amdgcn_mfma_f32_32x32x16_bf16(pa1, (bf16x8){S##l1[0], S##l1[1], S##l1[2], S##l1[3], S##h1[0], S##h1[1], S##h1[2], S##h1[3]}, o[g], 0, 0, 0); \
        o[g] = __builtin_amdgcn_mfma_f32_32x32x16_bf16(pa2, (bf16x8){S##l2[0], S##l2[1], S##l2[2], S##l2[3], S##h2[0], S##h2[1], S##h2[2], S##h2[3]}, o[g], 0, 0, 0); \
        o[g] = __builtin_amdgcn_mfma_f32_32x32x16_bf16(pa3, (bf16x8){S##l3[0], S##l3[1], S##l3[2], S##l3[3], S##h3[0], S##h3[1], S##h3[2], S##h3[3]}, o[g], 0, 0, 0); } while (0)
#define LW() do { asm volatile("s_waitcnt lgkmcnt(0)" ::: "memory"); SBAR(); } while (0)
    s16x4 Al0, Al1, Al2, Al3, Ah0, Ah1, Ah2, Ah3, Bl0, Bl1, Bl2, Bl3, Bh0, Bh1, Bh2, Bh3;
    RD8(A, 0);
    LW(); RD8(B, 1); SBAR(); MM4(A, 0); SBAR();
    LW(); RD8(A, 2); SBAR(); MM4(B, 1); SBAR();
    LW(); RD8(B, 3); SBAR(); MM4(A, 2); SBAR();
    LW(); RD8(A, 4); SBAR(); MM4(B, 3); SBAR();
    LW(); RD8(B, 5); SBAR(); MM4(A, 4); SBAR();
    LW(); RD8(A, 6); SBAR(); MM4(B, 5); SBAR();
    LW(); RD8(B, 7); SBAR(); MM4(A, 6); SBAR();
    LW(); MM4(B, 7);
#undef TRRD
#undef RD8
#undef MM4
#undef LW
}

__device__ __forceinline__ void qk64(f32x16& p0, f32x16& p1, const char* K_lds, const char* Q_w, int r32, int hi) {
    p0 = f32x16{}; p1 = f32x16{};
    int ka[4], qa[4];
#pragma unroll
    for (int dd = 0; dd < 4; ++dd) { const int off = KSWZ(r32, (dd * 16 + hi * 8) * 2); ka[dd] = (int)(uintptr_t)K_lds + off; qa[dd] = (int)(uintptr_t)Q_w + off; }
#define LDR(dst, addr, off) asm volatile("ds_read_b128 %0, %1 offset:%2" : "=&v"(dst) : "v"(addr), "i"(off) : "memory")
#define RDS(S, d0) do { LDR(S##q, qa[(d0) & 3], ((d0) >> 2) * 128); LDR(S##a, ka[(d0) & 3], ((d0) >> 2) * 128); LDR(S##b, ka[(d0) & 3], ((d0) >> 2) * 128 + 32 * 256); } while (0)
#define MMS(S) do { p0 = __builtin_amdgcn_mfma_f32_32x32x16_bf16(S##a, S##q, p0, 0, 0, 0); p1 = __builtin_amdgcn_mfma_f32_32x32x16_bf16(S##b, S##q, p1, 0, 0, 0); } while (0)
#define LWN(n) do { asm volatile("s_waitcnt lgkmcnt(" #n ")" ::: "memory"); SBAR(); } while (0)
    bf16x8 Aq, Aa, Ab, Bq, Ba, Bb;
    RDS(A, 0); RDS(B, 1);
    LWN(3); MMS(A); SBAR(); RDS(A, 2);
    LWN(3); MMS(B); SBAR(); RDS(B, 3);
    LWN(3); MMS(A); SBAR(); RDS(A, 4);
    LWN(3); MMS(B); SBAR(); RDS(B, 5);
    LWN(3); MMS(A); SBAR(); RDS(A, 6);
    LWN(3); MMS(B); SBAR(); RDS(B, 7);
    LWN(3); MMS(A); SBAR();
    LWN(0); MMS(B);
#undef LDR
#undef RDS
#undef MMS
#undef LWN
}
constexpr int DLDS_K = 2 * SHM_V, DLDS_Q = DLDS_K + SHM_K, DLDS_WS = DLDS_Q + NW * 8192, DLDS_BYTES = DLDS_WS + NW * 64 * 4;
struct DiffRef { unsigned qoff, koff, v0off, v1off, ooff; int qb; };
__device__ __forceinline__ void diff_block(const DiffRef& R, const bf16* qkv, bf16* obase, int ldo, char* lds, const int wv) {
    const int tid = fresh_tid(wv), wid = wv, lane = tid & 63, r32 = lane & 31, hi = lane >> 5;
    char* V_lds = lds; char* K_lds = lds + DLDS_K; char* Q_lds = lds + DLDS_Q + wid * 8192;
    float* ws = (float*)(lds + DLDS_WS) + wid * 64; float* li_l = ws, * al_l = ws + 32;
    const int NT = 4 * R.qb + 5, myNT = 4 * R.qb + 2 + (wid >> 1);
    const int sr = tid >> 4, sc = (tid & 15) * 8, vst0 = v_st(sr, sc), vst1 = v_st(32 + sr, sc), kws = KSWZ(sr, sc * 2);
    const int vb0 = (int)(uintptr_t)V_lds + v_rd_base(lane);
    const bf16* Kh = qkv + R.koff; const bf16* V0h = qkv + R.v0off; const bf16* V1h = qkv + R.v1off;
    const int qsw = KSWZ(r32, hi * 16);
#define QCH(d0) (KSWZ(r32, ((d0) * 16 + hi * 8) * 2))
    {
        const bf16* Qp = qkv + R.qoff + (size_t)(wid * QBLK + r32) * D + hi * 8; bf16x8 q[8];
#pragma unroll
        for (int d0 = 0; d0 < 8; ++d0) q[d0] = load8<bf16>(Qp + d0 * 16);
#pragma unroll
        for (int d0 = 0; d0 < 8; ++d0) *(bf16x8*)(Q_lds + QCH(d0)) = q[d0];
    }
    (void)qsw;
    bf16x8 sk0, sk1, sv0, sv1, sv2, sv3;
    const unsigned lo0 = (unsigned)(sr * D + sc), lo1 = lo0 + 32u * D;
#define DLOAD(k0) do { const bf16* kp_ = Kh + (size_t)(k0) * D; const bf16* v0_ = V0h + (size_t)(k0) * D; const bf16* v1_ = V1h + (size_t)(k0) * D;          \
                       sk0 = load8<bf16>(kp_ + lo0); sk1 = load8<bf16>(kp_ + lo1); sv0 = load8<bf16>(v0_ + lo0); sv1 = load8<bf16>(v0_ + lo1);           \
                       sv2 = load8<bf16>(v1_ + lo0); sv3 = load8<bf16>(v1_ + lo1); } while (0)
#define DWRITE() do { *(bf16x8*)(K_lds + kws) = sk0; *(bf16x8*)(K_lds + kws + 32 * 256) = sk1;                                                 \
                      *(bf16x8*)(V_lds + vst0) = sv0; *(bf16x8*)(V_lds + vst1) = sv1; *(bf16x8*)(V_lds + SHM_V + vst0) = sv2; *(bf16x8*)(V_lds + SHM_V + vst1) = sv3; } while (0)
    DLOAD(0);
    float m_reg = -1e30f, l_reg = 0; f32x16 o[8] = {};
#pragma unroll 1
    for (int t = 0; t < NT; ++t) {
        asm volatile("s_waitcnt vmcnt(0)" ::: "memory");
        __syncthreads();
        DWRITE();
        __syncthreads();
        if (t + 1 < NT) DLOAD((t + 1) * KVBLK);
        SBAR();
        if (t < myNT) {
            f32x16 p0, p1; float mn, al; bf16x8 pa0, pa1, pa2, pa3;
            qk64(p0, p1, K_lds, Q_lds, r32, hi);
            if (t == 0) { const float NEG_ = -__builtin_inff();
#pragma unroll
                for (int r_ = 0; r_ < 16; ++r_) { if (r_ >= 8) p0[r_] = NEG_; p1[r_] = NEG_; } }
            partialSM(p0, p1, m_reg, mn, al);
            finishSM(p0, p1, al, l_reg, pa0, pa1, pa2, pa3);
            if (__any(al < 1.f)) { if (hi == 0) al_l[r32] = al; asm volatile("s_waitcnt lgkmcnt(0)" ::: "memory");
#pragma unroll
                for (int d_ = 0; d_ < 8; ++d_)
#pragma unroll
                    for (int r = 0; r < 16; ++r) o[d_][r] *= al_l[crow(r, hi)]; }
            SBAR();
            pv256(o, vb0, pa0, pa1, pa2, pa3);
        }
    }
    if (hi == 0) li_l[r32] = l_reg; asm volatile("s_waitcnt lgkmcnt(0)" ::: "memory");
    bf16* Ow = obase + R.ooff + (size_t)(wid * QBLK) * ldo;
    float rl[16];
#pragma unroll
    for (int r = 0; r < 16; ++r) rl[r] = __builtin_amdgcn_rcpf(li_l[crow(r, hi)]);
    o_rows_store<4>(o, rl, Q_lds, Ow, ldo, 0, r32, hi, lane);
    o_rows_store<4>(o + 4, rl, Q_lds, Ow, ldo, 128, r32, hi, lane);
#undef QCH
#undef DLOAD
#undef DWRITE
}

}


constexpr int NWAVES = 8;
constexpr int NB = 2, T = 8192, DM = 4096, NMETA = 16, LSEQ = NMETA + T;
constexpr int MR = NB * T;
constexpr int KVR = 64 + T;
constexpr int NPROJ = 12288, INW = 12304, FFW = 16384, NGRP = 96;
constexpr int NFH = 16;
constexpr float LN_EPS = 1e-5f, SUBLN_EPS = 1e-5f;
constexpr float DN_ALPHA = 1.189207115002721f;
constexpr float LAMBDA_INIT = 0.2f;

constexpr size_t MiB = 1u << 20;
constexpr size_t WS_CTL = 0, CTL_ZERO_BYTES = 1 * MiB;
constexpr size_t WS_STATS0 = 1 * MiB, WS_STATS1 = WS_STATS0 + 131072, WS_HMETA = WS_STATS1 + 131072, WS_WFF = WS_HMETA + 131072;
constexpr size_t WS_ZF = 2 * MiB;
constexpr size_t WS_CUMS = 4 * MiB;
constexpr size_t WS_ROPE = 6 * MiB;
constexpr size_t WS_WUP = 16 * MiB, WS_WDN = 144 * MiB, WS_WOUT = 272 * MiB, WS_WIN = 304 * MiB;
constexpr size_t WS_H0B = 400 * MiB;
constexpr size_t WS_QKV = 528 * MiB;
constexpr size_t WS_PART0 = 304 * MiB, WS_PART1 = 915 * MiB;
constexpr size_t WS_H1B = 304 * MiB;
constexpr size_t WS_ACT = 432 * MiB;
constexpr size_t WS_RPART = 980 * MiB;
constexpr size_t WS_UPART = 988 * MiB, WS_CPART = 992 * MiB;
constexpr size_t WS_UCOL = 996 * MiB, WS_CCOL = WS_UCOL + 65536;
constexpr size_t WS_END = 997 * MiB;
static_assert(WS_ZF + (size_t)NB * KVR * 16 * 4 <= WS_CUMS && WS_CUMS + (size_t)NB * 16 * KVR * 4 <= WS_ROPE && WS_ROPE + (size_t)2 * LSEQ * 64 * 4 <= WS_WUP, "small regions");
static_assert(WS_QKV + (size_t)NGRP * NB * KVR * 128 * 2 <= WS_PART1 && WS_PART1 + (size_t)MR * 2048 * 2 <= WS_END && WS_ACT + (size_t)MR * FFW * 2 <= WS_END, "big regions");
static_assert(WS_H1B + (size_t)MR * DM * 2 <= WS_ACT && WS_WIN + (size_t)NPROJ * DM * 2 <= WS_H0B && WS_PART0 + (size_t)MR * 2048 * 2 <= WS_H0B, "overlays");
constexpr int CW_TMO = 0, CW_CODE = 1;
constexpr int CW_BAR = 4096;
constexpr int CW_QUEUE = 64, CW_QUEUE2 = 128, CW_QUEUE3 = 1024;
constexpr int CW_UC = 13312;
constexpr int CW_GRP = 12800;
constexpr int CW_NRM = 8192;

constexpr int RING_OFF = 0, RING_BYTES = 131072;
constexpr int LDSCTL_OFF = RING_BYTES, MISC_OFF = LDSCTL_OFF + 320;
constexpr int LDS_BYTES = 147456;
static_assert(MISC_OFF + 128 <= LDS_BYTES, "LDS map");
static_assert(att::LDS_BYTES <= RING_BYTES && att::DLDS_BYTES <= RING_BYTES, "attention LDS");

#define GAS __attribute__((address_space(1)))
#define LAS __attribute__((address_space(3)))
typedef unsigned short bf16;
typedef unsigned v4u __attribute__((ext_vector_type(4)));
typedef float f32x4 __attribute__((ext_vector_type(4)));
typedef short bf16x8 __attribute__((ext_vector_type(8)));
typedef GAS unsigned gu32;
typedef GAS unsigned long long gu64;
#define RLX_AGENT __ATOMIC_RELAXED, __HIP_MEMORY_SCOPE_AGENT
#define LDS_WAIT() asm volatile("s_waitcnt lgkmcnt(0)" ::: "memory")
#define VM_WAIT() asm volatile("s_waitcnt vmcnt(0)" ::: "memory")
__device__ __forceinline__ unsigned long long rt() { return __builtin_amdgcn_s_memrealtime(); }
__device__ __forceinline__ unsigned f2bf(float f) { unsigned u = __builtin_bit_cast(unsigned, f); return (u + 0x7fffu + ((u >> 16) & 1u)) >> 16; }
__device__ __forceinline__ unsigned pk2(float lo, float hi) { return f2bf(lo) | (f2bf(hi) << 16); }

#define XB_TMO      128
#define XB_XCNT(j)  (256  + 64 * (j))
#define XB_XSUB(j)  (1280 + 64 * (j))
#define XB_XGEN(j)  (2304 + 64 * (j))
#define XB_TOP      3328
#define XB_TOPGEN   3392
#define XCD_BAR_WORDS 3456
#define XB_SPIN_CAP (1u << 18)

__device__ __forceinline__ unsigned xb_ld(unsigned* p)              { return __hip_atomic_load(p, __ATOMIC_RELAXED, __HIP_MEMORY_SCOPE_AGENT); }
__device__ __forceinline__ unsigned xb_add(unsigned* p, unsigned v) { return __hip_atomic_fetch_add(p, v, __ATOMIC_RELAXED, __HIP_MEMORY_SCOPE_AGENT); }
__device__ __forceinline__ unsigned xb_xcc_id() { return (unsigned)__builtin_amdgcn_s_getreg((3 << 11) | 20) & 0xFu; }
#define XB_SPIN(cond, bar) do { unsigned _sp = 0; while (cond) { __builtin_amdgcn_s_sleep(1); \
    if ((++_sp & 255u) == 0u) { if (xb_ld(&(bar)[XB_TMO])) break; if (_sp > XB_SPIN_CAP) { atomicAdd(&(bar)[XB_TMO], 1u); break; } } } } while (0)

struct XcdBarrier {
    unsigned* bar; unsigned x;
    volatile LAS unsigned* st;
};

__device__ __forceinline__ XcdBarrier xcd_barrier_post(unsigned* bar, volatile LAS unsigned* st, const bool t0  ) {
    XcdBarrier b; b.bar = bar; b.x = xb_xcc_id(); b.st = st;
    if (t0) (void)xb_add(&bar[XB_XCNT(b.x)], 1u);
    return b;
}
__device__ __forceinline__ void xcd_barrier_complete(unsigned* bar, unsigned x, unsigned& nloc, unsigned& nx) {
    const unsigned G = gridDim.x * gridDim.y * gridDim.z;
    unsigned sum, cnt, mine, sp = 0u;
    for (;;) {
        sum = 0u; cnt = 0u; mine = 0u;
#pragma unroll
        for (unsigned j = 0; j < 16; ++j) { const unsigned c = xb_ld(&bar[XB_XCNT(j)]); sum += c; cnt += (c > 0u) ? 1u : 0u; mine = (j == x) ? c : mine; }
        if (sum == G) break;
        __builtin_amdgcn_s_sleep(1);
        if ((++sp & 255u) == 0u) { if (xb_ld(&bar[XB_TMO])) break; if (sp > XB_SPIN_CAP) { atomicAdd(&bar[XB_TMO], 1u); break; } }
    }
    nloc = mine > 0u ? mine : 1u; nx = cnt > 0u ? cnt : 1u;
}

__device__ __forceinline__ void xcd_barrier(const XcdBarrier& b, const bool t0  ) {
    asm volatile("s_waitcnt vmcnt(0)" ::: "memory");
    __syncthreads();
    if (t0) {
        unsigned* bar = b.bar;
        __builtin_amdgcn_s_waitcnt(0);
        unsigned nloc = b.st[0], nx = b.st[1];
        if (nloc == 0u) { xcd_barrier_complete(bar, b.x, nloc, nx); b.st[0] = nloc; b.st[1] = nx; }
        const unsigned old = xb_add(&bar[XB_XSUB(b.x)], 1u);
        const unsigned gen = old / nloc;
        if (old + 1u == (gen + 1u) * nloc) {
            __builtin_amdgcn_fence(__ATOMIC_RELEASE, "agent");
            asm volatile("s_waitcnt vmcnt(0)" ::: "memory");
            const unsigned og = xb_add(&bar[XB_TOP], 1u);
            const unsigned tg = og / nx;
            if (og + 1u == (tg + 1u) * nx) xb_add(&bar[XB_TOPGEN], 1u);
            else XB_SPIN(xb_ld(&bar[XB_TOPGEN]) == tg, bar);
            __builtin_amdgcn_fence(__ATOMIC_ACQUIRE, "agent");
            xb_add(&bar[XB_XGEN(b.x)], 1u);
            asm volatile("s_waitcnt vmcnt(0)" ::: "memory");
        } else {
            XB_SPIN(xb_ld(&bar[XB_XGEN(b.x)]) == gen, bar);
            __builtin_amdgcn_fence(__ATOMIC_ACQUIRE, "agent");
            asm volatile("s_waitcnt vmcnt(0)" ::: "memory");
        }
    }
    __syncthreads();
}


__device__ __forceinline__ float lane_xor(float v, int k, int lane) { return __builtin_bit_cast(float, __builtin_amdgcn_ds_bpermute((lane ^ k) << 2, __builtin_bit_cast(int, v))); }
__device__ __forceinline__ float lane_up(float v, int o, int lane) { return __builtin_bit_cast(float, __builtin_amdgcn_ds_bpermute(((lane - o) & 63) << 2, __builtin_bit_cast(int, v))); }
__device__ __forceinline__ float wave_sum(float v, int lane) {
#pragma unroll
    for (int o = 1; o < 64; o <<= 1) v += lane_xor(v, o, lane);
    return v;
}
__device__ __forceinline__ float bf2f(unsigned h) { return __builtin_bit_cast(float, h << 16); }
__device__ __forceinline__ float log_sigmoid(float z) { return fminf(z, 0.f) - log1pf(expf(-fabsf(z))); }

__device__ __forceinline__ int p0_rowmap(int n, int mode) {
    if (mode == 1) return n < 4096 ? ((n & ~192) | ((n & 64) << 1) | ((n & 128) >> 1)) : n;
    if (mode == 2) return n - NPROJ;
    return n;
}
__device__ __forceinline__ void p0_transpose_item(const float* W, int ldw, int K, bf16* WT, LAS float* scr, int k0, int n0, int nvalid, int mode, int lane) {
    const int n4 = (lane & 7) * 4;
#pragma unroll
    for (int i = 0; i < 8; ++i) { const int kk = 8 * i + (lane >> 3); f32x4 v = {0.f, 0.f, 0.f, 0.f}; if (n4 < nvalid) v = *(const GAS f32x4*)(W + (size_t)(k0 + kk) * ldw + n0 + n4);
        LAS float* d = scr + kk * 33 + n4; d[0] = v.x; d[1] = v.y; d[2] = v.z; d[3] = v.w; }
    LDS_WAIT(); asm volatile("" ::: "memory");
    const int c = lane & 7;
#pragma unroll
    for (int j = 0; j < 4; ++j) { const int n = (lane >> 3) + 8 * j; const LAS float* s = scr + (8 * c) * 33 + n;
        v4u o; o.x = pk2(s[0 * 33], s[1 * 33]); o.y = pk2(s[2 * 33], s[3 * 33]); o.z = pk2(s[4 * 33], s[5 * 33]); o.w = pk2(s[6 * 33], s[7 * 33]);
        if (n < nvalid) *(GAS v4u*)(WT + (size_t)p0_rowmap(n0 + n, mode) * K + k0 + 8 * c) = o; }
    LDS_WAIT(); asm volatile("" ::: "memory");
}
__device__ __forceinline__ void ln_row(const float* src, const float* g, const float* bta, int lane, float* dstf, bf16* dstb, float* stats) {
    const GAS f32x4* xr = (const GAS f32x4*)src + lane;
    f32x4 v[16]; float s = 0.f;
#pragma unroll
    for (int j = 0; j < 16; ++j) { v[j] = xr[64 * j]; s += (v[j].x + v[j].y) + (v[j].z + v[j].w); }
    const float mean = wave_sum(s, lane) * (1.f / DM); float s2 = 0.f;
#pragma unroll
    for (int j = 0; j < 16; ++j) { v[j] = v[j] - mean; s2 += (v[j].x * v[j].x + v[j].y * v[j].y) + (v[j].z * v[j].z + v[j].w * v[j].w); }
    const float rstd = 1.f / sqrtf(wave_sum(s2, lane) * (1.f / DM) + LN_EPS);
    if (stats && lane == 0) { stats[0] = mean; stats[1] = rstd; }
    const GAS f32x4* g4 = (const GAS f32x4*)g + lane; const GAS f32x4* b4 = (const GAS f32x4*)bta + lane;
#pragma unroll
    for (int j = 0; j < 16; ++j) { const f32x4 o = v[j] * rstd * g4[64 * j] + b4[64 * j];
        if (dstf) ((GAS f32x4*)dstf + lane)[64 * j] = o;
        if (dstb) ((GAS unsigned long long*)dstb + lane)[64 * j] = (unsigned long long)pk2(o.x, o.y) | ((unsigned long long)pk2(o.z, o.w) << 32); }
}
template <int R> __device__ __forceinline__ void ln_rows(const float* src, size_t rstride, const float* g, const float* bta, int lane, float* dstf, bf16* dstb, float* stats, size_t sstride) {
    f32x4 v[R][16]; float s[R];
#pragma unroll
    for (int r = 0; r < R; ++r) { const GAS f32x4* xr = (const GAS f32x4*)(src + r * rstride) + lane; s[r] = 0.f;
#pragma unroll
        for (int j = 0; j < 16; ++j) { v[r][j] = xr[64 * j]; s[r] += (v[r][j].x + v[r][j].y) + (v[r][j].z + v[r][j].w); } }
    float rstd[R];
#pragma unroll
    for (int r = 0; r < R; ++r) { const float mean = wave_sum(s[r], lane) * (1.f / DM); float s2 = 0.f;
#pragma unroll
        for (int j = 0; j < 16; ++j) { v[r][j] = v[r][j] - mean; s2 += (v[r][j].x * v[r][j].x + v[r][j].y * v[r][j].y) + (v[r][j].z * v[r][j].z + v[r][j].w * v[r][j].w); }
        rstd[r] = 1.f / sqrtf(wave_sum(s2, lane) * (1.f / DM) + LN_EPS);
        if (stats && lane == 0) { stats[r * sstride] = mean; stats[r * sstride + 1] = rstd[r]; } }
    const GAS f32x4* g4 = (const GAS f32x4*)g + lane; const GAS f32x4* b4 = (const GAS f32x4*)bta + lane;
#pragma unroll
    for (int j = 0; j < 16; ++j) { const f32x4 gv = g4[64 * j], bv = b4[64 * j];
#pragma unroll
        for (int r = 0; r < R; ++r) { const f32x4 o = v[r][j] * rstd[r] * gv + bv;
            if (dstf) ((GAS f32x4*)(dstf + r * rstride) + lane)[64 * j] = o;
            if (dstb) ((GAS unsigned long long*)(dstb + r * rstride) + lane)[64 * j] = (unsigned long long)pk2(o.x, o.y) | ((unsigned long long)pk2(o.z, o.w) << 32); } }
}
__device__ __forceinline__ void late_conv_decode(int it, const float* w_out, const float* w_up, const float* w_down, bf16* Wout, bf16* Wup, bf16* Wdn,
                                                 const float*& W, int& ldw, int& K, bf16*& WT, int& k0, int& n0) {
    constexpr int I_OUT = 64 * 128, I_UP = 64 * 512;
    if (it < I_OUT) { W = w_out; ldw = DM; K = DM; WT = Wout; k0 = 64 * (it / 128); n0 = 32 * (it % 128); return; } it -= I_OUT;
    if (it < I_UP) { W = w_up; ldw = FFW; K = DM; WT = Wup; k0 = 64 * (it / 512); n0 = 32 * (it % 512); return; } it -= I_UP;
    W = w_down; ldw = DM; K = FFW; WT = Wdn; k0 = 64 * (it / 128); n0 = 32 * (it % 128);
}
__device__ __forceinline__ void late_weight_conv(const float* w_out, const float* w_up, const float* w_down, bf16* Wout, bf16* Wup, bf16* Wdn, LAS float* scr, int gw, int lane, const float* g1, const float* b1, float* upart, float* cpart) {
    constexpr int NIT = 64 * 128 + 64 * 512 + 256 * 128, NGW_ = 256 * NWAVES; static_assert(NIT % (4 * NGW_) == 0, "whole batches of four items per wave");
    const int n4 = (lane & 7) * 4, c = lane & 7;
#pragma unroll 1
    for (int it0 = gw; it0 < NIT; it0 += 4 * NGW_) {
        f32x4 v[4][8];
#pragma unroll
        for (int j = 0; j < 4; ++j) { const float* W; int ldw, K, k0, n0; bf16* WT; late_conv_decode(it0 + j * NGW_, w_out, w_up, w_down, Wout, Wup, Wdn, W, ldw, K, WT, k0, n0);
#pragma unroll
            for (int i = 0; i < 8; ++i) v[j][i] = *(const GAS f32x4*)(W + (size_t)(k0 + 8 * i + (lane >> 3)) * ldw + n0 + n4); }
#pragma unroll
        for (int j = 0; j < 4; ++j) { const float* W; int ldw, K, k0, n0; bf16* WT; late_conv_decode(it0 + j * NGW_, w_out, w_up, w_down, Wout, Wup, Wdn, W, ldw, K, WT, k0, n0);
#pragma unroll
            for (int i = 0; i < 8; ++i) { LAS float* d = scr + (8 * i + (lane >> 3)) * 33 + n4; d[0] = v[j][i].x; d[1] = v[j][i].y; d[2] = v[j][i].z; d[3] = v[j][i].w; }
            LDS_WAIT(); asm volatile("" ::: "memory");
            const int itj = it0 + j * NGW_;
            if (itj >= 64 * 128 && itj < 64 * 128 + 64 * 512) {
                const f32x4 ga = *(const GAS f32x4*)(g1 + k0 + 8 * c), gb = *(const GAS f32x4*)(g1 + k0 + 8 * c + 4), ba = *(const GAS f32x4*)(b1 + k0 + 8 * c), bb = *(const GAS f32x4*)(b1 + k0 + 8 * c + 4);
#pragma unroll
                for (int q = 0; q < 4; ++q) { const int n = (lane >> 3) + 8 * q; const LAS float* s = scr + (8 * c) * 33 + n;
                    const float w0 = s[0 * 33], w1 = s[1 * 33], w2 = s[2 * 33], w3 = s[3 * 33], w4 = s[4 * 33], w5 = s[5 * 33], w6 = s[6 * 33], w7 = s[7 * 33];
                    float cs = ((ba.x * w0 + ba.y * w1) + (ba.z * w2 + ba.w * w3)) + ((bb.x * w4 + bb.y * w5) + (bb.z * w6 + bb.w * w7));
                    v4u o; o.x = pk2(ga.x * w0, ga.y * w1); o.y = pk2(ga.z * w2, ga.w * w3); o.z = pk2(gb.x * w4, gb.y * w5); o.w = pk2(gb.z * w6, gb.w * w7);
                    *(GAS v4u*)(WT + (size_t)(n0 + n) * K + k0 + 8 * c) = o;
                    float us = ((bf2f(o.x & 0xffffu) + bf2f(o.x >> 16)) + (bf2f(o.y & 0xffffu) + bf2f(o.y >> 16))) + ((bf2f(o.z & 0xffffu) + bf2f(o.z >> 16)) + (bf2f(o.w & 0xffffu) + bf2f(o.w >> 16)));
#pragma unroll
                    for (int x = 1; x < 8; x <<= 1) { us += lane_xor(us, x, lane); cs += lane_xor(cs, x, lane); }
                    if (c == 0) { upart[(size_t)(k0 >> 6) * FFW + n0 + n] = us; cpart[(size_t)(k0 >> 6) * FFW + n0 + n] = cs; } }
            } else {
#pragma unroll
            for (int q = 0; q < 4; ++q) { const int n = (lane >> 3) + 8 * q; const LAS float* s = scr + (8 * c) * 33 + n;
                v4u o; o.x = pk2(s[0 * 33], s[1 * 33]); o.y = pk2(s[2 * 33], s[3 * 33]); o.z = pk2(s[4 * 33], s[5 * 33]); o.w = pk2(s[6 * 33], s[7 * 33]);
                *(GAS v4u*)(WT + (size_t)(n0 + n) * K + k0 + 8 * c) = o; }
            }
            LDS_WAIT(); asm volatile("" ::: "memory"); }
    }
}
template <int R> __device__ __forceinline__ void ln_rows_b(const bf16* src, size_t rstride, const float* g, const float* bta, int lane, float* dstf, bf16* dstb, float* stats, size_t sstride, size_t dstride) {
    f32x4 v[R][16]; float s[R];
#pragma unroll
    for (int r = 0; r < R; ++r) { const GAS unsigned long long* xr = (const GAS unsigned long long*)(src + r * rstride) + lane; s[r] = 0.f;
#pragma unroll
        for (int j = 0; j < 16; ++j) { const unsigned long long w = xr[64 * j]; const unsigned lo = (unsigned)w, hi = (unsigned)(w >> 32);
            v[r][j] = (f32x4){bf2f(lo & 0xffffu), bf2f(lo >> 16), bf2f(hi & 0xffffu), bf2f(hi >> 16)}; s[r] += (v[r][j].x + v[r][j].y) + (v[r][j].z + v[r][j].w); } }
    float rstd[R];
#pragma unroll
    for (int r = 0; r < R; ++r) { const float mean = wave_sum(s[r], lane) * (1.f / DM); float s2 = 0.f;
#pragma unroll
        for (int j = 0; j < 16; ++j) { v[r][j] = v[r][j] - mean; s2 += (v[r][j].x * v[r][j].x + v[r][j].y * v[r][j].y) + (v[r][j].z * v[r][j].z + v[r][j].w * v[r][j].w); }
        rstd[r] = 1.f / sqrtf(wave_sum(s2, lane) * (1.f / DM) + LN_EPS);
        if (stats && lane == 0) { stats[r * sstride] = mean; stats[r * sstride + 1] = rstd[r]; } }
    const GAS f32x4* g4 = (const GAS f32x4*)g + lane; const GAS f32x4* b4 = (const GAS f32x4*)bta + lane;
#pragma unroll
    for (int j = 0; j < 16; ++j) { const f32x4 gv = g4[64 * j], bv = b4[64 * j];
#pragma unroll
        for (int r = 0; r < R; ++r) { const f32x4 o = v[r][j] * rstd[r] * gv + bv;
            if (dstf) ((GAS f32x4*)(dstf + r * dstride) + lane)[64 * j] = o;
            if (dstb) ((GAS unsigned long long*)(dstb + r * dstride) + lane)[64 * j] = (unsigned long long)pk2(o.x, o.y) | ((unsigned long long)pk2(o.z, o.w) << 32); } }
}
__device__ __forceinline__ void grp_barrier(gu32* ctl, const int slot, const int bx, const bool t0) {
    asm volatile("s_waitcnt vmcnt(0)" ::: "memory");
    __syncthreads();
    if (t0) {
        unsigned* bar = (unsigned*)(ctl + CW_BAR);
        __builtin_amdgcn_s_waitcnt(0);
        __builtin_amdgcn_fence(__ATOMIC_RELEASE, "agent"); asm volatile("s_waitcnt vmcnt(0)" ::: "memory");
        unsigned* c = (unsigned*)(ctl + CW_GRP + slot * 64 + (bx & 63));
        (void)xb_add(c, 1u);
        XB_SPIN(xb_ld(c) < 4u, bar);
        __builtin_amdgcn_fence(__ATOMIC_ACQUIRE, "agent");
        asm volatile("s_waitcnt vmcnt(0)" ::: "memory");
    }
    __syncthreads();
}
__device__ __forceinline__ void sincos_d(double x, double& sn, double& cs) {
    const double kq = rint(x * 0.63661977236758134308);
    double r = fma(-kq, 1.57079632673412561417e+00, x); r = fma(-kq, 6.07710050630396597660e-11, r); r = fma(-kq, 2.02226624879595063154e-21, r);
    const int q = ((int)kq) & 3; const double z = r * r;
    const double sp = r + r * z * (-1.66666666666666324348e-01 + z * (8.33333333332248946124e-03 + z * (-1.98412698298579493134e-04 + z * (2.75573137070700676789e-06 + z * (-2.50507602534068634195e-08 + z * 1.58969099521155010221e-10)))));
    const double cp = 1.0 - 0.5 * z + z * z * (4.16666666666666019037e-02 + z * (-1.38888888888741095749e-03 + z * (2.48015872894767294178e-05 + z * (-2.75573143513906633035e-07 + z * (2.08757232129817482790e-09 + z * -1.13596475577881948265e-11)))));
    sn = (q == 0) ? sp : (q == 1) ? cp : (q == 2) ? -sp : -cp;
    cs = (q == 0) ? cp : (q == 1) ? -sp : (q == 2) ? -cp : sp;
}

#ifndef STAG_F32
#define STAG_F32 0
#endif
#ifndef STAG_BF
#define STAG_BF 0
#endif
__device__ __forceinline__ void xcd_stagger(unsigned ticks_per) {
    if (ticks_per == 0u) return;
    const unsigned long long t0 = __builtin_amdgcn_s_memrealtime(), w = (unsigned long long)(xb_xcc_id() & 7u) * ticks_per;
    while (__builtin_amdgcn_s_memrealtime() - t0 < w) __builtin_amdgcn_s_sleep(4);
}
struct Args { const float* in[18]; float* out; unsigned char* ws; int ph_lo, ph_hi; };
static_assert(sizeof(Args) == 18 * 8 + 8 + 8 + 8, "Args has padding");
__device__ const float INV_FREQ[64] = {0x1.0000000000000p+0f, 0x1.bb5fae0000000p-1f, 0x1.7ff2220000000p-1f, 0x1.4c7bc00000000p-1f, 0x1.1feb340000000p-1f, 0x1.f2a79e0000000p-2f, 0x1.afd1360000000p-2f, 0x1.75f0360000000p-2f, 0x1.43d1360000000p-2f, 0x1.186a080000000p-2f, 0x1.e5a8460000000p-3f, 0x1.a48fda0000000p-3f, 0x1.6c310e0000000p-3f, 0x1.3b60800000000p-3f, 0x1.111aee0000000p-3f, 0x1.d8ffac0000000p-4f, 0x1.99999a0000000p-4f, 0x1.62b2f00000000p-4f, 0x1.33281a0000000p-4f, 0x1.09fc9a0000000p-4f, 0x1.ccab840000000p-5f, 0x1.8eec7e0000000p-5f, 0x1.59742a0000000p-5f, 0x1.2b26900000000p-5f, 0x1.030dc60000000p-5f, 0x1.c0a9a40000000p-6f, 0x1.84869e0000000p-6f, 0x1.5073160000000p-6f, 0x1.235a720000000p-6f, 0x1.f89a660000000p-7f, 0x1.b4f7e40000000p-7f, 0x1.7a66220000000p-7f, 0x1.47ae140000000p-7f, 0x1.1bc25a0000000p-7f, 0x1.eb73600000000p-8f, 0x1.a9942a0000000p-8f, 0x1.7089380000000p-8f, 0x1.3f23980000000p-8f, 0x1.145cee0000000p-8f, 0x1.dea41c0000000p-9f, 0x1.9e7c700000000p-9f, 0x1.66ee1e0000000p-9f, 0x1.36d21a0000000p-9f, 0x1.0d28de0000000p-9f, 0x1.d22a500000000p-10f, 0x1.93aeb80000000p-10f, 0x1.5d931c0000000p-10f, 0x1.2eb81c0000000p-10f, 0x1.0624de0000000p-10f, 0x1.c603c40000000p-11f, 0x1.8929180000000p-11f, 0x1.5476880000000p-11f, 0x1.26d42c0000000p-11f, 0x1.fe9f580000000p-12f, 0x1.ba2e4a0000000p-12f, 0x1.7ee9ae0000000p-12f, 0x1.4b96c00000000p-12f, 0x1.1f24e40000000p-12f, 0x1.f1502a0000000p-13f, 0x1.aea7c80000000p-13f, 0x1.74eea60000000p-13f, 0x1.42f22c0000000p-13f, 0x1.17a8e40000000p-13f, 0x1.e459c40000000p-14f};
typedef att::BlockRef<att::bf16, att::bf16> ABR;
typedef att::Bases<att::bf16, att::bf16> ABS;
__device__ __forceinline__ att::DiffRef mkref_diff(int ph, int c, int qb) {
    const int b = ph >> 3, h = ph & 7; att::DiffRef r;
    r.qoff = (unsigned)((((2 * h + c) * NB + b) * KVR + 64 + 256 * qb) * 128); r.koff = (unsigned)(((16 + 2 * h + c) * NB + b) * KVR * 128);
    r.v0off = (unsigned)(((32 + 2 * h) * NB + b) * KVR * 128); r.v1off = (unsigned)(((33 + 2 * h) * NB + b) * KVR * 128);
    r.ooff = (unsigned)((c ? WS_PART1 : WS_PART0) / 2) + (unsigned)((b * T + 256 * qb) * 2048 + h * 256); r.qb = qb; return r;
}
__device__ __forceinline__ int fox_jlo(int idx, const float* cums, const LAS float* base_all, const LAS float* smax2_l, int lane) {
    asm volatile("" : "+v"(lane));
    const int qb = 31 - (idx >> 5), bh = idx & 31;
    const float* cb = cums + (size_t)bh * KVR; const LAS float* bl = base_all + bh * 64;
    const float cq = bl[2 * qb] + cb[64 + 256 * qb], thr = -112.5f - smax2_l[bh];
    int jlo = 0; bool found = false;
#pragma unroll
    for (int pass = 0; pass < 2; ++pass) { const int j = pass * 64 + lane; bool keep = true;
        if (j <= 4 * qb) { const float cend = (j == 0) ? cb[15] : bl[(j - 1) >> 1] + cb[64 * j + 63]; keep = !((cq - cend) <= thr); }
        const unsigned long long km = __ballot(keep);
        if (!found && km != 0ull) { jlo = pass * 64 + (int)__builtin_ctzll(km); found = true; } }
    return __builtin_amdgcn_readfirstlane(jlo);
}
struct FoxRef {
    int idx, jlo_;
    __device__ __forceinline__ int qb() const { return 31 - (idx >> 5); }
    __device__ __forceinline__ int bh() const { return idx & 31; }
    __device__ __forceinline__ unsigned qoff() const { const int h = idx & 15, b = (idx >> 4) & 1; return (unsigned)((((48 + h) * NB + b) * KVR + 64 + 256 * qb()) * 128); }
    __device__ __forceinline__ unsigned koff() const { const int h = idx & 15, b = (idx >> 4) & 1; return (unsigned)(((64 + h) * NB + b) * KVR * 128); }
    __device__ __forceinline__ unsigned voff() const { const int h = idx & 15, b = (idx >> 4) & 1; return (unsigned)(((80 + h) * NB + b) * KVR * 128); }
    __device__ __forceinline__ unsigned ooff() const { const int h = idx & 15, b = (idx >> 4) & 1; return (unsigned)((b * T + 256 * qb()) * (2 * DM) + 2048 + h * 128); }
    __device__ __forceinline__ unsigned coff() const { return (unsigned)(bh() * KVR); }
    __device__ __forceinline__ int P0() const { return 64 + 256 * qb(); }
    __device__ __forceinline__ int ldo() const { return DM; }
    __device__ __forceinline__ int boff() const { return LDSCTL_OFF + 4096 + bh() * 256; }
    __device__ __forceinline__ int jlo() const { return jlo_; }
};
struct FoxNext {
    int cidx, cjlo, nidx, njlo; bool pulled; int wv_, qx;
    unsigned* qh; volatile LAS int* slot; const float* cums; const LAS float* base_all; const LAS float* smax2_l;
    __device__ __forceinline__ void early(int t, int NT) { if (!pulled && t + 5 >= NT) { if (wv_ == 0 && att::fresh_lane() == 0) slot[0] = (int)atomicAdd(qh, 1u); pulled = true; } }
    __device__ __forceinline__ FoxRef operator()() { const int li = __builtin_amdgcn_readfirstlane(slot[0]); nidx = (li < 128) ? (((li >> 2) << 5) | (4 * qx + (li & 3))) : 1024; FoxRef r;
        if (nidx < 1024) { njlo = fox_jlo(nidx, cums, base_all, smax2_l, att::fresh_lane()); r.idx = nidx; r.jlo_ = njlo; } else { njlo = cjlo; r.idx = cidx; r.jlo_ = cjlo; }
        return r; }
};
constexpr int N_PHASES = 8;
#ifndef MK_FUSED
#define MK_FUSED 1
#endif

__device__ __forceinline__ const float* karg_f(int idx) {
    const char __attribute__((address_space(4)))* kb = (const char __attribute__((address_space(4)))*)__builtin_amdgcn_kernarg_segment_ptr();
    int off = 8 * idx; asm volatile("" : "+s"(off));
    return (const float*)(const __attribute__((address_space(1))) float*)*(const unsigned long long __attribute__((address_space(4)))*)(kb + off);
}
__global__ void __launch_bounds__(NWAVES * 64, 2) mk_fwd(Args args) {
    extern __shared__ __attribute__((aligned(16))) unsigned char lds_raw[];
    LAS unsigned char* lds = (LAS unsigned char*)lds_raw;
    volatile LAS unsigned* MISC = (volatile LAS unsigned*)(lds + MISC_OFF);
    const int wv = __builtin_amdgcn_readfirstlane((int)threadIdx.x >> 6);
    constexpr int G = 256;
    const int bx = blockIdx.x;
#define vcu ((bx % 8) * (G / 8) + bx / 8)
    constexpr int NGW = G * NWAVES;
#define LANE_IDS() const int tid = att::fresh_tid(wv), lane = tid & 63, wave = wv, gw = vcu * NWAVES + wave; (void)lane; (void)gw
#define T0() (wv == 0 && att::fresh_tid(0) == 0)
    unsigned char* ws = args.ws;
    gu32* ctl = (gu32*)(ws + WS_CTL);
    float* out = args.out;
    float* stats0 = (float*)(ws + WS_STATS0); float* stats1 = (float*)(ws + WS_STATS1);
    bf16* hmeta = (bf16*)(ws + WS_HMETA); bf16* wff = (bf16*)(ws + WS_WFF);
    float* ftot = (float*)(ws + WS_ZF); float* fmeta = ftot + NB * 64 * 16; float* cums = (float*)(ws + WS_CUMS);
    float* ropeC = (float*)(ws + WS_ROPE); float* ropeS = ropeC + (size_t)LSEQ * 64;
    bf16* Wup = (bf16*)(ws + WS_WUP); bf16* Wdn = (bf16*)(ws + WS_WDN); bf16* Wout = (bf16*)(ws + WS_WOUT); bf16* Win = (bf16*)(ws + WS_WIN);
    bf16* h0b = (bf16*)(ws + WS_H0B); bf16* mixb = (bf16*)out;     bf16* qkv = (bf16*)(ws + WS_QKV);
    bf16* part0 = (bf16*)(ws + WS_PART0); bf16* part1 = (bf16*)(ws + WS_PART1);
    bf16* h1b = (bf16*)(ws + WS_H1B); bf16* actb = (bf16*)(ws + WS_ACT);
    float* rpart = (float*)(ws + WS_RPART); float* upart = (float*)(ws + WS_UPART); float* cpart = (float*)(ws + WS_CPART); float* ucol = (float*)(ws + WS_UCOL); float* ccol = (float*)(ws + WS_CCOL);

    for (int u = threadIdx.x; u < (LDS_BYTES - LDSCTL_OFF) / 4; u += NWAVES * 64) ((LAS unsigned*)(lds + LDSCTL_OFF))[u] = 0u;
    __syncthreads();
#if MK_FUSED
#define OPQ1() ({ int one_; asm volatile("s_mov_b32 %0, 1" : "=s"(one_)); one_ != 0; })
    constexpr int lo = 0, hi = N_PHASES;
#else
    const int lo = args.ph_lo, hi = args.ph_hi;
#define OPQ1() true
#endif
    if (hi - lo > 1) (void)xcd_barrier_post((unsigned*)(ctl + CW_BAR), MISC + 8, T0());
#define MKBAR() XcdBarrier bar_; bar_.bar = (unsigned*)(ctl + CW_BAR); bar_.x = xb_xcc_id(); bar_.st = MISC + 8
#ifndef REP_PHASE
#define REP_PHASE (-1)
#endif
#define IN(k) (lo <= (k) && (k) < hi && OPQ1())
#if defined(PROBE_SPIN)
    volatile LAS unsigned long long* PW = (volatile LAS unsigned long long*)(lds + LDSCTL_OFF + 1024);
    if (bx == 0 && T0()) PW[31] = __builtin_amdgcn_s_memrealtime();
#ifndef PROBE_PH
#define PROBE_PH (-9)
#endif
#define PSTAMP(k) do { if constexpr (PROBE_PH < 0 || (k) == PROBE_PH || (k) == PROBE_PH - 1) { if (bx == 0 && T0()) { const unsigned long long n_ = __builtin_amdgcn_s_memrealtime(); PW[k] = n_ - PW[31]; PW[31] = n_; } } } while (0)
#if defined(PROBE_EPI)
#define PCOPY(j) do { if (bx == 0 && T0()) PW[j] = PW[16]; } while (0)
#else
#define PCOPY(j) do { } while (0)
#endif
#if defined(PROBE_CLK)
#define PCLK0() do { if (bx == 0 && T0()) { PW[29] = __builtin_amdgcn_s_memtime(); PW[30] = __builtin_amdgcn_s_memrealtime(); } } while (0)
#define PCLK1(j) do { if (bx == 0 && T0()) { PW[j] = (__builtin_amdgcn_s_memtime() - PW[29]) * 1000ull / (__builtin_amdgcn_s_memrealtime() - PW[30]); } } while (0)
#else
#define PCLK0() do { } while (0)
#define PCLK1(j) do { } while (0)
#endif
#else
#define PSTAMP(k) do { } while (0)
#define PCOPY(j) do { } while (0)
#define PCLK0() do { } while (0)
#define PCLK1(j) do { } while (0)
#endif
#define NREP(k) ((REP_PHASE == (k)) ? 2 : 1)
#if defined(PROBE_SPIN) && defined(PROBE_SPREAD)
#define SEAM(k) do { if (IN(k) && IN((k) + 1)) { MKBAR(); if ((k) == PROBE_SPREAD && T0()) { const unsigned long long v_ = (__builtin_amdgcn_s_memrealtime() << 10) | (unsigned long long)bx; \
            atomicMax((unsigned long long*)(ctl + 2052), v_); atomicMax((unsigned long long*)(ctl + 2054), (1ull << 62) - v_); } xcd_barrier(bar_, T0()); } } while (0)
#elif defined(PROBE_SPIN) && defined(PROBE_SEAM)
#ifndef PROBE_BLK
#define PROBE_BLK 0
#endif
#define SEAM(k) do { if (IN(k) && IN((k) + 1)) { MKBAR(); unsigned long long sb_ = 0; if ((k) == PROBE_SEAM && bx == PROBE_BLK && T0()) sb_ = __builtin_amdgcn_s_memrealtime(); xcd_barrier(bar_, T0()); \
        if ((k) == PROBE_SEAM && bx == PROBE_BLK && T0()) atomicExch((unsigned*)(ctl + 2048), (unsigned)(__builtin_amdgcn_s_memrealtime() - sb_)); } } while (0)
#else
#define SEAM(k) do { if (IN(k) && IN((k) + 1)) { MKBAR(); xcd_barrier(bar_, T0()); } } while (0)
#endif

    if (IN(0)) {
        LANE_IDS();
        const float* x = karg_f(0); const float* meta_tok = karg_f(1); const float* ln_in_g = karg_f(2); const float* ln_in_b = karg_f(3);
        const float* w_in = karg_f(4);
        LAS float* scr = (LAS float*)(lds + RING_OFF + wave * 16384);
        constexpr int I_IN = 64 * 385;
        for (int it = gw; it < I_IN; it += NGW) { const int kb = it / 385, nb = it % 385;
            if (nb < 384) p0_transpose_item(w_in, INW, DM, Win, scr, 64 * kb, 32 * nb, 32, 1, lane);
            else p0_transpose_item(w_in, INW, DM, wff, scr, 64 * kb, NPROJ, 16, 2, lane);
        }
        for (int m = 2 * gw; m < MR; m += 2 * NGW) ln_rows<2>(x + (size_t)m * DM, DM, ln_in_g, ln_in_b, lane, nullptr, h0b + (size_t)m * DM, stats0 + 2 * m, 2);
        if (gw < NMETA) ln_row(meta_tok + (size_t)gw * DM, ln_in_g, ln_in_b, lane, nullptr, hmeta + (size_t)gw * DM, nullptr);
        for (int idx = bx * (NWAVES * 64) + tid; idx < LSEQ * 64; idx += G * NWAVES * 64) {
            const int pos = idx >> 6, i = idx & 63; const float ang = (float)pos * INV_FREQ[i]; double sn, cs; sincos_d((double)ang, sn, cs);
            ropeC[idx] = (float)cs; ropeS[idx] = (float)sn; }
        if (gw < NGRP * NB) { GAS v4u* p = (GAS v4u*)(qkv + ((size_t)gw * KVR + 16) * 128);
#pragma unroll
            for (int j = 0; j < 12; ++j) p[64 * j + lane] = (v4u){0u, 0u, 0u, 0u}; }
    }
    SEAM(0); PSTAMP(0);

    if (IN(1)) {
        LANE_IDS();
        const int r16 = lane & 15, q4 = lane >> 4;
        if (bx < 128) {
            const float* b_forget = karg_f(5);
            LAS float* wt = (LAS float*)(lds + LDSCTL_OFF + 2048);
            const int m0 = 128 * bx + 16 * wave;
            const bf16* ap = h0b + (size_t)(m0 + r16) * DM + 8 * q4; const bf16* bp = wff + (size_t)r16 * DM + 8 * q4;
            f32x4 acc = {0.f, 0.f, 0.f, 0.f};
            for (int k0 = 0; k0 < DM; k0 += 512) {
                bf16x8 av[16], bv[16];
#pragma unroll
                for (int j = 0; j < 16; ++j) { av[j] = *(const bf16x8*)(ap + k0 + 32 * j); bv[j] = *(const bf16x8*)(bp + k0 + 32 * j); }
                __builtin_amdgcn_sched_barrier(0);
#pragma unroll
                for (int j = 0; j < 16; ++j) acc = __builtin_amdgcn_mfma_f32_16x16x32_bf16(av[j], bv[j], acc, 0, 0, 0);
                __builtin_amdgcn_sched_barrier(0); }
            const float bfg = b_forget[r16];
            const float lf0 = log_sigmoid(acc[0] + bfg), lf1 = lf0 + log_sigmoid(acc[1] + bfg), lf2 = lf1 + log_sigmoid(acc[2] + bfg), lf3 = lf2 + log_sigmoid(acc[3] + bfg);
            float s = lf3; { const float u = lane_up(s, 16, lane); if (q4 >= 1) s += u; } { const float u = lane_up(s, 32, lane); if (q4 >= 2) s += u; }
            const float exg = s - lf3;
            if (q4 == 3) wt[wave * 16 + r16] = s;
            __syncthreads();
            float wex = 0.f, wall = 0.f;
#pragma unroll
            for (int w2 = 0; w2 < NWAVES; ++w2) { const float v = wt[w2 * 16 + r16]; wall += v; if (w2 < wave) wex += v; }
            const int b = m0 >> 13, t0 = (m0 & 8191) + 4 * q4; float* cp = cums + (size_t)(b * NFH + r16) * KVR + 64 + t0; const float o = wex + exg;
            cp[0] = o + lf0; cp[1] = o + lf1; cp[2] = o + lf2; cp[3] = o + lf3;
            if (wave == 0 && q4 == 0) ftot[(size_t)(b * 64 + (bx & 63)) * 16 + r16] = wall;
        } else if (bx < 128 + 96) {
            const int pn = (bx - 128) >> 1, hh = (bx - 128) & 1, wq = wave & 3, kh = wave >> 2, s = 64 * hh + 16 * wq + r16;
            const bf16* ap = hmeta + (size_t)r16 * DM + 8 * q4 + 2048 * kh; const bf16* bp0 = Win + (size_t)(256 * pn + s) * DM + 8 * q4 + 2048 * kh; const bf16* bp1 = bp0 + (size_t)128 * DM;
            f32x4 a0 = {0.f, 0.f, 0.f, 0.f}, a1 = {0.f, 0.f, 0.f, 0.f};
            for (int k0 = 0; k0 < DM / 2; k0 += 512) {
                bf16x8 av[16], b0v[16], b1v[16];
#pragma unroll
                for (int j = 0; j < 16; ++j) { av[j] = *(const bf16x8*)(ap + k0 + 32 * j); b0v[j] = *(const bf16x8*)(bp0 + k0 + 32 * j); b1v[j] = *(const bf16x8*)(bp1 + k0 + 32 * j); }
                __builtin_amdgcn_sched_barrier(0);
#pragma unroll
                for (int j = 0; j < 16; ++j) { a0 = __builtin_amdgcn_mfma_f32_16x16x32_bf16(av[j], b0v[j], a0, 0, 0, 0); a1 = __builtin_amdgcn_mfma_f32_16x16x32_bf16(av[j], b1v[j], a1, 0, 0, 0); }
                __builtin_amdgcn_sched_barrier(0); }
            { LAS f32x4* xch = (LAS f32x4*)(lds + RING_OFF) + (wq * 64 + lane) * 2;
              if (kh == 1) { xch[0] = a0; xch[1] = a1; }
              __syncthreads();
              if (kh == 0) { a0 = a0 + xch[0]; a1 = a1 + xch[1]; } }
            if (kh == 0) {
#pragma unroll
            for (int rg = 0; rg < 4; ++rg) { const int i = 4 * q4 + rg;
                if (pn < 16) { const int hh = s >> 6, dl = s & 63, g = 2 * pn + hh; const float c = ropeC[i * 64 + dl], sn = ropeS[i * 64 + dl];
                    const unsigned o1 = f2bf(a0[rg] * c - a1[rg] * sn), o2 = f2bf(a1[rg] * c + a0[rg] * sn);
#pragma unroll
                    for (int b = 0; b < NB; ++b) { bf16* p = qkv + ((size_t)(g * NB + b) * KVR + i) * 128 + dl; p[0] = (bf16)o1; p[64] = (bf16)o2; }
                } else {
#pragma unroll
                    for (int b = 0; b < NB; ++b) { qkv[((size_t)((2 * pn) * NB + b) * KVR + i) * 128 + s] = (bf16)f2bf(a0[rg]); qkv[((size_t)((2 * pn + 1) * NB + b) * KVR + i) * 128 + s] = (bf16)f2bf(a1[rg]); }
                } }
            if (pn >= 32 && pn < 40) {
                float m0 = 0.f, m1 = 0.f;
#pragma unroll
                for (int rg = 0; rg < 4; ++rg) { float s0 = a0[rg] * a0[rg], s1 = a1[rg] * a1[rg];
#pragma unroll
                    for (int o = 1; o < 16; o <<= 1) { s0 += lane_xor(s0, o, lane); s1 += lane_xor(s1, o, lane); }
                    m0 = fmaxf(m0, s0); m1 = fmaxf(m1, s1); }
                m0 = fmaxf(m0, lane_xor(m0, 16, lane)); m0 = fmaxf(m0, lane_xor(m0, 32, lane)); m1 = fmaxf(m1, lane_xor(m1, 16, lane)); m1 = fmaxf(m1, lane_xor(m1, 32, lane));
                if (lane == 0) { gu32* nrm = ctl + CW_NRM;
#pragma unroll
                    for (int b = 0; b < NB; ++b) { atomicMax((unsigned*)nrm + ((2 * pn - 48) * NB + b) * 16 + 4 + 4 * hh + wq, __float_as_uint(m0 * 1.02f)); atomicMax((unsigned*)nrm + ((2 * pn + 1 - 48) * NB + b) * 16 + 4 + 4 * hh + wq, __float_as_uint(m1 * 1.02f)); } }
            }
            }
            __syncthreads();
        } else if (bx == 224) {
            const float* b_forget = karg_f(5);
            const bf16* ap = hmeta + (size_t)r16 * DM + 8 * q4 + 512 * wave; const bf16* bp = wff + (size_t)r16 * DM + 8 * q4 + 512 * wave;
            f32x4 acc = {0.f, 0.f, 0.f, 0.f};
            {   bf16x8 av[16], bv[16];
#pragma unroll
                for (int j = 0; j < 16; ++j) { av[j] = *(const bf16x8*)(ap + 32 * j); bv[j] = *(const bf16x8*)(bp + 32 * j); }
                __builtin_amdgcn_sched_barrier(0);
#pragma unroll
                for (int j = 0; j < 16; ++j) acc = __builtin_amdgcn_mfma_f32_16x16x32_bf16(av[j], bv[j], acc, 0, 0, 0);
                __builtin_amdgcn_sched_barrier(0); }
            LAS f32x4* xch = (LAS f32x4*)(lds + RING_OFF);
            xch[wave * 64 + lane] = acc;
            __syncthreads();
            if (wave == 0) {
#pragma unroll
                for (int w2 = 1; w2 < NWAVES; ++w2) acc = acc + xch[w2 * 64 + lane];
                const float bfg = b_forget[r16];
                const float lf0 = log_sigmoid(acc[0] + bfg), lf1 = lf0 + log_sigmoid(acc[1] + bfg), lf2 = lf1 + log_sigmoid(acc[2] + bfg), lf3 = lf2 + log_sigmoid(acc[3] + bfg);
                float s = lf3; { const float u = lane_up(s, 16, lane); if (q4 >= 1) s += u; } { const float u = lane_up(s, 32, lane); if (q4 >= 2) s += u; }
                const float exg = s - lf3;
#pragma unroll
                for (int b = 0; b < NB; ++b) { float* cp = cums + (size_t)(b * NFH + r16) * KVR + 4 * q4; cp[0] = exg + lf0; cp[1] = exg + lf1; cp[2] = exg + lf2; cp[3] = exg + lf3; }
                if (q4 == 3) fmeta[r16] = s;
            }
            __syncthreads();
        }
        pg8::Gemm g{h0b, Win, MR, NPROJ, DM}; pg8::StaticOrder S; S.init(MR, NPROJ, G, bx);
        pg8::EpiProj E{qkv, ropeC, ropeS, KVR, NB, (unsigned*)(ctl + CW_NRM)};
        xcd_stagger(STAG_BF);
        pg8::gemm_phase<pg8::EpiProj, pg8::StaticOrder, PG8_ALIGN, PG8_SP2>(lds + RING_OFF, g, S, E, wv); PCOPY(17);
    }
    SEAM(1); PSTAMP(1);

    if (IN(2)) {
        PCLK0();
        const ABS AB{(const att::bf16*)qkv, (att::bf16*)out, cums};
        LAS float* base_all = (LAS float*)(lds + LDSCTL_OFF + 4096);
        LAS float* smax2_l = (LAS float*)(lds + LDSCTL_OFF + 12288);
        volatile LAS int* qslot = (volatile LAS int*)(lds + LDSCTL_OFF + 12288 + 128);
#define QSLOT() ({ int qo_ = LDSCTL_OFF + 12288 + 128; asm volatile("" : "+s"(qo_)); (volatile LAS int*)(lds + qo_); })
        gu32* qh = ctl + CW_QUEUE;
        if (((bx >> 3) & 1) == 0) { LANE_IDS(); late_weight_conv(karg_f(11), karg_f(14), karg_f(15), Wout, Wup, Wdn, (LAS float*)(lds + RING_OFF + wave * 16384), gw, lane, karg_f(12), karg_f(13), upart, cpart); __syncthreads(); }
        int ci = 0;
        {   LANE_IDS();
#pragma unroll
            for (int k = 0; k < 4; ++k) { const int bh = wave * 4 + k, b = bh >> 4, h = bh & 15;
                const float v = ftot[(size_t)(b * 64 + lane) * 16 + h]; float s = v;
#pragma unroll
                for (int o = 1; o < 64; o <<= 1) { const float u = lane_up(s, o, lane); if (lane >= o) s += u; }
                base_all[bh * 64 + lane] = fmeta[h] + (s - v); }
            if (tid < 32) { const int b = tid >> 4, h = tid & 15; const gu32* nq = ctl + CW_NRM + (h * NB + b) * 16; const gu32* nk = ctl + CW_NRM + ((16 + h) * NB + b) * 16;
                float q2 = 0.f, k2 = 0.f, km2 = 0.f;
#pragma unroll
                for (int s = 0; s < 4; ++s) { q2 += __uint_as_float(nq[s]); k2 += __uint_as_float(nk[s]); }
#pragma unroll
                for (int s = 4; s < 12; ++s) km2 += __uint_as_float(nk[s]);
                smax2_l[tid] = 2.f * sqrtf(q2 * fmaxf(k2, km2)) * att::SCALE; }
            __syncthreads();
        }
#define XCC() ((int)(xb_xcc_id() & 7u))
#pragma unroll 1
        for (int kq = 0; kq < 8; ++kq) {
          const int qx = (XCC() + kq) & 7;
#pragma unroll 1
          for (;;) {
            __syncthreads();
            if (T0()) qslot[0] = (int)atomicAdd((unsigned*)(ctl + CW_QUEUE2 + 64 * qx), 1u);
            __syncthreads();
            ci = qslot[0];
            if (ci >= 64) break;
            const int qb = 31 - (ci >> 1), rr = 2 * qx + (ci & 1);
#pragma unroll 1
            for (int c = 0; c < 2; ++c) { const att::DiffRef R = mkref_diff(rr, c, qb); att::diff_block(R, (const att::bf16*)qkv, (att::bf16*)ws, 2048, (char*)lds_raw, wv); }
            asm volatile("s_waitcnt vmcnt(0)" ::: "memory"); __syncthreads();
            {   LANE_IDS();
                const float* lq1 = karg_f(6); const float* lk1 = karg_f(7); const float* lq2 = karg_f(8); const float* lk2 = karg_f(9); const float* subln_g = karg_f(10);
                const float s1 = wave_sum(lq1[lane] * lk1[lane] + lq1[lane + 64] * lk1[lane + 64], lane), s2 = wave_sum(lq2[lane] * lk2[lane] + lq2[lane + 64] * lk2[lane + 64], lane);
                const float lam = expf(s1) - expf(s2) + LAMBDA_INIT;
                const f32x4 gl = *(const f32x4*)(subln_g + 4 * lane) * (1.0f - LAMBDA_INIT);
                const int b = rr >> 3, h = rr & 7; const size_t m0 = (size_t)b * T + 256 * qb + 32 * wave;
#pragma unroll 4
                for (int r = 0; r < 32; ++r) { const size_t m = m0 + r;
                    const unsigned long long u0 = *((const GAS unsigned long long*)(part0 + m * 2048 + h * 256) + lane), u1 = *((const GAS unsigned long long*)(part1 + m * 2048 + h * 256) + lane);
                    f32x4 d; d.x = bf2f((unsigned)u0 & 0xffffu) - lam * bf2f((unsigned)u1 & 0xffffu); d.y = bf2f(((unsigned)u0 >> 16)) - lam * bf2f(((unsigned)u1 >> 16));
                    d.z = bf2f((unsigned)(u0 >> 32) & 0xffffu) - lam * bf2f((unsigned)(u1 >> 32) & 0xffffu); d.w = bf2f((unsigned)(u0 >> 48)) - lam * bf2f((unsigned)(u1 >> 48));
                    const float ss = wave_sum((d.x * d.x + d.y * d.y) + (d.z * d.z + d.w * d.w), lane);
                    const float rq = 1.f / sqrtf(ss * (1.f / 256.f) + SUBLN_EPS);
                    const f32x4 o = d * rq * gl;
                    *((GAS unsigned long long*)(mixb + ((m >> 8) * 512 + (m & 255)) * DM + h * 256) + lane) = (unsigned long long)pk2(o.x, o.y) | ((unsigned long long)pk2(o.z, o.w) << 32); }
            }
          }
        }
        if (((bx >> 3) & 1) == 1) { __syncthreads(); LANE_IDS(); late_weight_conv(karg_f(11), karg_f(14), karg_f(15), Wout, Wup, Wdn, (LAS float*)(lds + RING_OFF + wave * 16384), gw, lane, karg_f(12), karg_f(13), upart, cpart); __syncthreads(); }
#pragma unroll 1
        for (int kf = 0; kf < 8; ++kf) {
            const int qxf = ((int)(xb_xcc_id() & 7u) + kf) & 7;
            __syncthreads();
            if (T0()) QSLOT()[0] = (int)atomicAdd((unsigned*)(ctl + CW_QUEUE3 + 64 * qxf), 1u);
            __syncthreads();
            const int li0 = QSLOT()[0];
            if (li0 >= 128) continue;
            ci = ((li0 >> 2) << 5) | (4 * qxf + (li0 & 3));
            att::Seam<att::bf16> S; S.st_b = 0.f; int cj = fox_jlo(ci, cums, base_all, smax2_l, att::fresh_lane());
            { FoxRef cur; cur.idx = ci; cur.jlo_ = cj; att::causal_swa_prime<att::bf16, att::bf16, 1, FoxRef>(cur, AB, 1 << 30, (char*)lds_raw, S, wv); }
#pragma unroll 1
            for (;;) {
                FoxNext nf; nf.cidx = ci; nf.cjlo = cj; nf.nidx = 1024; nf.njlo = 0; nf.pulled = false; nf.wv_ = wv; nf.qx = qxf; nf.qh = (unsigned*)(ctl + CW_QUEUE3 + 64 * qxf); nf.slot = qslot; nf.cums = cums; nf.base_all = base_all; nf.smax2_l = smax2_l;
                { FoxRef cur; cur.idx = ci; cur.jlo_ = cj; att::causal_swa_block<att::bf16, att::bf16, 1, FoxRef, FoxNext>(cur, nf, AB, KVR, 1 << 30, (char*)lds_raw, S, wv); }
                if (nf.nidx >= 1024) break;
                ci = nf.nidx; cj = nf.njlo;
            }
        }
    }
    PCLK1(22);
    SEAM(2); PSTAMP(2);

    if (IN(3)) {
        {   LANE_IDS();
            LAS float* red = (LAS float*)(lds + LDSCTL_OFF + 4096);
            const int nl = tid & 63, ch = tid >> 6, n = bx * 64 + nl; float us = 0.f, cs = 0.f;
#pragma unroll
            for (int kb = 0; kb < 8; ++kb) { us += upart[(size_t)(8 * ch + kb) * FFW + n]; cs += cpart[(size_t)(8 * ch + kb) * FFW + n]; }
            red[ch * 64 + nl] = us; red[512 + ch * 64 + nl] = cs;
            __syncthreads();
            if (tid < 128) { const LAS float* r = red + (tid >> 6) * 512 + nl; float a = 0.f;
#pragma unroll
                for (int k2 = 0; k2 < 8; ++k2) a += r[k2 * 64];
                __hip_atomic_store((tid < 64 ? ucol : ccol) + n, a, RLX_AGENT); }
            asm volatile("s_waitcnt vmcnt(0)" ::: "memory"); __syncthreads();
            if (T0()) (void)xb_add((unsigned*)(ctl + CW_UC), 1u); }
        const float* x = karg_f(0); const float* ln_in_g = karg_f(2); const float* ln_in_b = karg_f(3);
        pg8::Gemm g{mixb, Wout, MR, DM, DM, 1}; pg8::StaticOrder S; S.init(MR, DM, G, bx);
        pg8::EpiOutS E{x, stats0, ln_in_g, ln_in_b, h1b, DM, DN_ALPHA, rpart};
        pg8::gemm_phase<pg8::EpiOutS, pg8::StaticOrder, PG8_ALIGN, PG8_SP2>(lds + RING_OFF, g, S, E, wv); PCOPY(18);
    }
    if (IN(3) && IN(5)) grp_barrier(ctl, 2, bx, T0());
    PSTAMP(3);

    PSTAMP(4);

    if (IN(5)) {
        pg8::Gemm g{h1b, Wup, MR, FFW, DM}; pg8::StaticOrder S; S.init(MR, FFW, G, bx);
        LAS float* st1 = (LAS float*)(lds + LDSCTL_OFF + 4096);
        {   LANE_IDS(); pg8::Unit u0; S.next(0, u0);
            const int rl = tid >> 1, hf = tid & 1, row = u0.pm * 256 + rl; const GAS f32x4* p = (const GAS f32x4*)(rpart + (size_t)row * 128 + 64 * hf);
            float s1 = 0.f, s2 = 0.f;
#pragma unroll
            for (int i = 0; i < 16; ++i) { const f32x4 v = p[i]; s1 += v.x + v.z; s2 += v.y + v.w; }
            s1 += lane_xor(s1, 1, lane); s2 += lane_xor(s2, 1, lane);
            const float mean = s1 * (1.f / DM), var = fmaxf(s2 * (1.f / DM) - mean * mean, 0.f), rstd = 1.f / sqrtf(var + LN_EPS);
            if (hf == 0) { st1[2 * rl] = mean; st1[2 * rl + 1] = rstd; if (bx < 64) { stats1[2 * row] = mean; stats1[2 * row + 1] = rstd; } }
            if (T0()) { unsigned* bar = (unsigned*)(ctl + CW_BAR); XB_SPIN(xb_ld((unsigned*)(ctl + CW_UC)) < 256u, bar); __builtin_amdgcn_fence(__ATOMIC_ACQUIRE, "agent"); asm volatile("s_waitcnt vmcnt(0)" ::: "memory"); }
            __syncthreads(); }
        pg8::EpiUpS E{actb, FFW, ucol, ccol, st1};
        xcd_stagger(STAG_BF);
        PCLK0();
        pg8::gemm_phase<pg8::EpiUpS, pg8::StaticOrder, PG8_ALIGN, PG8_SP2>(lds + RING_OFF, g, S, E, wv); PCOPY(19); PCLK1(21);
    }
    if (IN(5) && IN(6)) grp_barrier(ctl, 0, bx, T0());
    PSTAMP(5);

    if (IN(6)) {
        const float* ln_attn_g = karg_f(12); const float* ln_attn_b = karg_f(13);
        pg8::Gemm g{actb, Wdn, MR, DM, FFW}; pg8::StaticOrder S; S.init(MR, DM, G, bx);
        pg8::EpiDownB E{h1b, (bf16*)out + DM, stats1, ln_attn_g, ln_attn_b, DM, DN_ALPHA, 2 * DM};
        pg8::gemm_phase<pg8::EpiDownB, pg8::StaticOrder, PG8_ALIGN, PG8_SP2>(lds + RING_OFF, g, S, E, wv); PCOPY(20);
    }
    if (IN(6) && IN(7)) grp_barrier(ctl, 1, bx, T0());
    PSTAMP(6);

    if (IN(7)) { PCLK0(); LANE_IDS(); const float* ln_mlp_g = karg_f(16); const float* ln_mlp_b = karg_f(17);
        const int m0 = (8 * (bx & 7) + ((bx >> 3) & 7)) * 256 + 64 * (bx >> 6) + 8 * wave;
#pragma unroll 1
        for (int m = m0; m < m0 + 8; m += 2) ln_rows_b<2>((const bf16*)out + (size_t)m * (2 * DM) + DM, 2 * DM, ln_mlp_g, ln_mlp_b, lane, out + (size_t)m * DM, nullptr, nullptr, 0, DM); }
    PCLK1(23); PSTAMP(7);
#if defined(PROBE_SPIN)
#ifndef PROBE_MUL
#define PROBE_MUL 1
#endif
#ifndef PROBE_DIV
#define PROBE_DIV 1
#endif
    const unsigned PSEAM = __hip_atomic_load((unsigned*)(ctl + 2048), __ATOMIC_RELAXED, __HIP_MEMORY_SCOPE_AGENT); (void)PSEAM;
    const unsigned long long PMAXV = __hip_atomic_load((unsigned long long*)(ctl + 2052), __ATOMIC_RELAXED, __HIP_MEMORY_SCOPE_AGENT), PMINV = (1ull << 62) - __hip_atomic_load((unsigned long long*)(ctl + 2054), __ATOMIC_RELAXED, __HIP_MEMORY_SCOPE_AGENT);
    const unsigned long long PSPREAD = (PMAXV >> 10) - (PMINV >> 10), PLASTBLK = PMAXV & 1023ull, PFIRSTBLK = PMINV & 1023ull; (void)PSPREAD; (void)PLASTBLK; (void)PFIRSTBLK;
    if (bx == 0 && T0()) { const unsigned long long w = (unsigned long long)(PROBE_SPIN) * PROBE_MUL / PROBE_DIV, t0 = __builtin_amdgcn_s_memrealtime();
        while (__builtin_amdgcn_s_memrealtime() - t0 < w) __builtin_amdgcn_s_sleep(8); }
#endif
#undef IN
#undef SEAM
}

extern "C" void kernel_launch(void* const* d_in, const int* in_sizes, int n_in, void* d_out, int out_size, void* d_ws, size_t ws_size, hipStream_t stream) {
    static int grid = 0;
    if (grid == 0) {
        if (n_in != 18 || in_sizes[0] != MR * DM || out_size != MR * DM || ws_size < WS_END) { fprintf(stderr, "kernel_launch: shape/workspace mismatch (n_in %d, in0 %d, out %d, ws %zu < %zu)\n", n_in, n_in > 0 ? in_sizes[0] : -1, out_size, ws_size, (size_t)WS_END); grid = -1; return; }
        if (hipFuncSetAttribute((const void*)mk_fwd, hipFuncAttributeMaxDynamicSharedMemorySize, LDS_BYTES) != hipSuccess) { fprintf(stderr, "kernel_launch: hipFuncSetAttribute failed\n"); grid = -1; return; }
        int per_cu = 0;
        if (hipOccupancyMaxActiveBlocksPerMultiprocessor(&per_cu, (const void*)mk_fwd, NWAVES * 64, LDS_BYTES) != hipSuccess || per_cu < 1) fprintf(stderr, "kernel_launch: occupancy query reports %d\n", per_cu);
        (void)hipGetLastError();
        grid = 256;
    }
    if (grid < 0) return;
    if (hipMemsetAsync((char*)d_ws + WS_CTL, 0, CTL_ZERO_BYTES, stream) != hipSuccess) { fprintf(stderr, "kernel_launch: memset failed\n"); return; }
    Args a{};
    for (int i = 0; i < 18; ++i) a.in[i] = (const float*)d_in[i];
    a.out = (float*)d_out; a.ws = (unsigned char*)d_ws;
#if MK_FUSED
    a.ph_lo = 0; a.ph_hi = N_PHASES;
    hipLaunchKernelGGL(mk_fwd, dim3(grid), dim3(NWAVES * 64), LDS_BYTES, stream, a);
#else
    for (int p = 0; p < N_PHASES; ++p) { a.ph_lo = p; a.ph_hi = p + 1;
        for (int r = 0; r < ((p == REP_PHASE) ? 2 : 1); ++r) hipLaunchKernelGGL(mk_fwd, dim3(grid), dim3(NWAVES * 64), LDS_BYTES, stream, a); }
#endif
    const hipError_t le = hipPeekAtLastError();
    if (le != hipSuccess) fprintf(stderr, "kernel_launch: launch failed: %s\n", hipGetErrorName(le));
}
```

```cpp
#include <hip/hip_runtime.h>
#include <hip/hip_bf16.h>
#include <cstdio>
#include <cstdint>
#include <cmath>
#ifndef MK_FUSED
#define MK_FUSED 1
#endif
#ifndef REP_PHASE
#define REP_PHASE -1
#endif
#if 1
#endif
__device__ __forceinline__ int mk_lane_id() { return (int)__builtin_amdgcn_mbcnt_hi(~0u, __builtin_amdgcn_mbcnt_lo(~0u, 0u)); }
namespace pg8 {
#define PG8_LAS __attribute__((address_space(3)))
typedef unsigned short bf16_t;
typedef short bf16x8 __attribute__((ext_vector_type(8)));
typedef float f32x4 __attribute__((ext_vector_type(4)));
typedef unsigned u32x4 __attribute__((ext_vector_type(4)));
constexpr int BM = 256, BK = 64, HALF = 128, HTB = HALF * BK * 2  , STAGE_BYTES = 8 * HTB, NXCD = 8, WGM = 8;

__host__ __device__ __forceinline__ int lds_byte(int r, int c) { const int st = (r >> 4) * 2 + (c >> 5), rr = r & 15, cc = c & 31, ob = rr * 64 + cc * 2; return st * 1024 + (ob ^ (((ob >> 9) & 1) << 5)); }
__host__ __device__ __forceinline__ void stage_rc(int b, int& R, int& C) { const int st = b / 1024, sb = b % 1024, swz = sb ^ (((sb >> 9) & 1) << 5); R = (st >> 1) * 16 + swz / 64; C = (st & 1) * 32 + (swz % 64) / 2; }
__host__ __device__ __forceinline__ int perm32(int rho) { const int n = rho >> 4, i = rho & 15; return 8 * (i >> 2) + 4 * n + (i & 3); }

struct Unit { int pm, pn; };
struct Gemm { const bf16_t* A; const bf16_t* Bt; int M, N, K; int ashift; };

struct StaticOrder {
    int nM, nN, nwg, G, c;
    __host__ __device__ void init(int M, int N, int G_, int c_) { nM = M / BM; nN = N / BM; nwg = nM * nN; G = G_; c = c_; }
    __host__ __device__ bool next(int i, Unit& u) const {
        const long L = (long)i * G + c; if (L >= nwg) return false;
        int wgid = (int)L; { const int q = nwg / NXCD, r = nwg % NXCD, xcd = wgid % NXCD, off = wgid / NXCD; wgid = (xcd < r ? xcd * (q + 1) : r * (q + 1) + (xcd - r) * q) + off; }
        const int nig = WGM * nN, gid = wgid / nig, fm = gid * WGM, gsz = (nM - fm) < WGM ? (nM - fm) : WGM;
        u.pm = fm + ((wgid % nig) % gsz); u.pn = (wgid % nig) / gsz; return true;
    }
    __device__ __forceinline__ void a_ready(const Unit&) const {}
    __device__ __forceinline__ void done(const Unit&) const {}
};

__device__ __forceinline__ unsigned cvt_pk_bf16(float lo, float hi) { unsigned r; asm volatile("v_cvt_pk_bf16_f32 %0, %1, %2" : "=v"(r) : "v"(lo), "v"(hi)); return r; }
__device__ __forceinline__ u32x4 pack8bf(const f32x4 v0, const f32x4 v1) { u32x4 w; w.x = cvt_pk_bf16(v0[0], v0[1]); w.y = cvt_pk_bf16(v0[2], v0[3]); w.z = cvt_pk_bf16(v1[0], v1[1]); w.w = cvt_pk_bf16(v1[2], v1[3]); return w; }

struct EpiProj {
    static constexpr bool PERM = true, AFTER_DRAIN = false;
    bf16_t* QKV; const float* ropeC; const float* ropeS; int kvr, nb; unsigned* nrm;
    __device__ __forceinline__ void operator()(const f32x4 (&acc)[2][2][4][2], const Unit& u, int wr, int wc, int fr, int fq) const {
        const int m0 = u.pm * BM, b = m0 >> 13, t0 = (m0 & 8191) + wr * 64 + fr;
        if (u.pn < 16) {
            const int hh = wc >> 1, dl0 = 32 * (wc & 1) + 8 * fq, g = 2 * u.pn + hh;
            bf16_t* base = QKV + ((size_t)(g * nb + b) * kvr + 64) * 128 + dl0;
#pragma unroll
            for (int ai = 0; ai < 2; ++ai)
#pragma unroll
                for (int m = 0; m < 4; ++m) { const int t = t0 + ai * HALF + m * 16; const float* cp = ropeC + (size_t)(16 + t) * 64 + dl0; const float* sp = ropeS + (size_t)(16 + t) * 64 + dl0;
                    const f32x4 c0 = *(const f32x4*)cp, c1 = *(const f32x4*)(cp + 4), s0 = *(const f32x4*)sp, s1 = *(const f32x4*)(sp + 4);
                    const f32x4 x1a = acc[ai][0][m][0], x1b = acc[ai][0][m][1], x2a = acc[ai][1][m][0], x2b = acc[ai][1][m][1];
                    const f32x4 o1a = x1a * c0 - x2a * s0, o1b = x1b * c1 - x2b * s1, o2a = x2a * c0 + x1a * s0, o2b = x2b * c1 + x1b * s1;
                    bf16_t* rowp = base + (size_t)t * 128;
                    *(u32x4*)rowp = pack8bf(o1a, o1b); *(u32x4*)(rowp + 64) = pack8bf(o2a, o2b); }
        } else {
#pragma unroll
            for (int bj = 0; bj < 2; ++bj) { const int g = 2 * u.pn + bj; bf16_t* base = QKV + ((size_t)(g * nb + b) * kvr + 64) * 128 + 32 * wc + 8 * fq;
#pragma unroll
                for (int ai = 0; ai < 2; ++ai)
#pragma unroll
                    for (int m = 0; m < 4; ++m) { const int t = t0 + ai * HALF + m * 16; *(u32x4*)(base + (size_t)t * 128) = pack8bf(acc[ai][bj][m][0], acc[ai][bj][m][1]); } }
            if (u.pn >= 24 && u.pn < 40) {
#pragma unroll
                for (int bj = 0; bj < 2; ++bj) { float mx = 0.f;
#pragma unroll
                    for (int ai = 0; ai < 2; ++ai)
#pragma unroll
                        for (int m = 0; m < 4; ++m) { const f32x4 a = acc[ai][bj][m][0], c = acc[ai][bj][m][1];
                            float ss = (a[0] * a[0] + a[1] * a[1]) + (a[2] * a[2] + a[3] * a[3]) + (c[0] * c[0] + c[1] * c[1]) + (c[2] * c[2] + c[3] * c[3]);
                            ss += __shfl_xor(ss, 16); ss += __shfl_xor(ss, 32); mx = fmaxf(mx, ss); }
                    mx = fmaxf(mx, __shfl_xor(mx, 1)); mx = fmaxf(mx, __shfl_xor(mx, 2)); mx = fmaxf(mx, __shfl_xor(mx, 4)); mx = fmaxf(mx, __shfl_xor(mx, 8));
                    if (fr == 0 && fq == 0) atomicMax(nrm + ((2 * u.pn + bj - 48) * nb + b) * 16 + wc, __float_as_uint(mx * 1.02f)); }
            }
        }
    }
};
struct EpiOut {
    static constexpr bool PERM = false, AFTER_DRAIN = false;
    const float* X; const float* stats; const float* g; const float* bta; float* Y; int ldc; float alpha;
    __device__ __forceinline__ void operator()(const f32x4 (&acc)[2][2][4][2], const Unit& u, int wr, int wc, int fr, int fq) const {
        const int row0 = u.pm * BM + wr * 64 + fr, col0 = u.pn * BM + wc * 32 + 4 * fq;
        f32x4 gv[2][2], bv[2][2];
#pragma unroll
        for (int bj = 0; bj < 2; ++bj)
#pragma unroll
            for (int n = 0; n < 2; ++n) { gv[bj][n] = *(const f32x4*)(g + col0 + bj * HALF + n * 16); bv[bj][n] = *(const f32x4*)(bta + col0 + bj * HALF + n * 16); }
#pragma unroll
        for (int ai = 0; ai < 2; ++ai)
#pragma unroll
            for (int m = 0; m < 4; ++m) { const int r = row0 + ai * HALF + m * 16; const float mu = stats[2 * r], rs = stats[2 * r + 1] * alpha; const size_t off = (size_t)r * ldc + col0;
#pragma unroll
                for (int bj = 0; bj < 2; ++bj)
#pragma unroll
                    for (int n = 0; n < 2; ++n) { const f32x4 xv = *(const f32x4*)(X + off + bj * HALF + n * 16);
                        *(f32x4*)(Y + off + bj * HALF + n * 16) = (xv - mu) * rs * gv[bj][n] + bv[bj][n] * alpha + acc[ai][bj][m][n]; }
                if (m & 1) asm volatile("" ::: "memory"); }
    }
};
struct EpiUp {
    static constexpr bool PERM = true, AFTER_DRAIN = false;
    bf16_t* O; int ldc;
    __device__ __forceinline__ void operator()(const f32x4 (&acc)[2][2][4][2], const Unit& u, int wr, int wc, int fr, int fq) const {
        const int row0 = u.pm * BM + wr * 64 + fr, col0 = u.pn * BM + wc * 32 + 8 * fq;
#pragma unroll
        for (int ai = 0; ai < 2; ++ai)
#pragma unroll
            for (int m = 0; m < 4; ++m) { bf16_t* rowp = O + (size_t)(row0 + ai * HALF + m * 16) * ldc + col0;
#pragma unroll
                for (int bj = 0; bj < 2; ++bj) { f32x4 v0 = acc[ai][bj][m][0], v1 = acc[ai][bj][m][1];
#pragma unroll
                    for (int e = 0; e < 4; ++e) { const float a = fmaxf(v0[e], 0.f), c = fmaxf(v1[e], 0.f); v0[e] = a * a; v1[e] = c * c; }
                    *(u32x4*)(rowp + bj * HALF) = pack8bf(v0, v1); } }
    }
};
struct EpiDown {
    static constexpr bool PERM = false, AFTER_DRAIN = false;
    float* Y; const float* stats; const float* g; const float* bta; int ldc; float alpha;
    __device__ __forceinline__ void operator()(const f32x4 (&acc)[2][2][4][2], const Unit& u, int wr, int wc, int fr, int fq) const {
        const int row0 = u.pm * BM + wr * 64 + fr, col0 = u.pn * BM + wc * 32 + 4 * fq;
        f32x4 gv[2][2], bv[2][2];
#pragma unroll
        for (int bj = 0; bj < 2; ++bj)
#pragma unroll
            for (int n = 0; n < 2; ++n) { gv[bj][n] = *(const f32x4*)(g + col0 + bj * HALF + n * 16); bv[bj][n] = *(const f32x4*)(bta + col0 + bj * HALF + n * 16); }
#pragma unroll
        for (int ai = 0; ai < 2; ++ai)
#pragma unroll
            for (int m = 0; m < 4; ++m) { const int r = row0 + ai * HALF + m * 16; const float mu = stats[2 * r], rs = stats[2 * r + 1] * alpha; const size_t off = (size_t)r * ldc + col0;
#pragma unroll
                for (int bj = 0; bj < 2; ++bj)
#pragma unroll
                    for (int n = 0; n < 2; ++n) { float* p = Y + off + bj * HALF + n * 16; const f32x4 yv = *(const f32x4*)p;
                        *(f32x4*)p = (yv - mu) * rs * gv[bj][n] + bv[bj][n] * alpha + acc[ai][bj][m][n]; }
                if (m & 1) asm volatile("" ::: "memory"); }
    }
};

__device__ __forceinline__ void unpack8bf(const u32x4 w, f32x4& lo, f32x4& hi) {
    lo[0] = __builtin_bit_cast(float, w.x << 16); lo[1] = __builtin_bit_cast(float, w.x & 0xffff0000u); lo[2] = __builtin_bit_cast(float, w.y << 16); lo[3] = __builtin_bit_cast(float, w.y & 0xffff0000u);
    hi[0] = __builtin_bit_cast(float, w.z << 16); hi[1] = __builtin_bit_cast(float, w.z & 0xffff0000u); hi[2] = __builtin_bit_cast(float, w.w << 16); hi[3] = __builtin_bit_cast(float, w.w & 0xffff0000u);
}
struct EpiOutB {
    static constexpr bool PERM = true, AFTER_DRAIN = false;
    const float* X; const float* stats; const float* g; const float* bta; bf16_t* Yb; int ldc; float alpha;
    __device__ __forceinline__ void operator()(const f32x4 (&acc)[2][2][4][2], const Unit& u, int wr, int wc, int fr, int fq) const {
        const int row0 = u.pm * BM + wr * 64 + fr, col0 = u.pn * BM + wc * 32 + 8 * fq;
        f32x4 gv[2][2], bv[2][2];
#pragma unroll
        for (int bj = 0; bj < 2; ++bj)
#pragma unroll
            for (int n = 0; n < 2; ++n) { gv[bj][n] = *(const f32x4*)(g + col0 + bj * HALF + n * 4); bv[bj][n] = *(const f32x4*)(bta + col0 + bj * HALF + n * 4) * alpha; }
#pragma unroll
        for (int ai = 0; ai < 2; ++ai)
#pragma unroll
            for (int m = 0; m < 4; ++m) { const int r = row0 + ai * HALF + m * 16; const float mu = stats[2 * r], rs = stats[2 * r + 1] * alpha; const size_t off = (size_t)r * ldc + col0;
#pragma unroll
                for (int bj = 0; bj < 2; ++bj) { const f32x4 x0 = *(const f32x4*)(X + off + bj * HALF), x1 = *(const f32x4*)(X + off + bj * HALF + 4);
                    const f32x4 y0 = (x0 - mu) * rs * gv[bj][0] + bv[bj][0] + acc[ai][bj][m][0], y1 = (x1 - mu) * rs * gv[bj][1] + bv[bj][1] + acc[ai][bj][m][1];
                    *(u32x4*)(Yb + off + bj * HALF) = pack8bf(y0, y1); }
                if (m & 1) asm volatile("" ::: "memory"); }
    }
};
struct EpiOutS {
    static constexpr bool PERM = true, AFTER_DRAIN = false;
    const float* X; const float* stats; const float* g; const float* bta; bf16_t* Yb; int ldc; float alpha; float* rpart;
    __device__ __forceinline__ void operator()(const f32x4 (&acc)[2][2][4][2], const Unit& u, int wr, int wc, int fr, int fq) const {
        const int row0 = u.pm * BM + wr * 64 + fr, col0 = u.pn * BM + wc * 32 + 8 * fq, lane = fq * 16 + fr;
        f32x4 gv[2][2], bv[2][2];
#pragma unroll
        for (int bj = 0; bj < 2; ++bj)
#pragma unroll
            for (int n = 0; n < 2; ++n) { gv[bj][n] = *(const f32x4*)(g + col0 + bj * HALF + n * 4); bv[bj][n] = *(const f32x4*)(bta + col0 + bj * HALF + n * 4) * alpha; }
#pragma unroll
        for (int ai = 0; ai < 2; ++ai)
#pragma unroll
            for (int m = 0; m < 4; ++m) { const int r = row0 + ai * HALF + m * 16; const float mu = stats[2 * r], rs = stats[2 * r + 1] * alpha; const size_t off = (size_t)r * ldc + col0;
                float s1 = 0.f, s2 = 0.f;
#pragma unroll
                for (int bj = 0; bj < 2; ++bj) { const f32x4 x0 = *(const f32x4*)(X + off + bj * HALF), x1 = *(const f32x4*)(X + off + bj * HALF + 4);
                    const f32x4 y0 = (x0 - mu) * rs * gv[bj][0] + bv[bj][0] + acc[ai][bj][m][0], y1 = (x1 - mu) * rs * gv[bj][1] + bv[bj][1] + acc[ai][bj][m][1];
                    s1 += ((y0[0] + y0[1]) + (y0[2] + y0[3])) + ((y1[0] + y1[1]) + (y1[2] + y1[3]));
                    s2 += ((y0[0] * y0[0] + y0[1] * y0[1]) + (y0[2] * y0[2] + y0[3] * y0[3])) + ((y1[0] * y1[0] + y1[1] * y1[1]) + (y1[2] * y1[2] + y1[3] * y1[3]));
                    *(u32x4*)(Yb + off + bj * HALF) = pack8bf(y0, y1); }
#pragma unroll
                for (int x = 16; x < 64; x <<= 1) { s1 += __builtin_bit_cast(float, __builtin_amdgcn_ds_bpermute((lane ^ x) << 2, __builtin_bit_cast(int, s1))); s2 += __builtin_bit_cast(float, __builtin_amdgcn_ds_bpermute((lane ^ x) << 2, __builtin_bit_cast(int, s2))); }
                if (fq == 0) { typedef float f32x2v __attribute__((ext_vector_type(2))); *(f32x2v*)(rpart + ((size_t)r * 64 + u.pn * 4 + wc) * 2) = (f32x2v){s1, s2}; }
                if (m & 1) asm volatile("" ::: "memory"); }
    }
};
struct EpiUpS {
    static constexpr bool PERM = true, AFTER_DRAIN = false;
    bf16_t* O; int ldc; const float* ucol; const float* ccol; const PG8_LAS float* st;
    __device__ __forceinline__ void operator()(const f32x4 (&acc)[2][2][4][2], const Unit& u, int wr, int wc, int fr, int fq) const {
        typedef float f32x2v __attribute__((ext_vector_type(2)));
        const int rl0 = wr * 64 + fr, row0 = u.pm * BM + rl0, col0 = u.pn * BM + wc * 32 + 8 * fq;
        f32x4 uv[2][2], cv[2][2];
#pragma unroll
        for (int bj = 0; bj < 2; ++bj)
#pragma unroll
            for (int n = 0; n < 2; ++n) { uv[bj][n] = *(const f32x4*)(ucol + col0 + bj * HALF + n * 4); cv[bj][n] = *(const f32x4*)(ccol + col0 + bj * HALF + n * 4); }
#pragma unroll
        for (int ai = 0; ai < 2; ++ai)
#pragma unroll
            for (int m = 0; m < 4; ++m) { bf16_t* rowp = O + (size_t)(row0 + ai * HALF + m * 16) * ldc + col0; const f32x2v sr = *(const PG8_LAS f32x2v*)(st + 2 * (rl0 + ai * HALF + m * 16));
#pragma unroll
                for (int bj = 0; bj < 2; ++bj) { f32x4 v0 = (acc[ai][bj][m][0] - sr.x * uv[bj][0]) * sr.y + cv[bj][0], v1 = (acc[ai][bj][m][1] - sr.x * uv[bj][1]) * sr.y + cv[bj][1];
#pragma unroll
                    for (int e = 0; e < 4; ++e) { const float a = fmaxf(v0[e], 0.f), c = fmaxf(v1[e], 0.f); v0[e] = a * a; v1[e] = c * c; }
                    *(u32x4*)(rowp + bj * HALF) = pack8bf(v0, v1); } }
    }
};
struct EpiDownB {
    static constexpr bool PERM = true, AFTER_DRAIN = false;
    const bf16_t* Y1b; bf16_t* Y2b; const float* stats; const float* g; const float* bta; int ldc; float alpha; int ldy;
    __device__ __forceinline__ void operator()(const f32x4 (&acc)[2][2][4][2], const Unit& u, int wr, int wc, int fr, int fq) const {
        const int row0 = u.pm * BM + wr * 64 + fr, col0 = u.pn * BM + wc * 32 + 8 * fq;
        f32x4 gv[2][2], bv[2][2];
#pragma unroll
        for (int bj = 0; bj < 2; ++bj)
#pragma unroll
            for (int n = 0; n < 2; ++n) { gv[bj][n] = *(const f32x4*)(g + col0 + bj * HALF + n * 4); bv[bj][n] = *(const f32x4*)(bta + col0 + bj * HALF + n * 4) * alpha; }
#pragma unroll
        for (int ai = 0; ai < 2; ++ai)
#pragma unroll
            for (int m = 0; m < 4; ++m) { const int r = row0 + ai * HALF + m * 16; const float mu = stats[2 * r], rs = stats[2 * r + 1] * alpha; const size_t off = (size_t)r * ldc + col0;
#pragma unroll
                for (int bj = 0; bj < 2; ++bj) { f32x4 x0, x1; unpack8bf(*(const u32x4*)(Y1b + off + bj * HALF), x0, x1);
                    const f32x4 y0 = (x0 - mu) * rs * gv[bj][0] + bv[bj][0] + acc[ai][bj][m][0], y1 = (x1 - mu) * rs * gv[bj][1] + bv[bj][1] + acc[ai][bj][m][1];
                    *(u32x4*)(Y2b + (size_t)r * ldy + col0 + bj * HALF) = pack8bf(y0, y1); }
                if (m & 1) asm volatile("" ::: "memory"); }
    }
};

template <class Epi, class Sched, bool ALIGN_EPI = false, bool SP2 = false>
__device__ __forceinline__ void gemm_phase(PG8_LAS unsigned char* lds, const Gemm g, const Sched& S, const Epi& E, const int wv  ) {
    const int lane = mk_lane_id(), wid = wv, tid = wv * 64 + lane, wr = wid >> 2, wc = wid & 3, fr = lane & 15, fq = lane >> 4;
    const int K = g.K, nt = K / BK;
    unsigned voffA[2], voffB[2];
#pragma unroll
    for (int i = 0; i < 2; ++i) { int R, C; stage_rc(tid * 16 + i * 8192, R, C); const int Rb = Epi::PERM ? ((R & ~31) + perm32(R & 31)) : R;
        voffA[i] = (unsigned)(R * K + C) * 2u; voffB[i] = (unsigned)(Rb * K + C) * 2u; }
    const size_t kstep = (size_t)(BK * 2);
    const size_t hstep = (size_t)HALF * K * 2;
    const size_t tstep = 2 * hstep;
    const unsigned ldsw = (unsigned)wid * 1024u;
    const int aoff = lds_byte(wr * 64 + fr, fq * 8), boff = lds_byte(wc * 32 + fr, fq * 8);
#define PG8_SA(b, h) (((b) * 2 + (h)) * HTB)
#define PG8_SB(b, h) ((4 + (b) * 2 + (h)) * HTB)
#define PG8_STAGE(bufoff, gbase, voff) do { _Pragma("unroll") for (int _i = 0; _i < 2; ++_i) \
        __builtin_amdgcn_global_load_lds((const unsigned*)((const char*)(gbase) + (voff)[_i]), (PG8_LAS unsigned*)(lds + (bufoff) + ldsw + _i * 8192), 16, 0, 0); } while (0)
#define PG8_LDA(dst, b, h) do { _Pragma("unroll") for (int m = 0; m < 4; ++m) _Pragma("unroll") for (int k = 0; k < 2; ++k) dst[m][k] = *(const PG8_LAS bf16x8*)(lds + PG8_SA(b, h) + aoff + m * 2048 + k * 1024); } while (0)
#define PG8_LDB(dst, b, h) do { _Pragma("unroll") for (int n = 0; n < 2; ++n) _Pragma("unroll") for (int k = 0; k < 2; ++k) dst[n][k] = *(const PG8_LAS bf16x8*)(lds + PG8_SB(b, h) + boff + n * 2048 + k * 1024); } while (0)
#define PG8_MMA(ai, bj, At, Bt) do { __builtin_amdgcn_s_setprio(1); _Pragma("unroll") for (int m = 0; m < 4; ++m) _Pragma("unroll") for (int n = 0; n < 2; ++n) _Pragma("unroll") for (int k = 0; k < 2; ++k) \
        acc[ai][bj][m][n] = __builtin_amdgcn_mfma_f32_16x16x32_bf16(Bt[n][k], At[m][k], acc[ai][bj][m][n], 0, 0, 0); __builtin_amdgcn_s_setprio(0); } while (0)
#define PG8_WAIT_V(n) asm volatile("s_waitcnt vmcnt(" #n ")" ::: "memory")
#define PG8_WAIT_L(n) asm volatile("s_waitcnt lgkmcnt(" #n ")" ::: "memory")
#define PG8_BAR __builtin_amdgcn_s_barrier()
#define PG8_SCHED __builtin_amdgcn_sched_barrier(0)
    Unit cur, nxt; int ui = 0;
#if defined(PROBE_EPI)
    unsigned long long pe_acc = 0ull;
#endif
    if (!S.next(0, cur)) return;
    f32x4 acc[2][2][4][2];
#pragma unroll
    for (int a = 0; a < 2; ++a)
#pragma unroll
        for (int b = 0; b < 2; ++b)
#pragma unroll
            for (int m = 0; m < 4; ++m)
#pragma unroll
                for (int n = 0; n < 2; ++n) acc[a][b][m][n] = (f32x4){0.f, 0.f, 0.f, 0.f};
    bf16x8 At[4][2], B0[2][2], B1[2][2];
    const char* cA = (const char*)g.A + (((size_t)cur.pm * tstep) << g.ashift); const char* cB = (const char*)g.Bt + (size_t)cur.pn * tstep;
    S.a_ready(cur);
    if constexpr (SP2) {
        PG8_STAGE(PG8_SB(0, 0), cB, voffB); PG8_STAGE(PG8_SB(0, 1), cB + hstep, voffB); PG8_STAGE(PG8_SA(0, 0), cA, voffA); PG8_STAGE(PG8_SA(0, 1), cA + hstep, voffA);
        if (wr == 1) PG8_BAR;
        PG8_WAIT_V(2); PG8_BAR;
        PG8_STAGE(PG8_SB(1, 0), cB + kstep, voffB); PG8_STAGE(PG8_SA(1, 0), cA + kstep, voffA); PG8_STAGE(PG8_SB(1, 1), cB + hstep + kstep, voffB);
        PG8_WAIT_V(6); PG8_BAR;
    } else {
        PG8_STAGE(PG8_SB(0, 0), cB, voffB); PG8_STAGE(PG8_SA(0, 0), cA, voffA); PG8_STAGE(PG8_SB(0, 1), cB + hstep, voffB); PG8_STAGE(PG8_SA(0, 1), cA + hstep, voffA);
        if (wr == 1) PG8_BAR;
        PG8_WAIT_V(4); PG8_BAR;
        PG8_STAGE(PG8_SB(1, 0), cB + kstep, voffB); PG8_STAGE(PG8_SA(1, 0), cA + kstep, voffA); PG8_STAGE(PG8_SB(1, 1), cB + hstep + kstep, voffB);
        PG8_WAIT_V(6); PG8_BAR;
    }
    for (;;) {
        const bool has_next = S.next(ui + 1, nxt);
        const char* nA = has_next ? (const char*)g.A + (((size_t)nxt.pm * tstep) << g.ashift) : cA; const char* nB = has_next ? (const char*)g.Bt + (size_t)nxt.pn * tstep : cB;
        for (int t = 0; t < nt; t += 2) {
            const bool last = (t == nt - 2);
            const char* a1 = cA + (size_t)(t + 1) * kstep;
            const char* a2 = last ? nA : cA + (size_t)(t + 2) * kstep; const char* b2 = last ? nB : cB + (size_t)(t + 2) * kstep;
            const char* a3 = a2 + kstep; const char* b3 = b2 + kstep;
            if (last && has_next) S.a_ready(nxt);
            if constexpr (SP2) {
            PG8_LDB(B0, 0, 0); PG8_LDB(B1, 0, 1); PG8_SCHED; PG8_LDA(At, 0, 0); PG8_STAGE(PG8_SA(1, 1), a1 + hstep, voffA);
            PG8_WAIT_V(8); PG8_WAIT_L(0); PG8_BAR; PG8_MMA(0, 0, At, B0); PG8_MMA(0, 1, At, B1); PG8_BAR; PG8_SCHED;
            PG8_LDA(At, 0, 1); PG8_STAGE(PG8_SB(0, 0), b2, voffB); PG8_STAGE(PG8_SB(0, 1), b2 + hstep, voffB); PG8_STAGE(PG8_SA(0, 0), a2, voffA);
            PG8_WAIT_V(8); PG8_WAIT_L(0); PG8_BAR; PG8_MMA(1, 0, At, B0); PG8_MMA(1, 1, At, B1); PG8_BAR; PG8_SCHED;
            PG8_LDB(B0, 1, 0); PG8_LDB(B1, 1, 1); PG8_SCHED; PG8_LDA(At, 1, 0); PG8_STAGE(PG8_SA(0, 1), a2 + hstep, voffA);
            PG8_WAIT_V(8); PG8_WAIT_L(0); PG8_BAR; PG8_MMA(0, 0, At, B0); PG8_MMA(0, 1, At, B1); PG8_BAR; PG8_SCHED;
            PG8_LDA(At, 1, 1); PG8_STAGE(PG8_SB(1, 0), b3, voffB); PG8_STAGE(PG8_SB(1, 1), b3 + hstep, voffB); PG8_STAGE(PG8_SA(1, 0), a3, voffA);
            PG8_WAIT_V(8); PG8_WAIT_L(0); PG8_BAR; PG8_MMA(1, 0, At, B0); PG8_MMA(1, 1, At, B1); PG8_BAR; PG8_SCHED;
            } else {
            PG8_LDB(B0, 0, 0); PG8_SCHED; PG8_LDA(At, 0, 0); PG8_STAGE(PG8_SA(1, 1), a1 + hstep, voffA);
            PG8_WAIT_L(8); PG8_BAR; PG8_WAIT_L(0); PG8_MMA(0, 0, At, B0); PG8_BAR; PG8_SCHED;
            PG8_LDB(B1, 0, 1); PG8_STAGE(PG8_SB(0, 0), b2, voffB);
            PG8_BAR; PG8_WAIT_L(0); PG8_MMA(0, 1, At, B1); PG8_BAR;
            PG8_LDA(At, 0, 1); PG8_STAGE(PG8_SA(0, 0), a2, voffA);
            PG8_BAR; PG8_WAIT_L(0); PG8_MMA(1, 0, At, B0); PG8_BAR; PG8_SCHED;
            PG8_STAGE(PG8_SB(0, 1), b2 + hstep, voffB);
            PG8_WAIT_V(6); PG8_BAR; PG8_MMA(1, 1, At, B1); PG8_BAR;
            PG8_LDB(B0, 1, 0); PG8_SCHED; PG8_LDA(At, 1, 0); PG8_STAGE(PG8_SA(0, 1), a2 + hstep, voffA);
            PG8_WAIT_L(8); PG8_BAR; PG8_WAIT_L(0); PG8_MMA(0, 0, At, B0); PG8_BAR; PG8_SCHED;
            PG8_LDB(B1, 1, 1); PG8_STAGE(PG8_SB(1, 0), b3, voffB);
            PG8_BAR; PG8_WAIT_L(0); PG8_MMA(0, 1, At, B1); PG8_BAR;
            PG8_LDA(At, 1, 1); PG8_STAGE(PG8_SA(1, 0), a3, voffA);
            PG8_BAR; PG8_WAIT_L(0); PG8_MMA(1, 0, At, B0); PG8_BAR; PG8_SCHED;
            PG8_STAGE(PG8_SB(1, 1), b3 + hstep, voffB);
            PG8_WAIT_V(6); PG8_BAR; PG8_MMA(1, 1, At, B1); PG8_BAR;
            }
        }
        if constexpr (ALIGN_EPI) { if (wr == 0) PG8_BAR; }
#if defined(PROBE_EPI)
        { const unsigned long long pe0_ = __builtin_amdgcn_s_memrealtime(); if constexpr (!Epi::AFTER_DRAIN) { E(acc, cur, wr, wc, fr, fq); S.done(cur); } pe_acc += __builtin_amdgcn_s_memrealtime() - pe0_; }
#else
        if constexpr (!Epi::AFTER_DRAIN) { E(acc, cur, wr, wc, fr, fq); S.done(cur); }
#endif
        if (!has_next) break;
#pragma unroll
        for (int a = 0; a < 2; ++a)
#pragma unroll
            for (int b = 0; b < 2; ++b)
#pragma unroll
                for (int m = 0; m < 4; ++m)
#pragma unroll
                    for (int n = 0; n < 2; ++n) acc[a][b][m][n] = (f32x4){0.f, 0.f, 0.f, 0.f};
        cur = nxt; cA = nA; cB = nB; ++ui;
        if constexpr (ALIGN_EPI) { if (wr == 1) PG8_BAR; }
    }
    PG8_WAIT_V(0);
    if constexpr (!ALIGN_EPI) { if (wr == 0) PG8_BAR; }
    PG8_BAR;
    if constexpr (Epi::AFTER_DRAIN) { E.fused(acc, cur, wr, wc, fr, fq, lds, wid, lane); S.done(cur); }
#if defined(PROBE_EPI)
    if (blockIdx.x == 0 && tid == 0) *(volatile PG8_LAS unsigned long long*)(lds + 131072 + 1024 + 8 * 16) = pe_acc;
#endif
#undef PG8_SA
#undef PG8_SB
#undef PG8_STAGE
#undef PG8_LDA
#undef PG8_LDB
#undef PG8_MMA
#undef PG8_WAIT_V
#undef PG8_WAIT_L
#undef PG8_BAR
#undef PG8_SCHED
}
}

#ifndef PG8_SP2
#define PG8_SP2 true
#endif
#ifndef PG8_ALIGN
#define PG8_ALIGN true
#endif
#include <hip/hip_bf16.h>
namespace att {
__device__ __forceinline__ int fresh_lane() { int l; asm volatile("v_mbcnt_lo_u32_b32 %0, -1, 0\n\tv_mbcnt_hi_u32_b32 %0, -1, %0" : "=v"(l)); return l; }
__device__ __forceinline__ int fresh_tid(int wv) { return wv * 64 + fresh_lane(); }
constexpr int D = 128;
constexpr float THR = 8.f;
constexpr bool WSKIP = false;
constexpr float SCALE = 0.08838834764831845f;
constexpr float RSCALE = 11.313708498984761f;
constexpr int NW = 8, QBLK = 32, KVBLK = 64, QB = NW * QBLK;
constexpr int SHM_V = KVBLK * D * 2, SHM_K = KVBLK * D * 2;
constexpr int LDS_BIAS = 2 * SHM_V + 2 * SHM_K + NW * 64 * 4;
constexpr int LDS_OST = LDS_BIAS + 2 * 64 * 4;
constexpr int LDS_BYTES = LDS_OST + NW * 4096;

using bf16 = __hip_bfloat16;
typedef short bf16x8 __attribute__((ext_vector_type(8)));
typedef short s16x4 __attribute__((ext_vector_type(4)));
typedef float f32x16 __attribute__((ext_vector_type(16)));
typedef float f32x4 __attribute__((ext_vector_type(4)));
typedef unsigned u32x4 __attribute__((ext_vector_type(4)));
template <class A, class Bt> struct same_t { static constexpr bool v = false; };
template <class A> struct same_t<A, A> { static constexpr bool v = true; };

#define KSWZ(row, colB) ((row) * 256 + ((colB) ^ (((row) & 7) << 4)))
#define SBAR() __builtin_amdgcn_sched_barrier(0)
__device__ __forceinline__ int v_st(int k, int c) { const int kk = (k & ~0xC) | ((k & 4) << 1) | ((k & 8) >> 1); return ((kk >> 3) * 4 + (c >> 5)) * 512 + ((kk & 7) * 32 + (c & 31)) * 2; }
__device__ __forceinline__ int v_rd_base(int lane) { return ((lane & 3) << 3) | (((lane >> 2) & 3) << 6) | (((lane >> 4) & 1) << 5) | (((lane >> 5) & 1) << 8); }
constexpr int v_rd_off(int d0, int ks, int half) { return d0 * 512 + ks * 4096 + half * 2048; }
__device__ __forceinline__ int crow(int r, int hi) { return (r & 3) + 8 * (r >> 2) + 4 * hi; }
__device__ __forceinline__ unsigned cvtpk(float lo, float hi) {
    unsigned r; asm volatile("v_cvt_pk_bf16_f32 %0, %1, %2" : "=v"(r) : "v"(lo), "v"(hi)); return r;
}
__device__ __forceinline__ bf16x8 pack8(f32x4 a, f32x4 b) {
    u32x4 w = {cvtpk(a[0], a[1]), cvtpk(a[2], a[3]), cvtpk(b[0], b[1]), cvtpk(b[2], b[3])};
    return *reinterpret_cast<bf16x8*>(&w);
}
template <class T> __device__ __forceinline__ bf16x8 load8(const T* p) {
    if constexpr (same_t<T, float>::v) { return pack8(*(const f32x4*)p, *(const f32x4*)(p + 4)); }
    else { return *reinterpret_cast<const bf16x8*>(p); }
}
__device__ __forceinline__ void mask_tile(f32x16& p0, f32x16& p1, int dq, unsigned W) {
    const float NEG = -__builtin_inff();
#pragma unroll
    for (int r = 0; r < 16; ++r) {
        const int c = (r & 3) + 8 * (r >> 2);
        if ((unsigned)(dq - c) >= W) p0[r] = NEG;
        if ((unsigned)(dq - c - 32) >= W) p1[r] = NEG;
    }
}
__device__ __forceinline__ void partialSM(f32x16& p0, f32x16& p1, float& m_reg, float& mn, float& alpha) {
    float pmax = p0[0]; for (int r = 1; r < 16; ++r) pmax = fmaxf(pmax, p0[r]); for (int r = 0; r < 16; ++r) pmax = fmaxf(pmax, p1[r]);
    { auto rr = __builtin_amdgcn_permlane32_swap(__float_as_uint(pmax), __float_as_uint(pmax), false, false);
      pmax = fmaxf(__uint_as_float(rr[0]), __uint_as_float(rr[1])); }
    constexpr float C2 = 1.4426950408889634f * SCALE;
    if (__builtin_expect(__all((pmax - m_reg) * SCALE <= THR), 1)) { mn = m_reg; alpha = 1.f; }
    else { mn = fmaxf(m_reg, pmax); alpha = __builtin_amdgcn_exp2f((m_reg - mn) * C2); m_reg = mn; }
    const float mnL = -mn * C2;
    for (int r = 0; r < 16; ++r) p0[r] = fmaf(p0[r], C2, mnL); for (int r = 0; r < 16; ++r) p1[r] = fmaf(p1[r], C2, mnL);
    for (int r = 0; r < 16; ++r) p0[r] = __builtin_amdgcn_exp2f(p0[r]);
}
__device__ __forceinline__ void finishSM(f32x16& p0, f32x16& p1, float alpha, float& l_reg, bf16x8& pa0, bf16x8& pa1, bf16x8& pa2, bf16x8& pa3) {
    for (int r = 0; r < 16; ++r) p1[r] = __builtin_amdgcn_exp2f(p1[r]);
    float ps = 0; for (int r = 0; r < 16; ++r) ps += p0[r]; for (int r = 0; r < 16; ++r) ps += p1[r];
    { auto rr = __builtin_amdgcn_permlane32_swap(__float_as_uint(ps), __float_as_uint(ps), false, false);
      ps = __uint_as_float(rr[0]) + __uint_as_float(rr[1]); }
    l_reg = l_reg * alpha + ps;
#define PK4(P, B_, OUT) do { unsigned a0 = cvtpk(P[B_+0], P[B_+1]), a1 = cvtpk(P[B_+2], P[B_+3]);                          \
        unsigned b0 = cvtpk(P[B_+4], P[B_+5]), b1 = cvtpk(P[B_+6], P[B_+7]);                                             \
        auto r0 = __builtin_amdgcn_permlane32_swap(a0, b0, false, false); auto r1 = __builtin_amdgcn_permlane32_swap(a1, b1, false, false); \
        u32x4 w = {r0[0], r1[0], r0[1], r1[1]}; OUT = *reinterpret_cast<bf16x8*>(&w); } while (0)
    PK4(p0, 0, pa0); PK4(p0, 8, pa1); PK4(p1, 0, pa2); PK4(p1, 8, pa3);
#undef PK4
}
template <int KB, bool SK>
__device__ __forceinline__ void qkt(f32x16& p0, f32x16& p1, const char* K_lds, int r32, int hi, const bf16x8* qr, bool act) {
    if (SK && !act) { const float NEG = -__builtin_inff();
#pragma unroll
        for (int r = 0; r < 16; ++r) { p0[r] = NEG; p1[r] = NEG; } return; }
    p0 = f32x16{}; p1 = f32x16{};
    const char* kb[4];
#pragma unroll
    for (int dd = 0; dd < 4; ++dd) kb[dd] = K_lds + KB * SHM_K + KSWZ(r32, (dd * 16 + hi * 8) * 2);
#pragma unroll
    for (int d0 = 0; d0 < 8; ++d0) { const char* a = kb[d0 & 3] + (d0 >> 2) * 128;
        bf16x8 b0 = *reinterpret_cast<const bf16x8*>(a);
        bf16x8 b1 = *reinterpret_cast<const bf16x8*>(a + 32 * 256);
        p0 = __builtin_amdgcn_mfma_f32_32x32x16_bf16(b0, qr[d0], p0, 0, 0, 0);
        p1 = __builtin_amdgcn_mfma_f32_32x32x16_bf16(b1, qr[d0], p1, 0, 0, 0); }
}
template <int VB, bool SK>
__device__ __forceinline__ void pv_tile(f32x16* o, int vb0, bf16x8 pa0, bf16x8 pa1, bf16x8 pa2, bf16x8 pa3, bool act) {
    if (SK && !act) return;
#define TRRD(dst, off) asm volatile("ds_read_b64_tr_b16 %0, %1 offset:%2" : "=&v"(dst) : "v"(vb0), "i"(off) : "memory")
#define PV_D0(d0) do { s16x4 l0, l1, l2, l3, h0, h1, h2, h3; constexpr int b_ = VB * SHM_V + v_rd_off(d0, 0, 0);     \
        TRRD(l0, b_); TRRD(h0, b_ + 2048); TRRD(l1, b_ + 4096); TRRD(h1, b_ + 6144); TRRD(l2, b_ + 8192); TRRD(h2, b_ + 10240); TRRD(l3, b_ + 12288); TRRD(h3, b_ + 14336); \
        asm volatile("s_waitcnt lgkmcnt(0)" ::: "memory"); SBAR();                 \
        o[d0] = __builtin_amdgcn_mfma_f32_32x32x16_bf16(pa0, (bf16x8){l0[0], l0[1], l0[2], l0[3], h0[0], h0[1], h0[2], h0[3]}, o[d0], 0, 0, 0);   \
        o[d0] = __builtin_amdgcn_mfma_f32_32x32x16_bf16(pa1, (bf16x8){l1[0], l1[1], l1[2], l1[3], h1[0], h1[1], h1[2], h1[3]}, o[d0], 0, 0, 0);   \
        o[d0] = __builtin_amdgcn_mfma_f32_32x32x16_bf16(pa2, (bf16x8){l2[0], l2[1], l2[2], l2[3], h2[0], h2[1], h2[2], h2[3]}, o[d0], 0, 0, 0);   \
        o[d0] = __builtin_amdgcn_mfma_f32_32x32x16_bf16(pa3, (bf16x8){l3[0], l3[1], l3[2], l3[3], h3[0], h3[1], h3[2], h3[3]}, o[d0], 0, 0, 0); } while (0)
    PV_D0(0); PV_D0(1); PV_D0(2); PV_D0(3);
#undef PV_D0
#undef TRRD
}


template <int NB>
__device__ __forceinline__ void o_rows_store(const f32x16* o, const float (&rl)[16], char* stg, bf16* Ow, const int ldo, const int col0, const int r32, const int hi, const int lane) {
    constexpr int PITCH = NB * 64, CPR = PITCH / 16;
#pragma unroll
    for (int r = 0; r < 16; ++r) { char* rp = stg + crow(r, hi) * PITCH + r32 * 2;
#pragma unroll
        for (int b = 0; b < NB; ++b) { const float v = o[b][r] * rl[r]; *(unsigned short*)(rp + b * 64) = (unsigned short)cvtpk(v, v); } }
    asm volatile("s_waitcnt lgkmcnt(0)" ::: "memory");
#pragma unroll
    for (int k = 0; k < 2 * NB; ++k) { const int c = lane + 64 * k, row = c / CPR, ch = c % CPR;
        const u32x4 w = *(const u32x4*)(stg + c * 16);
        *(u32x4*)(Ow + (size_t)row * ldo + col0 + ch * 8) = w; }
}
template <class TIn, class TOut> struct BlockRef { unsigned qoff, koff, voff, ooff, coff; int P0; int ldo; int boff; int jlo; };
template <class TIn, class TOut> struct Bases { const TIn* qkv; TOut* o; const float* c; };
template <class TIn> struct Seam {
    bf16x8 qr[8];
    bf16x8 st_v0, st_v1, st_k0, st_k1; f32x4 sf0, sf1, sf2, sf3;
    f32x4 tq[16];
    float st_b;
};
__device__ __forceinline__ int swa_jlo(int P0, int W) { const int lowk = P0 - W + 1; return lowk > 0 ? lowk / KVBLK : 0; }
#define ROW(p, k0, rr) ((p) + (size_t)((k0) + (rr)) * D + sc)
#define VMW() asm volatile("s_waitcnt vmcnt(0)" ::: "memory")
#define VMWN(n) asm volatile("s_waitcnt vmcnt(%0)" :: "i"(n) : "memory")
#define SLOAD_H(Kp, Vp, Cp, k0) do { S.st_v0 = load8<TIn>(ROW(Vp, k0, sr)); S.st_v1 = load8<TIn>(ROW(Vp, k0, 32 + sr));              \
                         S.st_k0 = load8<TIn>(ROW(Kp, k0, sr)); S.st_k1 = load8<TIn>(ROW(Kp, k0, 32 + sr));                       \
                         if constexpr (MODE == 1) { if (tid < 64) S.st_b = (Cp)[(k0) + tid]; } } while (0)
#define SWRITE_HK(bf, cref) do { *(bf16x8*)(K_lds + (bf) * SHM_K + kws) = S.st_k0; *(bf16x8*)(K_lds + (bf) * SHM_K + kws + 32 * 256) = S.st_k1; \
                         if constexpr (MODE == 1) { if (tid < 64) bias_l[(bf) * 64 + tid] = ((cref) - S.st_b) * RSCALE; } } while (0)
#define SWRITE_HV(bf) do { *(bf16x8*)(V_lds + (bf) * SHM_V + vst0) = S.st_v0; *(bf16x8*)(V_lds + (bf) * SHM_V + vst1) = S.st_v1; } while (0)
#define SWRITE_H(bf, cref) do { SWRITE_HV(bf); SWRITE_HK(bf, cref); } while (0)
#define BIASADD(P0_, P1_, kb) do { if constexpr (MODE == 1) { const float* bp_ = bias_l + (kb) * 64 + 4 * hi;                    \
        _Pragma("unroll") for (int g_ = 0; g_ < 4; ++g_) { const f32x4 b0_ = *(const f32x4*)(bp_ + 8 * g_), b1_ = *(const f32x4*)(bp_ + 32 + 8 * g_); \
            _Pragma("unroll") for (int e_ = 0; e_ < 4; ++e_) { P0_[4 * g_ + e_] += b0_[e_]; P1_[4 * g_ + e_] += b1_[e_]; } } } } while (0)
#define PADMASK(P0_, P1_) do { const float NEG_ = -__builtin_inff(); _Pragma("unroll") for (int r_ = 0; r_ < 16; ++r_) { if (r_ >= 8) P0_[r_] = NEG_; P1_[r_] = NEG_; } } while (0)
#define SLOAD_F(p, k0) do { S.sf0 = *(const f32x4*)ROW(p, k0, sr); S.sf1 = *(const f32x4*)(ROW(p, k0, sr) + 4);                \
                            S.sf2 = *(const f32x4*)ROW(p, k0, 32 + sr); S.sf3 = *(const f32x4*)(ROW(p, k0, 32 + sr) + 4); } while (0)
#define SWRITE_KF(bf) do { *(bf16x8*)(K_lds + (bf) * SHM_K + kws) = pack8(S.sf0, S.sf1); *(bf16x8*)(K_lds + (bf) * SHM_K + kws + 32 * 256) = pack8(S.sf2, S.sf3); } while (0)
#define SWRITE_VF(bf) do { *(bf16x8*)(V_lds + (bf) * SHM_V + vst0) = pack8(S.sf0, S.sf1); *(bf16x8*)(V_lds + (bf) * SHM_V + vst1) = pack8(S.sf2, S.sf3); } while (0)
template <class TIn, class TOut, int MODE  , class Ref>
__device__ __forceinline__ void causal_swa_prime(const Ref& cur, const Bases<TIn, TOut>& B, int W, char* lds, Seam<TIn>& S, const int wv) {
    constexpr bool F32 = same_t<TIn, float>::v;
    const int tid = fresh_tid(wv), wid = wv, lane = tid & 63, r32 = lane & 31, hi = lane >> 5;
    const int sr = tid >> 4, sc = (tid & 15) * 8, kws = KSWZ(sr, sc * 2); char* K_lds = lds + 2 * SHM_V; float* bias_l = (float*)(lds + LDS_BIAS);
    float cref_cur = 0.f; if constexpr (MODE == 1) cref_cur = __uint_as_float(__builtin_amdgcn_readfirstlane(__float_as_uint(((const float*)(lds + cur.boff()))[(cur.P0() - 64) >> 7] + (B.c + cur.coff())[cur.P0()])));
    const int kb0 = cur.jlo() * KVBLK;
    if constexpr (MODE == 1) { if (kb0 >= 64) cref_cur -= __uint_as_float(__builtin_amdgcn_readfirstlane(__float_as_uint(((const float*)(lds + cur.boff()))[(kb0 - 64) >> 7]))); }
    for (int d0 = 0; d0 < 8; ++d0) S.qr[d0] = load8<TIn>(B.qkv + cur.qoff() + (size_t)(wid * QBLK + r32) * D + d0 * 16 + hi * 8);
    if constexpr (F32) { SLOAD_F((const float*)(B.qkv + cur.koff()), kb0); VMW(); SWRITE_KF(0); SBAR(); SLOAD_F((const float*)(B.qkv + cur.voff()), kb0); }
    else { SLOAD_H(B.qkv + cur.koff(), B.qkv + cur.voff(), B.c + cur.coff(), kb0); VMW(); SWRITE_HK(0, cref_cur); }
    __syncthreads();
}
template <class TIn, class TOut, int MODE, class Ref, class NxtFn>
__device__ __forceinline__ void causal_swa_block(const Ref& cur, NxtFn& nxtfn, const Bases<TIn, TOut>& B, int skv, int W, char* lds, Seam<TIn>& S, const int wv) {
    constexpr bool F32 = same_t<TIn, float>::v;
    const int tid = fresh_tid(wv), wid = wv, lane = tid & 63, r32 = lane & 31, hi = lane >> 5;
    const int j_lo = cur.jlo();
    int j_hi = (cur.P0() + QB - 1) / KVBLK + 1; if (j_hi > skv / KVBLK) j_hi = skv / KVBLK;
    const int NT = j_hi - j_lo;
    const int qlo_r = cur.P0() + wid * QBLK, qlo = (MODE == 0) ? (qlo_r | 63) : qlo_r, qm = (MODE == 0) ? (qlo - 4 * hi) : (qlo_r + r32 - 4 * hi);
    char* V_lds = lds; char* K_lds = lds + 2 * SHM_V; float* bias_l = (float*)(lds + LDS_BIAS);
    const float* base_l = (const float*)(lds + cur.boff());
    float cref_cur = 0.f; if constexpr (MODE == 1) { cref_cur = __uint_as_float(__builtin_amdgcn_readfirstlane(__float_as_uint(base_l[(cur.P0() - 64) >> 7] + (B.c + cur.coff())[cur.P0()]))); }
    const float* Ch = B.c + cur.coff();
#define CADJ(k0) ((MODE == 1) ? (cref_cur - (((k0) >= 64) ? __uint_as_float(__builtin_amdgcn_readfirstlane(__float_as_uint(base_l[((k0) - 64) >> 7]))) : 0.f)) : 0.f)
    float* ws = (float*)(lds + 2 * SHM_V + 2 * SHM_K) + wid * 64; float* li_l = ws, * al_l = ws + 32;
    float m_reg = -1e30f, l_reg = 0; f32x16 o[4] = {};
    const int sr = tid >> 4, sc = (tid & 15) * 8, vst0 = v_st(sr, sc), vst1 = v_st(32 + sr, sc), kws = KSWZ(sr, sc * 2);
    const int vb0 = (int)(uintptr_t)V_lds + v_rd_base(lane);
    const TIn* Kh = B.qkv + cur.koff(); const TIn* Vh = B.qkv + cur.voff();
#define RESC(a) do { if (__any((a) < 1.f)) { if (hi == 0) al_l[r32] = (a); asm volatile("s_waitcnt lgkmcnt(0)" ::: "memory");              \
                     for (int d_ = 0; d_ < 4; ++d_) for (int r = 0; r < 16; ++r) o[d_][r] *= al_l[crow(r, hi)]; } } while (0)
#define KBASE(t) ((j_lo + (t)) * KVBLK)
#define ACT(t) (KBASE(t) <= qlo + QBLK - 1 && KBASE(t) + KVBLK - 1 >= qlo - W + 1)
#define MASKT(P0_, P1_, t) do { const int kb_ = KBASE(t); if ((!SK || ACT(t)) && (kb_ + KVBLK - 1 > qlo || kb_ <= qlo + QBLK - 1 - W)) mask_tile(P0_, P1_, qm - kb_, (unsigned)W); } while (0)
    constexpr int NQL = F32 ? 16 : 8;
    constexpr bool SK = WSKIP && !F32;
#define SEAM_K0() do { VMWN(NQL); if constexpr (F32) { SWRITE_KF(0); SBAR(); SLOAD_F((const float*)(B.qkv + nxt.voff()), kbn); } else { SWRITE_HK(0, cref_nxt); } SBAR(); } while (0)
    f32x16 pA0, pA1, pB0, pB1; float mnA, mnB, alA, alB; bf16x8 pa0, pa1, pa2, pa3;
    if constexpr (F32) { VMW(); SWRITE_VF(0); SBAR(); } else { SWRITE_HV(0); SBAR(); }
    if (NT > 1) { if constexpr (F32) SLOAD_F((const float*)Kh, KBASE(1)); else SLOAD_H(Kh, Vh, Ch, KBASE(1)); }
    SBAR(); qkt<0, SK>(pA0, pA1, K_lds, r32, hi, S.qr, ACT(0));
    if constexpr (F32) { if (NT > 1) { VMW(); SWRITE_KF(1); SBAR(); SLOAD_F((const float*)Vh, KBASE(1)); } }
    BIASADD(pA0, pA1, 0); if (j_lo == 0) PADMASK(pA0, pA1); MASKT(pA0, pA1, 0); partialSM(pA0, pA1, m_reg, mnA, alA);
    if (NT > 1) { VMW(); if constexpr (F32) { SWRITE_VF(1); SBAR(); if (NT > 2) SLOAD_F((const float*)Kh, KBASE(2)); } else SWRITE_H(1, CADJ(KBASE(1))); }
    __syncthreads();
#define HALF_STEP(PX0, PX1, mnX, alX, PY0, PY1, alY, t, KB, VB, SB) do {                                                      \
        SBAR(); qkt<KB, SK>(PX0, PX1, K_lds, r32, hi, S.qr, ACT(t));                                             \
        finishSM(PY0, PY1, alY, l_reg, pa0, pa1, pa2, pa3); SBAR();                                                           \
        if ((t) + 1 < NT) { if constexpr (F32) { VMW(); SWRITE_KF(SB); SBAR(); SLOAD_F((const float*)Vh, KBASE((t) + 1)); }  \
                            else { SLOAD_H(Kh, Vh, Ch, KBASE((t) + 1)); } SBAR(); }                                               \
        pv_tile<VB, SK>(o, vb0, pa0, pa1, pa2, pa3, ACT((t) - 1)); BIASADD(PX0, PX1, KB); MASKT(PX0, PX1, (t)); partialSM(PX0, PX1, m_reg, mnX, alX);                                        \
        __syncthreads();                                                                                                      \
        if ((t) + 1 < NT) { VMW(); if constexpr (F32) { SWRITE_VF(SB); SBAR(); if ((t) + 2 < NT) SLOAD_F((const float*)Kh, KBASE((t) + 2)); } \
                            else { SWRITE_H(SB, CADJ(KBASE((t) + 1))); } }                                                                          \
        RESC(alX); __syncthreads(); } while (0)
    for (int t = 1; t + 1 < NT; t += 2) {
        nxtfn.early(t, NT);
        HALF_STEP(pB0, pB1, mnB, alB, pA0, pA1, alA, t, 1, 0, 0);
        HALF_STEP(pA0, pA1, mnA, alA, pB0, pB1, alB, t + 1, 0, 1, 1);
    }
    const Ref nxt = nxtfn();
    const int kbn = nxt.jlo() * KVBLK;
    float cref_nxt = 0.f; if constexpr (MODE == 1) { const float* bn_ = (const float*)(lds + nxt.boff());
        cref_nxt = __uint_as_float(__builtin_amdgcn_readfirstlane(__float_as_uint(bn_[(nxt.P0() - 64) >> 7] + (B.c + nxt.coff())[nxt.P0()] - ((kbn >= 64) ? bn_[(kbn - 64) >> 7] : 0.f)))); }
    const bool even = (NT & 1) == 0;
    if (even) { SBAR(); qkt<1, SK>(pB0, pB1, K_lds, r32, hi, S.qr, ACT(NT - 1)); SBAR(); }
#define QROW(e) (B.qkv + nxt.qoff() + (size_t)(wid * QBLK + r32) * D + ((e) >> 1) * 16 + hi * 8 + ((e) & 1) * 4)
    if constexpr (F32) { SLOAD_F((const float*)(B.qkv + nxt.koff()), kbn); SBAR();
#pragma unroll
        for (int e = 0; e < 8; ++e) S.tq[e] = *(const f32x4*)QROW(e); }
    else { SLOAD_H(B.qkv + nxt.koff(), B.qkv + nxt.voff(), B.c + nxt.coff(), kbn); SBAR();
#pragma unroll
        for (int d0 = 0; d0 < 8; ++d0) S.qr[d0] = load8<TIn>(B.qkv + nxt.qoff() + (size_t)(wid * QBLK + r32) * D + d0 * 16 + hi * 8); }
    SBAR();
    finishSM(pA0, pA1, alA, l_reg, pa0, pa1, pa2, pa3); SBAR();
    if constexpr (F32) {
#pragma unroll
        for (int e = 8; e < 16; ++e) S.tq[e] = *(const f32x4*)QROW(e); SBAR(); }
#undef QROW
    pv_tile<0, SK>(o, vb0, pa0, pa1, pa2, pa3, ACT(even ? NT - 2 : NT - 1));
    if (even) { BIASADD(pB0, pB1, 1); MASKT(pB0, pB1, NT - 1); partialSM(pB0, pB1, m_reg, mnB, alB); __syncthreads(); RESC(alB);
        finishSM(pB0, pB1, alB, l_reg, pa0, pa1, pa2, pa3); SBAR(); pv_tile<1, SK>(o, vb0, pa0, pa1, pa2, pa3, ACT(NT - 1)); }
    SBAR(); SEAM_K0();
    if (hi == 0) li_l[r32] = l_reg; asm volatile("s_waitcnt lgkmcnt(0)" ::: "memory");
    float rli[16];
#pragma unroll
    for (int r = 0; r < 16; ++r) rli[r] = __builtin_amdgcn_rcpf(li_l[crow(r, hi)]);
    TOut* Ow = B.o + cur.ooff() + (size_t)(wid * QBLK) * cur.ldo(); const int ldo = cur.ldo();
    if constexpr (same_t<TOut, float>::v) {
#pragma unroll
        for (int r = 0; r < 16; ++r) { const int orow = crow(r, hi);
#pragma unroll
            for (int d0 = 0; d0 < 4; ++d0) Ow[(size_t)orow * ldo + d0 * 32 + r32] = o[d0][r] * rli[r]; }
    } else {
        char* stg = lds + LDS_OST + wid * 4096;
        o_rows_store<2>(o, rli, stg, (bf16*)Ow, ldo, 0, r32, hi, lane);
        o_rows_store<2>(o + 2, rli, stg, (bf16*)Ow, ldo, 64, r32, hi, lane);
    }
    if constexpr (F32) {
#pragma unroll
        for (int d0 = 0; d0 < 8; ++d0) S.qr[d0] = pack8(S.tq[2 * d0], S.tq[2 * d0 + 1]); }
    __syncthreads();
#undef RESC
#undef CADJ
#undef KBASE
#undef ACT
#undef MASKT
#undef SEAM_K0
#undef HALF_STEP
}
#undef ROW
#undef VMW
#undef VMWN
#undef SLOAD_H
#undef SWRITE_HK
#undef SWRITE_HV
#undef SWRITE_H
#undef SLOAD_F
#undef SWRITE_KF
#undef SWRITE_VF
#undef BIASADD
#undef PADMASK


__device__ __forceinline__ void pv256(f32x16* o, int vb0, bf16x8 pa0, bf16x8 pa1, bf16x8 pa2, bf16x8 pa3) {
#define TRRD(dst, off) asm volatile("ds_read_b64_tr_b16 %0, %1 offset:%2" : "=&v"(dst) : "v"(vb0), "i"(off) : "memory")
#define RD8(S, g) do { constexpr int b_ = ((g) >> 2) * SHM_V + v_rd_off((g) & 3, 0, 0);                                                                   \
        TRRD(S##l0, b_); TRRD(S##h0, b_ + 2048); TRRD(S##l1, b_ + 4096); TRRD(S##h1, b_ + 6144); TRRD(S##l2, b_ + 8192); TRRD(S##h2, b_ + 10240); TRRD(S##l3, b_ + 12288); TRRD(S##h3, b_ + 14336); } while (0)
#define MM4(S, g) do {                                                                                                                                     \
        o[g] = __builtin_amdgcn_mfma_f32_32x32x16_bf16(pa0, (bf16x8){S##l0[0], S##l0[1], S##l0[2], S##l0[3], S##h0[0], S##h0[1], S##h0[2], S##h0[3]}, o[g], 0, 0, 0); \
        o[g] = __builtin_amdgcn_mfma_f32_32x32x16_bf16(pa1, (bf16x8){S##l1[0], S##l1[1], S##l1[2], S##l1[3], S##h1[0], S##h1[1], S##h1[2], S##h1[3]}, o[g], 0, 0, 0); \
        o[g] = __builtin_amdgcn_mfma_f32_32x32x16_bf16(pa2, (bf16x8){S##l2[0], S##l2[1], S##l2[2], S##l2[3], S##h2[0], S##h2[1], S##h2[2], S##h2[3]}, o[g], 0, 0, 0); \
        o[g] = __builtin_amdgcn_mfma_f32_32x32x16_bf16(pa3, (bf16x8){S##l3[0], S##l3[1], S##l3[2], S##l3[3], S##h3[0], S##h3[1], S##h3[2], S##h3[3]}, o[g], 0, 0, 0); } while (0)
#define LW() do { asm volatile("s_waitcnt lgkmcnt(0)" ::: "memory"); SBAR(); } while (0)
    s16x4 Al0, Al1, Al2, Al3, Ah0, Ah1, Ah2, Ah3, Bl0, Bl1, Bl2, Bl3, Bh0, Bh1, Bh2, Bh3;
    RD8(A, 0);
    LW(); RD8(B, 1); SBAR(); MM4(A, 0); SBAR();
    LW(); RD8(A, 2); SBAR(); MM4(B, 1); SBAR();
    LW(); RD8(B, 3); SBAR(); MM4(A, 2); SBAR();
    LW(); RD8(A, 4); SBAR(); MM4(B, 3); SBAR();
    LW(); RD8(B, 5); SBAR(); MM4(A, 4); SBAR();
    LW(); RD8(A, 6); SBAR(); MM4(B, 5); SBAR();
    LW(); RD8(B, 7); SBAR(); MM4(A, 6); SBAR();
    LW(); MM4(B, 7);
#undef TRRD
#undef RD8
#undef MM4
#undef LW
}

__device__ __forceinline__ void qk64(f32x16& p0, f32x16& p1, const char* K_lds, const char* Q_w, int r32, int hi) {
    p0 = f32x16{}; p1 = f32x16{};
    int ka[4], qa[4];
#pragma unroll
    for (int dd = 0; dd < 4; ++dd) { const int off = KSWZ(r32, (dd * 16 + hi * 8) * 2); ka[dd] = (int)(uintptr_t)K_lds + off; qa[dd] = (int)(uintptr_t)Q_w + off; }
#define LDR(dst, addr, off) asm volatile("ds_read_b128 %0, %1 offset:%2" : "=&v"(dst) : "v"(addr), "i"(off) : "memory")
#define RDS(S, d0) do { LDR(S##q, qa[(d0) & 3], ((d0) >> 2) * 128); LDR(S##a, ka[(d0) & 3], ((d0) >> 2) * 128); LDR(S##b, ka[(d0) & 3], ((d0) >> 2) * 128 + 32 * 256); } while (0)
#define MMS(S) do { p0 = __builtin_amdgcn_mfma_f32_32x32x16_bf16(S##a, S##q, p0, 0, 0, 0); p1 = __builtin_amdgcn_mfma_f32_32x32x16_bf16(S##b, S##q, p1, 0, 0, 0); } while (0)
#define LWN(n) do { asm volatile("s_waitcnt lgkmcnt(" #n ")" ::: "memory"); SBAR(); } while (0)
    bf16x8 Aq, Aa, Ab, Bq, Ba, Bb;
    RDS(A, 0); RDS(B, 1);
    LWN(3); MMS(A); SBAR(); RDS(A, 2);
    LWN(3); MMS(B); SBAR(); RDS(B, 3);
    LWN(3); MMS(A); SBAR(); RDS(A, 4);
    LWN(3); MMS(B); SBAR(); RDS(B, 5);
    LWN(3); MMS(A); SBAR(); RDS(A, 6);
    LWN(3); MMS(B); SBAR(); RDS(B, 7);
    LWN(3); MMS(A); SBAR();
    LWN(0); MMS(B);
#undef LDR
#undef RDS
#undef MMS
#undef LWN
}
constexpr int DLDS_K = 2 * SHM_V, DLDS_Q = DLDS_K + SHM_K, DLDS_WS = DLDS_Q + NW * 8192, DLDS_BYTES = DLDS_WS + NW * 64 * 4;
struct DiffRef { unsigned qoff, koff, v0off, v1off, ooff; int qb; };
__device__ __forceinline__ void diff_block(const DiffRef& R, const bf16* qkv, bf16* obase, int ldo, char* lds, const int wv) {
    const int tid = fresh_tid(wv), wid = wv, lane = tid & 63, r32 = lane & 31, hi = lane >> 5;
    char* V_lds = lds; char* K_lds = lds + DLDS_K; char* Q_lds = lds + DLDS_Q + wid * 8192;
    float* ws = (float*)(lds + DLDS_WS) + wid * 64; float* li_l = ws, * al_l = ws + 32;
    const int NT = 4 * R.qb + 5, myNT = 4 * R.qb + 2 + (wid >> 1);
    const int sr = tid >> 4, sc = (tid & 15) * 8, vst0 = v_st(sr, sc), vst1 = v_st(32 + sr, sc), kws = KSWZ(sr, sc * 2);
    const int vb0 = (int)(uintptr_t)V_lds + v_rd_base(lane);
    const bf16* Kh = qkv + R.koff; const bf16* V0h = qkv + R.v0off; const bf16* V1h = qkv + R.v1off;
    const int qsw = KSWZ(r32, hi * 16);
#define QCH(d0) (KSWZ(r32, ((d0) * 16 + hi * 8) * 2))
    {
        const bf16* Qp = qkv + R.qoff + (size_t)(wid * QBLK + r32) * D + hi * 8; bf16x8 q[8];
#pragma unroll
        for (int d0 = 0; d0 < 8; ++d0) q[d0] = load8<bf16>(Qp + d0 * 16);
#pragma unroll
        for (int d0 = 0; d0 < 8; ++d0) *(bf16x8*)(Q_lds + QCH(d0)) = q[d0];
    }
    (void)qsw;
    bf16x8 sk0, sk1, sv0, sv1, sv2, sv3;
    const unsigned lo0 = (unsigned)(sr * D + sc), lo1 = lo0 + 32u * D;
#define DLOAD(k0) do { const bf16* kp_ = Kh + (size_t)(k0) * D; const bf16* v0_ = V0h + (size_t)(k0) * D; const bf16* v1_ = V1h + (size_t)(k0) * D;          \
                       sk0 = load8<bf16>(kp_ + lo0); sk1 = load8<bf16>(kp_ + lo1); sv0 = load8<bf16>(v0_ + lo0); sv1 = load8<bf16>(v0_ + lo1);           \
                       sv2 = load8<bf16>(v1_ + lo0); sv3 = load8<bf16>(v1_ + lo1); } while (0)
#define DWRITE() do { *(bf16x8*)(K_lds + kws) = sk0; *(bf16x8*)(K_lds + kws + 32 * 256) = sk1;                                                 \
                      *(bf16x8*)(V_lds + vst0) = sv0; *(bf16x8*)(V_lds + vst1) = sv1; *(bf16x8*)(V_lds + SHM_V + vst0) = sv2; *(bf16x8*)(V_lds + SHM_V + vst1) = sv3; } while (0)
    DLOAD(0);
    float m_reg = -1e30f, l_reg = 0; f32x16 o[8] = {};
#pragma unroll 1
    for (int t = 0; t < NT; ++t) {
        asm volatile("s_waitcnt vmcnt(0)" ::: "memory");
        __syncthreads();
        DWRITE();
        __syncthreads();
        if (t + 1 < NT) DLOAD((t + 1) * KVBLK);
        SBAR();
        if (t < myNT) {
            f32x16 p0, p1; float mn, al; bf16x8 pa0, pa1, pa2, pa3;
            qk64(p0, p1, K_lds, Q_lds, r32, hi);
            if (t == 0) { const float NEG_ = -__builtin_inff();
#pragma unroll
                for (int r_ = 0; r_ < 16; ++r_) { if (r_ >= 8) p0[r_] = NEG_; p1[r_] = NEG_; } }
            partialSM(p0, p1, m_reg, mn, al);
            finishSM(p0, p1, al, l_reg, pa0, pa1, pa2, pa3);
            if (__any(al < 1.f)) { if (hi == 0) al_l[r32] = al; asm volatile("s_waitcnt lgkmcnt(0)" ::: "memory");
#pragma unroll
                for (int d_ = 0; d_ < 8; ++d_)
#pragma unroll
                    for (int r = 0; r < 16; ++r) o[d_][r] *= al_l[crow(r, hi)]; }
            SBAR();
            pv256(o, vb0, pa0, pa1, pa2, pa3);
        }
    }
    if (hi == 0) li_l[r32] = l_reg; asm volatile("s_waitcnt lgkmcnt(0)" ::: "memory");
    bf16* Ow = obase + R.ooff + (size_t)(wid * QBLK) * ldo;
    float rl[16];
#pragma unroll
    for (int r = 0; r < 16; ++r) rl[r] = __builtin_amdgcn_rcpf(li_l[crow(r, hi)]);
    o_rows_store<4>(o, rl, Q_lds, Ow, ldo, 0, r32, hi, lane);
    o_rows_store<4>(o + 4, rl, Q_lds, Ow, ldo, 128, r32, hi, lane);
#undef QCH
#undef DLOAD
#undef DWRITE
}

}


constexpr int NWAVES = 8;
constexpr int NB = 2, T = 8192, DM = 4096, NMETA = 16, LSEQ = NMETA + T;
constexpr int MR = NB * T;
constexpr int KVR = 64 + T;
constexpr int NPROJ = 12288, INW = 12304, FFW = 16384, NGRP = 96;
constexpr int NFH = 16;
constexpr float LN_EPS = 1e-5f, SUBLN_EPS = 1e-5f;
constexpr float DN_ALPHA = 1.189207115002721f;
constexpr float LAMBDA_INIT = 0.2f;

constexpr size_t MiB = 1u << 20;
constexpr size_t WS_CTL = 0, CTL_ZERO_BYTES = 1 * MiB;
constexpr size_t WS_STATS0 = 1 * MiB, WS_STATS1 = WS_STATS0 + 131072, WS_HMETA = WS_STATS1 + 131072, WS_WFF = WS_HMETA + 131072;
constexpr size_t WS_ZF = 2 * MiB;
constexpr size_t WS_CUMS = 4 * MiB;
constexpr size_t WS_ROPE = 6 * MiB;
constexpr size_t WS_WUP = 16 * MiB, WS_WDN = 144 * MiB, WS_WOUT = 272 * MiB, WS_WIN = 304 * MiB;
constexpr size_t WS_H0B = 400 * MiB;
constexpr size_t WS_QKV = 528 * MiB;
constexpr size_t WS_PART0 = 304 * MiB, WS_PART1 = 915 * MiB;
constexpr size_t WS_H1B = 304 * MiB;
constexpr size_t WS_ACT = 432 * MiB;
constexpr size_t WS_RPART = 980 * MiB;
constexpr size_t WS_UPART = 988 * MiB, WS_CPART = 992 * MiB;
constexpr size_t WS_UCOL = 996 * MiB, WS_CCOL = WS_UCOL + 65536;
constexpr size_t WS_END = 997 * MiB;
static_assert(WS_ZF + (size_t)NB * KVR * 16 * 4 <= WS_CUMS && WS_CUMS + (size_t)NB * 16 * KVR * 4 <= WS_ROPE && WS_ROPE + (size_t)2 * LSEQ * 64 * 4 <= WS_WUP, "small regions");
static_assert(WS_QKV + (size_t)NGRP * NB * KVR * 128 * 2 <= WS_PART1 && WS_PART1 + (size_t)MR * 2048 * 2 <= WS_END && WS_ACT + (size_t)MR * FFW * 2 <= WS_END, "big regions");
static_assert(WS_H1B + (size_t)MR * DM * 2 <= WS_ACT && WS_WIN + (size_t)NPROJ * DM * 2 <= WS_H0B && WS_PART0 + (size_t)MR * 2048 * 2 <= WS_H0B, "overlays");
constexpr int CW_TMO = 0, CW_CODE = 1;
constexpr int CW_BAR = 4096;
constexpr int CW_QUEUE = 64, CW_QUEUE2 = 128, CW_QUEUE3 = 1024;
constexpr int CW_UC = 13312;
constexpr int CW_GRP = 12800;
constexpr int CW_NRM = 8192;

constexpr int RING_OFF = 0, RING_BYTES = 131072;
constexpr int LDSCTL_OFF = RING_BYTES, MISC_OFF = LDSCTL_OFF + 320;
constexpr int LDS_BYTES = 147456;
static_assert(MISC_OFF + 128 <= LDS_BYTES, "LDS map");
static_assert(att::LDS_BYTES <= RING_BYTES && att::DLDS_BYTES <= RING_BYTES, "attention LDS");

#define GAS __attribute__((address_space(1)))
#define LAS __attribute__((address_space(3)))
typedef unsigned short bf16;
typedef unsigned v4u __attribute__((ext_vector_type(4)));
typedef float f32x4 __attribute__((ext_vector_type(4)));
typedef short bf16x8 __attribute__((ext_vector_type(8)));
typedef GAS unsigned gu32;
typedef GAS unsigned long long gu64;
#define RLX_AGENT __ATOMIC_RELAXED, __HIP_MEMORY_SCOPE_AGENT
#define LDS_WAIT() asm volatile("s_waitcnt lgkmcnt(0)" ::: "memory")
#define VM_WAIT() asm volatile("s_waitcnt vmcnt(0)" ::: "memory")
__device__ __forceinline__ unsigned long long rt() { return __builtin_amdgcn_s_memrealtime(); }
__device__ __forceinline__ unsigned f2bf(float f) { unsigned u = __builtin_bit_cast(unsigned, f); return (u + 0x7fffu + ((u >> 16) & 1u)) >> 16; }
__device__ __forceinline__ unsigned pk2(float lo, float hi) { return f2bf(lo) | (f2bf(hi) << 16); }

#define XB_TMO      128
#define XB_XCNT(j)  (256  + 64 * (j))
#define XB_XSUB(j)  (1280 + 64 * (j))
#define XB_XGEN(j)  (2304 + 64 * (j))
#define XB_TOP      3328
#define XB_TOPGEN   3392
#define XCD_BAR_WORDS 3456
#define XB_SPIN_CAP (1u << 18)

__device__ __forceinline__ unsigned xb_ld(unsigned* p)              { return __hip_atomic_load(p, __ATOMIC_RELAXED, __HIP_MEMORY_SCOPE_AGENT); }
__device__ __forceinline__ unsigned xb_add(unsigned* p, unsigned v) { return __hip_atomic_fetch_add(p, v, __ATOMIC_RELAXED, __HIP_MEMORY_SCOPE_AGENT); }
__device__ __forceinline__ unsigned xb_xcc_id() { return (unsigned)__builtin_amdgcn_s_getreg((3 << 11) | 20) & 0xFu; }
#define XB_SPIN(cond, bar) do { unsigned _sp = 0; while (cond) { __builtin_amdgcn_s_sleep(1); \
    if ((++_sp & 255u) == 0u) { if (xb_ld(&(bar)[XB_TMO])) break; if (_sp > XB_SPIN_CAP) { atomicAdd(&(bar)[XB_TMO], 1u); break; } } } } while (0)

struct XcdBarrier {
    unsigned* bar; unsigned x;
    volatile LAS unsigned* st;
};

__device__ __forceinline__ XcdBarrier xcd_barrier_post(unsigned* bar, volatile LAS unsigned* st, const bool t0  ) {
    XcdBarrier b; b.bar = bar; b.x = xb_xcc_id(); b.st = st;
    if (t0) (void)xb_add(&bar[XB_XCNT(b.x)], 1u);
    return b;
}
__device__ __forceinline__ void xcd_barrier_complete(unsigned* bar, unsigned x, unsigned& nloc, unsigned& nx) {
    const unsigned G = gridDim.x * gridDim.y * gridDim.z;
    unsigned sum, cnt, mine, sp = 0u;
    for (;;) {
        sum = 0u; cnt = 0u; mine = 0u;
#pragma unroll
        for (unsigned j = 0; j < 16; ++j) { const unsigned c = xb_ld(&bar[XB_XCNT(j)]); sum += c; cnt += (c > 0u) ? 1u : 0u; mine = (j == x) ? c : mine; }
        if (sum == G) break;
        __builtin_amdgcn_s_sleep(1);
        if ((++sp & 255u) == 0u) { if (xb_ld(&bar[XB_TMO])) break; if (sp > XB_SPIN_CAP) { atomicAdd(&bar[XB_TMO], 1u); break; } }
    }
    nloc = mine > 0u ? mine : 1u; nx = cnt > 0u ? cnt : 1u;
}

__device__ __forceinline__ void xcd_barrier(const XcdBarrier& b, const bool t0  ) {
    asm volatile("s_waitcnt vmcnt(0)" ::: "memory");
    __syncthreads();
    if (t0) {
        unsigned* bar = b.bar;
        __builtin_amdgcn_s_waitcnt(0);
        unsigned nloc = b.st[0], nx = b.st[1];
        if (nloc == 0u) { xcd_barrier_complete(bar, b.x, nloc, nx); b.st[0] = nloc; b.st[1] = nx; }
        const unsigned old = xb_add(&bar[XB_XSUB(b.x)], 1u);
        const unsigned gen = old / nloc;
        if (old + 1u == (gen + 1u) * nloc) {
            __builtin_amdgcn_fence(__ATOMIC_RELEASE, "agent");
            asm volatile("s_waitcnt vmcnt(0)" ::: "memory");
            const unsigned og = xb_add(&bar[XB_TOP], 1u);
            const unsigned tg = og / nx;
            if (og + 1u == (tg + 1u) * nx) xb_add(&bar[XB_TOPGEN], 1u);
            else XB_SPIN(xb_ld(&bar[XB_TOPGEN]) == tg, bar);
            __builtin_amdgcn_fence(__ATOMIC_ACQUIRE, "agent");
            xb_add(&bar[XB_XGEN(b.x)], 1u);
            asm volatile("s_waitcnt vmcnt(0)" ::: "memory");
        } else {
            XB_SPIN(xb_ld(&bar[XB_XGEN(b.x)]) == gen, bar);
            __builtin_amdgcn_fence(__ATOMIC_ACQUIRE, "agent");
            asm volatile("s_waitcnt vmcnt(0)" ::: "memory");
        }
    }
    __syncthreads();
}


__device__ __forceinline__ float lane_xor(float v, int k, int lane) { return __builtin_bit_cast(float, __builtin_amdgcn_ds_bpermute((lane ^ k) << 2, __builtin_bit_cast(int, v))); }
__device__ __forceinline__ float lane_up(float v, int o, int lane) { return __builtin_bit_cast(float, __builtin_amdgcn_ds_bpermute(((lane - o) & 63) << 2, __builtin_bit_cast(int, v))); }
__device__ __forceinline__ float wave_sum(float v, int lane) {
#pragma unroll
    for (int o = 1; o < 64; o <<= 1) v += lane_xor(v, o, lane);
    return v;
}
__device__ __forceinline__ float bf2f(unsigned h) { return __builtin_bit_cast(float, h << 16); }
__device__ __forceinline__ float log_sigmoid(float z) { return fminf(z, 0.f) - log1pf(expf(-fabsf(z))); }

__device__ __forceinline__ int p0_rowmap(int n, int mode) {
    if (mode == 1) return n < 4096 ? ((n & ~192) | ((n & 64) << 1) | ((n & 128) >> 1)) : n;
    if (mode == 2) return n - NPROJ;
    return n;
}
__device__ __forceinline__ void p0_transpose_item(const float* W, int ldw, int K, bf16* WT, LAS float* scr, int k0, int n0, int nvalid, int mode, int lane) {
    const int n4 = (lane & 7) * 4;
#pragma unroll
    for (int i = 0; i < 8; ++i) { const int kk = 8 * i + (lane >> 3); f32x4 v = {0.f, 0.f, 0.f, 0.f}; if (n4 < nvalid) v = *(const GAS f32x4*)(W + (size_t)(k0 + kk) * ldw + n0 + n4);
        LAS float* d = scr + kk * 33 + n4; d[0] = v.x; d[1] = v.y; d[2] = v.z; d[3] = v.w; }
    LDS_WAIT(); asm volatile("" ::: "memory");
    const int c = lane & 7;
#pragma unroll
    for (int j = 0; j < 4; ++j) { const int n = (lane >> 3) + 8 * j; const LAS float* s = scr + (8 * c) * 33 + n;
        v4u o; o.x = pk2(s[0 * 33], s[1 * 33]); o.y = pk2(s[2 * 33], s[3 * 33]); o.z = pk2(s[4 * 33], s[5 * 33]); o.w = pk2(s[6 * 33], s[7 * 33]);
        if (n < nvalid) *(GAS v4u*)(WT + (size_t)p0_rowmap(n0 + n, mode) * K + k0 + 8 * c) = o; }
    LDS_WAIT(); asm volatile("" ::: "memory");
}
__device__ __forceinline__ void ln_row(const float* src, const float* g, const float* bta, int lane, float* dstf, bf16* dstb, float* stats) {
    const GAS f32x4* xr = (const GAS f32x4*)src + lane;
    f32x4 v[16]; float s = 0.f;
#pragma unroll
    for (int j = 0; j < 16; ++j) { v[j] = xr[64 * j]; s += (v[j].x + v[j].y) + (v[j].z + v[j].w); }
    const float mean = wave_sum(s, lane) * (1.f / DM); float s2 = 0.f;
#pragma unroll
    for (int j = 0; j < 16; ++j) { v[j] = v[j] - mean; s2 += (v[j].x * v[j].x + v[j].y * v[j].y) + (v[j].z * v[j].z + v[j].w * v[j].w); }
    const float rstd = 1.f / sqrtf(wave_sum(s2, lane) * (1.f / DM) + LN_EPS);
    if (stats && lane == 0) { stats[0] = mean; stats[1] = rstd; }
    const GAS f32x4* g4 = (const GAS f32x4*)g + lane; const GAS f32x4* b4 = (const GAS f32x4*)bta + lane;
#pragma unroll
    for (int j = 0; j < 16; ++j) { const f32x4 o = v[j] * rstd * g4[64 * j] + b4[64 * j];
        if (dstf) ((GAS f32x4*)dstf + lane)[64 * j] = o;
        if (dstb) ((GAS unsigned long long*)dstb + lane)[64 * j] = (unsigned long long)pk2(o.x, o.y) | ((unsigned long long)pk2(o.z, o.w) << 32); }
}
template <int R> __device__ __forceinline__ void ln_rows(const float* src, size_t rstride, const float* g, const float* bta, int lane, float* dstf, bf16* dstb, float* stats, size_t sstride) {
    f32x4 v[R][16]; float s[R];
#pragma unroll
    for (int r = 0; r < R; ++r) { const GAS f32x4* xr = (const GAS f32x4*)(src + r * rstride) + lane; s[r] = 0.f;
#pragma unroll
        for (int j = 0; j < 16; ++j) { v[r][j] = xr[64 * j]; s[r] += (v[r][j].x + v[r][j].y) + (v[r][j].z + v[r][j].w); } }
    float rstd[R];
#pragma unroll
    for (int r = 0; r < R; ++r) { const float mean = wave_sum(s[r], lane) * (1.f / DM); float s2 = 0.f;
#pragma unroll
        for (int j = 0; j < 16; ++j) { v[r][j] = v[r][j] - mean; s2 += (v[r][j].x * v[r][j].x + v[r][j].y * v[r][j].y) + (v[r][j].z * v[r][j].z + v[r][j].w * v[r][j].w); }
        rstd[r] = 1.f / sqrtf(wave_sum(s2, lane) * (1.f / DM) + LN_EPS);
        if (stats && lane == 0) { stats[r * sstride] = mean; stats[r * sstride + 1] = rstd[r]; } }
    const GAS f32x4* g4 = (const GAS f32x4*)g + lane; const GAS f32x4* b4 = (const GAS f32x4*)bta + lane;
#pragma unroll
    for (int j = 0; j < 16; ++j) { const f32x4 gv = g4[64 * j], bv = b4[64 * j];
#pragma unroll
        for (int r = 0; r < R; ++r) { const f32x4 o = v[r][j] * rstd[r] * gv + bv;
            if (dstf) ((GAS f32x4*)(dstf + r * rstride) + lane)[64 * j] = o;
            if (dstb) ((GAS unsigned long long*)(dstb + r * rstride) + lane)[64 * j] = (unsigned long long)pk2(o.x, o.y) | ((unsigned long long)pk2(o.z, o.w) << 32); } }
}
__device__ __forceinline__ void late_conv_decode(int it, const float* w_out, const float* w_up, const float* w_down, bf16* Wout, bf16* Wup, bf16* Wdn,
                                                 const float*& W, int& ldw, int& K, bf16*& WT, int& k0, int& n0) {
    constexpr int I_OUT = 64 * 128, I_UP = 64 * 512;
    if (it < I_OUT) { W = w_out; ldw = DM; K = DM; WT = Wout; k0 = 64 * (it / 128); n0 = 32 * (it % 128); return; } it -= I_OUT;
    if (it < I_UP) { W = w_up; ldw = FFW; K = DM; WT = Wup; k0 = 64 * (it / 512); n0 = 32 * (it % 512); return; } it -= I_UP;
    W = w_down; ldw = DM; K = FFW; WT = Wdn; k0 = 64 * (it / 128); n0 = 32 * (it % 128);
}
__device__ __forceinline__ void late_weight_conv(const float* w_out, const float* w_up, const float* w_down, bf16* Wout, bf16* Wup, bf16* Wdn, LAS float* scr, int gw, int lane, const float* g1, const float* b1, float* upart, float* cpart) {
    constexpr int NIT = 64 * 128 + 64 * 512 + 256 * 128, NGW_ = 256 * NWAVES; static_assert(NIT % (4 * NGW_) == 0, "whole batches of four items per wave");
    const int n4 = (lane & 7) * 4, c = lane & 7;
#pragma unroll 1
    for (int it0 = gw; it0 < NIT; it0 += 4 * NGW_) {
        f32x4 v[4][8];
#pragma unroll
        for (int j = 0; j < 4; ++j) { const float* W; int ldw, K, k0, n0; bf16* WT; late_conv_decode(it0 + j * NGW_, w_out, w_up, w_down, Wout, Wup, Wdn, W, ldw, K, WT, k0, n0);
#pragma unroll
            for (int i = 0; i < 8; ++i) v[j][i] = *(const GAS f32x4*)(W + (size_t)(k0 + 8 * i + (lane >> 3)) * ldw + n0 + n4); }
#pragma unroll
        for (int j = 0; j < 4; ++j) { const float* W; int ldw, K, k0, n0; bf16* WT; late_conv_decode(it0 + j * NGW_, w_out, w_up, w_down, Wout, Wup, Wdn, W, ldw, K, WT, k0, n0);
#pragma unroll
            for (int i = 0; i < 8; ++i) { LAS float* d = scr + (8 * i + (lane >> 3)) * 33 + n4; d[0] = v[j][i].x; d[1] = v[j][i].y; d[2] = v[j][i].z; d[3] = v[j][i].w; }
            LDS_WAIT(); asm volatile("" ::: "memory");
            const int itj = it0 + j * NGW_;
            if (itj >= 64 * 128 && itj < 64 * 128 + 64 * 512) {
                const f32x4 ga = *(const GAS f32x4*)(g1 + k0 + 8 * c), gb = *(const GAS f32x4*)(g1 + k0 + 8 * c + 4), ba = *(const GAS f32x4*)(b1 + k0 + 8 * c), bb = *(const GAS f32x4*)(b1 + k0 + 8 * c + 4);
#pragma unroll
                for (int q = 0; q < 4; ++q) { const int n = (lane >> 3) + 8 * q; const LAS float* s = scr + (8 * c) * 33 + n;
                    const float w0 = s[0 * 33], w1 = s[1 * 33], w2 = s[2 * 33], w3 = s[3 * 33], w4 = s[4 * 33], w5 = s[5 * 33], w6 = s[6 * 33], w7 = s[7 * 33];
                    float cs = ((ba.x * w0 + ba.y * w1) + (ba.z * w2 + ba.w * w3)) + ((bb.x * w4 + bb.y * w5) + (bb.z * w6 + bb.w * w7));
                    v4u o; o.x = pk2(ga.x * w0, ga.y * w1); o.y = pk2(ga.z * w2, ga.w * w3); o.z = pk2(gb.x * w4, gb.y * w5); o.w = pk2(gb.z * w6, gb.w * w7);
                    *(GAS v4u*)(WT + (size_t)(n0 + n) * K + k0 + 8 * c) = o;
                    float us = ((bf2f(o.x & 0xffffu) + bf2f(o.x >> 16)) + (bf2f(o.y & 0xffffu) + bf2f(o.y >> 16))) + ((bf2f(o.z & 0xffffu) + bf2f(o.z >> 16)) + (bf2f(o.w & 0xffffu) + bf2f(o.w >> 16)));
#pragma unroll
                    for (int x = 1; x < 8; x <<= 1) { us += lane_xor(us, x, lane); cs += lane_xor(cs, x, lane); }
                    if (c == 0) { upart[(size_t)(k0 >> 6) * FFW + n0 + n] = us; cpart[(size_t)(k0 >> 6) * FFW + n0 + n] = cs; } }
            } else {
#pragma unroll
            for (int q = 0; q < 4; ++q) { const int n = (lane >> 3) + 8 * q; const LAS float* s = scr + (8 * c) * 33 + n;
                v4u o; o.x = pk2(s[0 * 33], s[1 * 33]); o.y = pk2(s[2 * 33], s[3 * 33]); o.z = pk2(s[4 * 33], s[5 * 33]); o.w = pk2(s[6 * 33], s[7 * 33]);
                *(GAS v4u*)(WT + (size_t)(n0 + n) * K + k0 + 8 * c) = o; }
            }
            LDS_WAIT(); asm volatile("" ::: "memory"); }
    }
}
template <int R> __device__ __forceinline__ void ln_rows_b(const bf16* src, size_t rstride, const float* g, const float* bta, int lane, float* dstf, bf16* dstb, float* stats, size_t sstride, size_t dstride) {
    f32x4 v[R][16]; float s[R];
#pragma unroll
    for (int r = 0; r < R; ++r) { const GAS unsigned long long* xr = (const GAS unsigned long long*)(src + r * rstride) + lane; s[r] = 0.f;
#pragma unroll
        for (int j = 0; j < 16; ++j) { const unsigned long long w = xr[64 * j]; const unsigned lo = (unsigned)w, hi = (unsigned)(w >> 32);
            v[r][j] = (f32x4){bf2f(lo & 0xffffu), bf2f(lo >> 16), bf2f(hi & 0xffffu), bf2f(hi >> 16)}; s[r] += (v[r][j].x + v[r][j].y) + (v[r][j].z + v[r][j].w); } }
    float rstd[R];
#pragma unroll
    for (int r = 0; r < R; ++r) { const float mean = wave_sum(s[r], lane) * (1.f / DM); float s2 = 0.f;
#pragma unroll
        for (int j = 0; j < 16; ++j) { v[r][j] = v[r][j] - mean; s2 += (v[r][j].x * v[r][j].x + v[r][j].y * v[r][j].y) + (v[r][j].z * v[r][j].z + v[r][j].w * v[r][j].w); }
        rstd[r] = 1.f / sqrtf(wave_sum(s2, lane) * (1.f / DM) + LN_EPS);
        if (stats && lane == 0) { stats[r * sstride] = mean; stats[r * sstride + 1] = rstd[r]; } }
    const GAS f32x4* g4 = (const GAS f32x4*)g + lane; const GAS f32x4* b4 = (const GAS f32x4*)bta + lane;
#pragma unroll
    for (int j = 0; j < 16; ++j) { const f32x4 gv = g4[64 * j], bv = b4[64 * j];
#pragma unroll
        for (int r = 0; r < R; ++r) { const f32x4 o = v[r][j] * rstd[r] * gv + bv;
            if (dstf) ((GAS f32x4*)(dstf + r * dstride) + lane)[64 * j] = o;
            if (dstb) ((GAS unsigned long long*)(dstb + r * dstride) + lane)[64 * j] = (unsigned long long)pk2(o.x, o.y) | ((unsigned long long)pk2(o.z, o.w) << 32); } }
}
__device__ __forceinline__ void grp_barrier(gu32* ctl, const int slot, const int bx, const bool t0) {
    asm volatile("s_waitcnt vmcnt(0)" ::: "memory");
    __syncthreads();
    if (t0) {
        unsigned* bar = (unsigned*)(ctl + CW_BAR);
        __builtin_amdgcn_s_waitcnt(0);
        __builtin_amdgcn_fence(__ATOMIC_RELEASE, "agent"); asm volatile("s_waitcnt vmcnt(0)" ::: "memory");
        unsigned* c = (unsigned*)(ctl + CW_GRP + slot * 64 + (bx & 63));
        (void)xb_add(c, 1u);
        XB_SPIN(xb_ld(c) < 4u, bar);
        __builtin_amdgcn_fence(__ATOMIC_ACQUIRE, "agent");
        asm volatile("s_waitcnt vmcnt(0)" ::: "memory");
    }
    __syncthreads();
}
__device__ __forceinline__ void sincos_d(double x, double& sn, double& cs) {
    const double kq = rint(x * 0.63661977236758134308);
    double r = fma(-kq, 1.57079632673412561417e+00, x); r = fma(-kq, 6.07710050630396597660e-11, r); r = fma(-kq, 2.02226624879595063154e-21, r);
    const int q = ((int)kq) & 3; const double z = r * r;
    const double sp = r + r * z * (-1.66666666666666324348e-01 + z * (8.33333333332248946124e-03 + z * (-1.98412698298579493134e-04 + z * (2.75573137070700676789e-06 + z * (-2.50507602534068634195e-08 + z * 1.58969099521155010221e-10)))));
    const double cp = 1.0 - 0.5 * z + z * z * (4.16666666666666019037e-02 + z * (-1.38888888888741095749e-03 + z * (2.48015872894767294178e-05 + z * (-2.75573143513906633035e-07 + z * (2.08757232129817482790e-09 + z * -1.13596475577881948265e-11)))));
    sn = (q == 0) ? sp : (q == 1) ? cp : (q == 2) ? -sp : -cp;
    cs = (q == 0) ? cp : (q == 1) ? -sp : (q == 2) ? -cp : sp;
}

#ifndef STAG_F32
#define STAG_F32 0
#endif
#ifndef STAG_BF
#define STAG_BF 0
#endif
__device__ __forceinline__ void xcd_stagger(unsigned ticks_per) {
    if (ticks_per == 0u) return;
    const unsigned long long t0 = __builtin_amdgcn_s_memrealtime(), w = (unsigned long long)(xb_xcc_id() & 7u) * ticks_per;
    while (__builtin_amdgcn_s_memrealtime() - t0 < w) __builtin_amdgcn_s_sleep(4);
}
struct Args { const float* in[18]; float* out; unsigned char* ws; int ph_lo, ph_hi; };
static_assert(sizeof(Args) == 18 * 8 + 8 + 8 + 8, "Args has padding");
__device__ const float INV_FREQ[64] = {0x1.0000000000000p+0f, 0x1.bb5fae0000000p-1f, 0x1.7ff2220000000p-1f, 0x1.4c7bc00000000p-1f, 0x1.1feb340000000p-1f, 0x1.f2a79e0000000p-2f, 0x1.afd1360000000p-2f, 0x1.75f0360000000p-2f, 0x1.43d1360000000p-2f, 0x1.186a080000000p-2f, 0x1.e5a8460000000p-3f, 0x1.a48fda0000000p-3f, 0x1.6c310e0000000p-3f, 0x1.3b60800000000p-3f, 0x1.111aee0000000p-3f, 0x1.d8ffac0000000p-4f, 0x1.99999a0000000p-4f, 0x1.62b2f00000000p-4f, 0x1.33281a0000000p-4f, 0x1.09fc9a0000000p-4f, 0x1.ccab840000000p-5f, 0x1.8eec7e0000000p-5f, 0x1.59742a0000000p-5f, 0x1.2b26900000000p-5f, 0x1.030dc60000000p-5f, 0x1.c0a9a40000000p-6f, 0x1.84869e0000000p-6f, 0x1.5073160000000p-6f, 0x1.235a720000000p-6f, 0x1.f89a660000000p-7f, 0x1.b4f7e40000000p-7f, 0x1.7a66220000000p-7f, 0x1.47ae140000000p-7f, 0x1.1bc25a0000000p-7f, 0x1.eb73600000000p-8f, 0x1.a9942a0000000p-8f, 0x1.7089380000000p-8f, 0x1.3f23980000000p-8f, 0x1.145cee0000000p-8f, 0x1.dea41c0000000p-9f, 0x1.9e7c700000000p-9f, 0x1.66ee1e0000000p-9f, 0x1.36d21a0000000p-9f, 0x1.0d28de0000000p-9f, 0x1.d22a500000000p-10f, 0x1.93aeb80000000p-10f, 0x1.5d931c0000000p-10f, 0x1.2eb81c0000000p-10f, 0x1.0624de0000000p-10f, 0x1.c603c40000000p-11f, 0x1.8929180000000p-11f, 0x1.5476880000000p-11f, 0x1.26d42c0000000p-11f, 0x1.fe9f580000000p-12f, 0x1.ba2e4a0000000p-12f, 0x1.7ee9ae0000000p-12f, 0x1.4b96c00000000p-12f, 0x1.1f24e40000000p-12f, 0x1.f1502a0000000p-13f, 0x1.aea7c80000000p-13f, 0x1.74eea60000000p-13f, 0x1.42f22c0000000p-13f, 0x1.17a8e40000000p-13f, 0x1.e459c40000000p-14f};
typedef att::BlockRef<att::bf16, att::bf16> ABR;
typedef att::Bases<att::bf16, att::bf16> ABS;
__device__ __forceinline__ att::DiffRef mkref_diff(int ph, int c, int qb) {
    const int b = ph >> 3, h = ph & 7; att::DiffRef r;
    r.qoff = (unsigned)((((2 * h + c) * NB + b) * KVR + 64 + 256 * qb) * 128); r.koff = (unsigned)(((16 + 2 * h + c) * NB + b) * KVR * 128);
    r.v0off = (unsigned)(((32 + 2 * h) * NB + b) * KVR * 128); r.v1off = (unsigned)(((33 + 2 * h) * NB + b) * KVR * 128);
    r.ooff = (unsigned)((c ? WS_PART1 : WS_PART0) / 2) + (unsigned)((b * T + 256 * qb) * 2048 + h * 256); r.qb = qb; return r;
}
__device__ __forceinline__ int fox_jlo(int idx, const float* cums, const LAS float* base_all, const LAS float* smax2_l, int lane) {
    asm volatile("" : "+v"(lane));
    const int qb = 31 - (idx >> 5), bh = idx & 31;
    const float* cb = cums + (size_t)bh * KVR; const LAS float* bl = base_all + bh * 64;
    const float cq = bl[2 * qb] + cb[64 + 256 * qb], thr = -112.5f - smax2_l[bh];
    int jlo = 0; bool found = false;
#pragma unroll
    for (int pass = 0; pass < 2; ++pass) { const int j = pass * 64 + lane; bool keep = true;
        if (j <= 4 * qb) { const float cend = (j == 0) ? cb[15] : bl[(j - 1) >> 1] + cb[64 * j + 63]; keep = !((cq - cend) <= thr); }
        const unsigned long long km = __ballot(keep);
        if (!found && km != 0ull) { jlo = pass * 64 + (int)__builtin_ctzll(km); found = true; } }
    return __builtin_amdgcn_readfirstlane(jlo);
}
struct FoxRef {
    int idx, jlo_;
    __device__ __forceinline__ int qb() const { return 31 - (idx >> 5); }
    __device__ __forceinline__ int bh() const { return idx & 31; }
    __device__ __forceinline__ unsigned qoff() const { const int h = idx & 15, b = (idx >> 4) & 1; return (unsigned)((((48 + h) * NB + b) * KVR + 64 + 256 * qb()) * 128); }
    __device__ __forceinline__ unsigned koff() const { const int h = idx & 15, b = (idx >> 4) & 1; return (unsigned)(((64 + h) * NB + b) * KVR * 128); }
    __device__ __forceinline__ unsigned voff() const { const int h = idx & 15, b = (idx >> 4) & 1; return (unsigned)(((80 + h) * NB + b) * KVR * 128); }
    __device__ __forceinline__ unsigned ooff() const { const int h = idx & 15, b = (idx >> 4) & 1; return (unsigned)((b * T + 256 * qb()) * (2 * DM) + 2048 + h * 128); }
    __device__ __forceinline__ unsigned coff() const { return (unsigned)(bh() * KVR); }
    __device__ __forceinline__ int P0() const { return 64 + 256 * qb(); }
    __device__ __forceinline__ int ldo() const { return DM; }
    __device__ __forceinline__ int boff() const { return LDSCTL_OFF + 4096 + bh() * 256; }
    __device__ __forceinline__ int jlo() const { return jlo_; }
};
struct FoxNext {
    int cidx, cjlo, nidx, njlo; bool pulled; int wv_, qx;
    unsigned* qh; volatile LAS int* slot; const float* cums; const LAS float* base_all; const LAS float* smax2_l;
    __device__ __forceinline__ void early(int t, int NT) { if (!pulled && t + 5 >= NT) { if (wv_ == 0 && att::fresh_lane() == 0) slot[0] = (int)atomicAdd(qh, 1u); pulled = true; } }
    __device__ __forceinline__ FoxRef operator()() { const int li = __builtin_amdgcn_readfirstlane(slot[0]); nidx = (li < 128) ? (((li >> 2) << 5) | (4 * qx + (li & 3))) : 1024; FoxRef r;
        if (nidx < 1024) { njlo = fox_jlo(nidx, cums, base_all, smax2_l, att::fresh_lane()); r.idx = nidx; r.jlo_ = njlo; } else { njlo = cjlo; r.idx = cidx; r.jlo_ = cjlo; }
        return r; }
};
constexpr int N_PHASES = 8;
#ifndef MK_FUSED
#define MK_FUSED 1
#endif

__device__ __forceinline__ const float* karg_f(int idx) {
    const char __attribute__((address_space(4)))* kb = (const char __attribute__((address_space(4)))*)__builtin_amdgcn_kernarg_segment_ptr();
    int off = 8 * idx; asm volatile("" : "+s"(off));
    return (const float*)(const __attribute__((address_space(1))) float*)*(const unsigned long long __attribute__((address_space(4)))*)(kb + off);
}
__global__ void __launch_bounds__(NWAVES * 64, 2) mk_fwd(Args args) {
    extern __shared__ __attribute__((aligned(16))) unsigned char lds_raw[];
    LAS unsigned char* lds = (LAS unsigned char*)lds_raw;
    volatile LAS unsigned* MISC = (volatile LAS unsigned*)(lds + MISC_OFF);
    const int wv = __builtin_amdgcn_readfirstlane((int)threadIdx.x >> 6);
    constexpr int G = 256;
    const int bx = blockIdx.x;
#define vcu ((bx % 8) * (G / 8) + bx / 8)
    constexpr int NGW = G * NWAVES;
#define LANE_IDS() const int tid = att::fresh_tid(wv), lane = tid & 63, wave = wv, gw = vcu * NWAVES + wave; (void)lane; (void)gw
#define T0() (wv == 0 && att::fresh_tid(0) == 0)
    unsigned char* ws = args.ws;
    gu32* ctl = (gu32*)(ws + WS_CTL);
    float* out = args.out;
    float* stats0 = (float*)(ws + WS_STATS0); float* stats1 = (float*)(ws + WS_STATS1);
    bf16* hmeta = (bf16*)(ws + WS_HMETA); bf16* wff = (bf16*)(ws + WS_WFF);
    float* ftot = (float*)(ws + WS_ZF); float* fmeta = ftot + NB * 64 * 16; float* cums = (float*)(ws + WS_CUMS);
    float* ropeC = (float*)(ws + WS_ROPE); float* ropeS = ropeC + (size_t)LSEQ * 64;
    bf16* Wup = (bf16*)(ws + WS_WUP); bf16* Wdn = (bf16*)(ws + WS_WDN); bf16* Wout = (bf16*)(ws + WS_WOUT); bf16* Win = (bf16*)(ws + WS_WIN);
    bf16* h0b = (bf16*)(ws + WS_H0B); bf16* mixb = (bf16*)out;     bf16* qkv = (bf16*)(ws + WS_QKV);
    bf16* part0 = (bf16*)(ws + WS_PART0); bf16* part1 = (bf16*)(ws + WS_PART1);
    bf16* h1b = (bf16*)(ws + WS_H1B); bf16* actb = (bf16*)(ws + WS_ACT);
    float* rpart = (float*)(ws + WS_RPART); float* upart = (float*)(ws + WS_UPART); float* cpart = (float*)(ws + WS_CPART); float* ucol = (float*)(ws + WS_UCOL); float* ccol = (float*)(ws + WS_CCOL);

    for (int u = threadIdx.x; u < (LDS_BYTES - LDSCTL_OFF) / 4; u += NWAVES * 64) ((LAS unsigned*)(lds + LDSCTL_OFF))[u] = 0u;
    __syncthreads();
#if MK_FUSED
#define OPQ1() ({ int one_; asm volatile("s_mov_b32 %0, 1" : "=s"(one_)); one_ != 0; })
    constexpr int lo = 0, hi = N_PHASES;
#else
    const int lo = args.ph_lo, hi = args.ph_hi;
#define OPQ1() true
#endif
    if (hi - lo > 1) (void)xcd_barrier_post((unsigned*)(ctl + CW_BAR), MISC + 8, T0());
#define MKBAR() XcdBarrier bar_; bar_.bar = (unsigned*)(ctl + CW_BAR); bar_.x = xb_xcc_id(); bar_.st = MISC + 8
#ifndef REP_PHASE
#define REP_PHASE (-1)
#endif
#define IN(k) (lo <= (k) && (k) < hi && OPQ1())
#if defined(PROBE_SPIN)
    volatile LAS unsigned long long* PW = (volatile LAS unsigned long long*)(lds + LDSCTL_OFF + 1024);
    if (bx == 0 && T0()) PW[31] = __builtin_amdgcn_s_memrealtime();
#ifndef PROBE_PH
#define PROBE_PH (-9)
#endif
#define PSTAMP(k) do { if constexpr (PROBE_PH < 0 || (k) == PROBE_PH || (k) == PROBE_PH - 1) { if (bx == 0 && T0()) { const unsigned long long n_ = __builtin_amdgcn_s_memrealtime(); PW[k] = n_ - PW[31]; PW[31] = n_; } } } while (0)
#if defined(PROBE_EPI)
#define PCOPY(j) do { if (bx == 0 && T0()) PW[j] = PW[16]; } while (0)
#else
#define PCOPY(j) do { } while (0)
#endif
#if defined(PROBE_CLK)
#define PCLK0() do { if (bx == 0 && T0()) { PW[29] = __builtin_amdgcn_s_memtime(); PW[30] = __builtin_amdgcn_s_memrealtime(); } } while (0)
#define PCLK1(j) do { if (bx == 0 && T0()) { PW[j] = (__builtin_amdgcn_s_memtime() - PW[29]) * 1000ull / (__builtin_amdgcn_s_memrealtime() - PW[30]); } } while (0)
#else
#define PCLK0() do { } while (0)
#define PCLK1(j) do { } while (0)
#endif
#else
#define PSTAMP(k) do { } while (0)
#define PCOPY(j) do { } while (0)
#define PCLK0() do { } while (0)
#define PCLK1(j) do { } while (0)
#endif
#define NREP(k) ((REP_PHASE == (k)) ? 2 : 1)
#if defined(PROBE_SPIN) && defined(PROBE_SPREAD)
#define SEAM(k) do { if (IN(k) && IN((k) + 1)) { MKBAR(); if ((k) == PROBE_SPREAD && T0()) { const unsigned long long v_ = (__builtin_amdgcn_s_memrealtime() << 10) | (unsigned long long)bx; \
            atomicMax((unsigned long long*)(ctl + 2052), v_); atomicMax((unsigned long long*)(ctl + 2054), (1ull << 62) - v_); } xcd_barrier(bar_, T0()); } } while (0)
#elif defined(PROBE_SPIN) && defined(PROBE_SEAM)
#ifndef PROBE_BLK
#define PROBE_BLK 0
#endif
#define SEAM(k) do { if (IN(k) && IN((k) + 1)) { MKBAR(); unsigned long long sb_ = 0; if ((k) == PROBE_SEAM && bx == PROBE_BLK && T0()) sb_ = __builtin_amdgcn_s_memrealtime(); xcd_barrier(bar_, T0()); \
        if ((k) == PROBE_SEAM && bx == PROBE_BLK && T0()) atomicExch((unsigned*)(ctl + 2048), (unsigned)(__builtin_amdgcn_s_memrealtime() - sb_)); } } while (0)
#else
#define SEAM(k) do { if (IN(k) && IN((k) + 1)) { MKBAR(); xcd_barrier(bar_, T0()); } } while (0)
#endif

    if (IN(0)) {
        LANE_IDS();
        const float* x = karg_f(0); const float* meta_tok = karg_f(1); const float* ln_in_g = karg_f(2); const float* ln_in_b = karg_f(3);
        const float* w_in = karg_f(4);
        LAS float* scr = (LAS float*)(lds + RING_OFF + wave * 16384);
        constexpr int I_IN = 64 * 385;
        for (int it = gw; it < I_IN; it += NGW) { const int kb = it / 385, nb = it % 385;
            if (nb < 384) p0_transpose_item(w_in, INW, DM, Win, scr, 64 * kb, 32 * nb, 32, 1, lane);
            else p0_transpose_item(w_in, INW, DM, wff, scr, 64 * kb, NPROJ, 16, 2, lane);
        }
        for (int m = 2 * gw; m < MR; m += 2 * NGW) ln_rows<2>(x + (size_t)m * DM, DM, ln_in_g, ln_in_b, lane, nullptr, h0b + (size_t)m * DM, stats0 + 2 * m, 2);
        if (gw < NMETA) ln_row(meta_tok + (size_t)gw * DM, ln_in_g, ln_in_b, lane, nullptr, hmeta + (size_t)gw * DM, nullptr);
        for (int idx = bx * (NWAVES * 64) + tid; idx < LSEQ * 64; idx += G * NWAVES * 64) {
            const int pos = idx >> 6, i = idx & 63; const float ang = (float)pos * INV_FREQ[i]; double sn, cs; sincos_d((double)ang, sn, cs);
            ropeC[idx] = (float)cs; ropeS[idx] = (float)sn; }
        if (gw < NGRP * NB) { GAS v4u* p = (GAS v4u*)(qkv + ((size_t)gw * KVR + 16) * 128);
#pragma unroll
            for (int j = 0; j < 12; ++j) p[64 * j + lane] = (v4u){0u, 0u, 0u, 0u}; }
    }
    SEAM(0); PSTAMP(0);

    if (IN(1)) {
        LANE_IDS();
        const int r16 = lane & 15, q4 = lane >> 4;
        if (bx < 128) {
            const float* b_forget = karg_f(5);
            LAS float* wt = (LAS float*)(lds + LDSCTL_OFF + 2048);
            const int m0 = 128 * bx + 16 * wave;
            const bf16* ap = h0b + (size_t)(m0 + r16) * DM + 8 * q4; const bf16* bp = wff + (size_t)r16 * DM + 8 * q4;
            f32x4 acc = {0.f, 0.f, 0.f, 0.f};
            for (int k0 = 0; k0 < DM; k0 += 512) {
                bf16x8 av[16], bv[16];
#pragma unroll
                for (int j = 0; j < 16; ++j) { av[j] = *(const bf16x8*)(ap + k0 + 32 * j); bv[j] = *(const bf16x8*)(bp + k0 + 32 * j); }
                __builtin_amdgcn_sched_barrier(0);
#pragma unroll
                for (int j = 0; j < 16; ++j) acc = __builtin_amdgcn_mfma_f32_16x16x32_bf16(av[j], bv[j], acc, 0, 0, 0);
                __builtin_amdgcn_sched_barrier(0); }
            const float bfg = b_forget[r16];
            const float lf0 = log_sigmoid(acc[0] + bfg), lf1 = lf0 + log_sigmoid(acc[1] + bfg), lf2 = lf1 + log_sigmoid(acc[2] + bfg), lf3 = lf2 + log_sigmoid(acc[3] + bfg);
            float s = lf3; { const float u = lane_up(s, 16, lane); if (q4 >= 1) s += u; } { const float u = lane_up(s, 32, lane); if (q4 >= 2) s += u; }
            const float exg = s - lf3;
            if (q4 == 3) wt[wave * 16 + r16] = s;
            __syncthreads();
            float wex = 0.f, wall = 0.f;
#pragma unroll
            for (int w2 = 0; w2 < NWAVES; ++w2) { const float v = wt[w2 * 16 + r16]; wall += v; if (w2 < wave) wex += v; }
            const int b = m0 >> 13, t0 = (m0 & 8191) + 4 * q4; float* cp = cums + (size_t)(b * NFH + r16) * KVR + 64 + t0; const float o = wex + exg;
            cp[0] = o + lf0; cp[1] = o + lf1; cp[2] = o + lf2; cp[3] = o + lf3;
            if (wave == 0 && q4 == 0) ftot[(size_t)(b * 64 + (bx & 63)) * 16 + r16] = wall;
        } else if (bx < 128 + 96) {
            const int pn = (bx - 128) >> 1, hh = (bx - 128) & 1, wq = wave & 3, kh = wave >> 2, s = 64 * hh + 16 * wq + r16;
            const bf16* ap = hmeta + (size_t)r16 * DM + 8 * q4 + 2048 * kh; const bf16* bp0 = Win + (size_t)(256 * pn + s) * DM + 8 * q4 + 2048 * kh; const bf16* bp1 = bp0 + (size_t)128 * DM;
            f32x4 a0 = {0.f, 0.f, 0.f, 0.f}, a1 = {0.f, 0.f, 0.f, 0.f};
            for (int k0 = 0; k0 < DM / 2; k0 += 512) {
                bf16x8 av[16], b0v[16], b1v[16];
#pragma unroll
                for (int j = 0; j < 16; ++j) { av[j] = *(const bf16x8*)(ap + k0 + 32 * j); b0v[j] = *(const bf16x8*)(bp0 + k0 + 32 * j); b1v[j] = *(const bf16x8*)(bp1 + k0 + 32 * j); }
                __builtin_amdgcn_sched_barrier(0);
#pragma unroll
                for (int j = 0; j < 16; ++j) { a0 = __builtin_amdgcn_mfma_f32_16x16x32_bf16(av[j], b0v[j], a0, 0, 0, 0); a1 = __builtin_amdgcn_mfma_f32_16x16x32_bf16(av[j], b1v[j], a1, 0, 0, 0); }
                __builtin_amdgcn_sched_barrier(0); }
            { LAS f32x4* xch = (LAS f32x4*)(lds + RING_OFF) + (wq * 64 + lane) * 2;
              if (kh == 1) { xch[0] = a0; xch[1] = a1; }
              __syncthreads();
              if (kh == 0) { a0 = a0 + xch[0]; a1 = a1 + xch[1]; } }
            if (kh == 0) {
#pragma unroll
            for (int rg = 0; rg < 4; ++rg) { const int i = 4 * q4 + rg;
                if (pn < 16) { const int hh = s >> 6, dl = s & 63, g = 2 * pn + hh; const float c = ropeC[i * 64 + dl], sn = ropeS[i * 64 + dl];
                    const unsigned o1 = f2bf(a0[rg] * c - a1[rg] * sn), o2 = f2bf(a1[rg] * c + a0[rg] * sn);
#pragma unroll
                    for (int b = 0; b < NB; ++b) { bf16* p = qkv + ((size_t)(g * NB + b) * KVR + i) * 128 + dl; p[0] = (bf16)o1; p[64] = (bf16)o2; }
                } else {
#pragma unroll
                    for (int b = 0; b < NB; ++b) { qkv[((size_t)((2 * pn) * NB + b) * KVR + i) * 128 + s] = (bf16)f2bf(a0[rg]); qkv[((size_t)((2 * pn + 1) * NB + b) * KVR + i) * 128 + s] = (bf16)f2bf(a1[rg]); }
                } }
            if (pn >= 32 && pn < 40) {
                float m0 = 0.f, m1 = 0.f;
#pragma unroll
                for (int rg = 0; rg < 4; ++rg) { float s0 = a0[rg] * a0[rg], s1 = a1[rg] * a1[rg];
#pragma unroll
                    for (int o = 1; o < 16; o <<= 1) { s0 += lane_xor(s0, o, lane); s1 += lane_xor(s1, o, lane); }
                    m0 = fmaxf(m0, s0); m1 = fmaxf(m1, s1); }
                m0 = fmaxf(m0, lane_xor(m0, 16, lane)); m0 = fmaxf(m0, lane_xor(m0, 32, lane)); m1 = fmaxf(m1, lane_xor(m1, 16, lane)); m1 = fmaxf(m1, lane_xor(m1, 32, lane));
                if (lane == 0) { gu32* nrm = ctl + CW_NRM;
#pragma unroll
                    for (int b = 0; b < NB; ++b) { atomicMax((unsigned*)nrm + ((2 * pn - 48) * NB + b) * 16 + 4 + 4 * hh + wq, __float_as_uint(m0 * 1.02f)); atomicMax((unsigned*)nrm + ((2 * pn + 1 - 48) * NB + b) * 16 + 4 + 4 * hh + wq, __float_as_uint(m1 * 1.02f)); } }
            }
            }
            __syncthreads();
        } else if (bx == 224) {
            const float* b_forget = karg_f(5);
            const bf16* ap = hmeta + (size_t)r16 * DM + 8 * q4 + 512 * wave; const bf16* bp = wff + (size_t)r16 * DM + 8 * q4 + 512 * wave;
            f32x4 acc = {0.f, 0.f, 0.f, 0.f};
            {   bf16x8 av[16], bv[16];
#pragma unroll
                for (int j = 0; j < 16; ++j) { av[j] = *(const bf16x8*)(ap + 32 * j); bv[j] = *(const bf16x8*)(bp + 32 * j); }
                __builtin_amdgcn_sched_barrier(0);
#pragma unroll
                for (int j = 0; j < 16; ++j) acc = __builtin_amdgcn_mfma_f32_16x16x32_bf16(av[j], bv[j], acc, 0, 0, 0);
                __builtin_amdgcn_sched_barrier(0); }
            LAS f32x4* xch = (LAS f32x4*)(lds + RING_OFF);
            xch[wave * 64 + lane] = acc;
            __syncthreads();
            if (wave == 0) {
#pragma unroll
                for (int w2 = 1; w2 < NWAVES; ++w2) acc = acc + xch[w2 * 64 + lane];
                const float bfg = b_forget[r16];
                const float lf0 = log_sigmoid(acc[0] + bfg), lf1 = lf0 + log_sigmoid(acc[1] + bfg), lf2 = lf1 + log_sigmoid(acc[2] + bfg), lf3 = lf2 + log_sigmoid(acc[3] + bfg);
                float s = lf3; { const float u = lane_up(s, 16, lane); if (q4 >= 1) s += u; } { const float u = lane_up(s, 32, lane); if (q4 >= 2) s += u; }
                const float exg = s - lf3;
#pragma unroll
                for (int b = 0; b < NB; ++b) { float* cp = cums + (size_t)(b * NFH + r16) * KVR + 4 * q4; cp[0] = exg + lf0; cp[1] = exg + lf1; cp[2] = exg + lf2; cp[3] = exg + lf3; }
                if (q4 == 3) fmeta[r16] = s;
            }
            __syncthreads();
        }
        pg8::Gemm g{h0b, Win, MR, NPROJ, DM}; pg8::StaticOrder S; S.init(MR, NPROJ, G, bx);
        pg8::EpiProj E{qkv, ropeC, ropeS, KVR, NB, (unsigned*)(ctl + CW_NRM)};
        xcd_stagger(STAG_BF);
        pg8::gemm_phase<pg8::EpiProj, pg8::StaticOrder, PG8_ALIGN, PG8_SP2>(lds + RING_OFF, g, S, E, wv); PCOPY(17);
    }
    SEAM(1); PSTAMP(1);

    if (IN(2)) {
        PCLK0();
        const ABS AB{(const att::bf16*)qkv, (att::bf16*)out, cums};
        LAS float* base_all = (LAS float*)(lds + LDSCTL_OFF + 4096);
        LAS float* smax2_l = (LAS float*)(lds + LDSCTL_OFF + 12288);
        volatile LAS int* qslot = (volatile LAS int*)(lds + LDSCTL_OFF + 12288 + 128);
#define QSLOT() ({ int qo_ = LDSCTL_OFF + 12288 + 128; asm volatile("" : "+s"(qo_)); (volatile LAS int*)(lds + qo_); })
        gu32* qh = ctl + CW_QUEUE;
        if (((bx >> 3) & 1) == 0) { LANE_IDS(); late_weight_conv(karg_f(11), karg_f(14), karg_f(15), Wout, Wup, Wdn, (LAS float*)(lds + RING_OFF + wave * 16384), gw, lane, karg_f(12), karg_f(13), upart, cpart); __syncthreads(); }
        int ci = 0;
        {   LANE_IDS();
#pragma unroll
            for (int k = 0; k < 4; ++k) { const int bh = wave * 4 + k, b = bh >> 4, h = bh & 15;
                const float v = ftot[(size_t)(b * 64 + lane) * 16 + h]; float s = v;
#pragma unroll
                for (int o = 1; o < 64; o <<= 1) { const float u = lane_up(s, o, lane); if (lane >= o) s += u; }
                base_all[bh * 64 + lane] = fmeta[h] + (s - v); }
            if (tid < 32) { const int b = tid >> 4, h = tid & 15; const gu32* nq = ctl + CW_NRM + (h * NB + b) * 16; const gu32* nk = ctl + CW_NRM + ((16 + h) * NB + b) * 16;
                float q2 = 0.f, k2 = 0.f, km2 = 0.f;
#pragma unroll
                for (int s = 0; s < 4; ++s) { q2 += __uint_as_float(nq[s]); k2 += __uint_as_float(nk[s]); }
#pragma unroll
                for (int s = 4; s < 12; ++s) km2 += __uint_as_float(nk[s]);
                smax2_l[tid] = 2.f * sqrtf(q2 * fmaxf(k2, km2)) * att::SCALE; }
            __syncthreads();
        }
#define XCC() ((int)(xb_xcc_id() & 7u))
#pragma unroll 1
        for (int kq = 0; kq < 8; ++kq) {
          const int qx = (XCC() + kq) & 7;
#pragma unroll 1
          for (;;) {
            __syncthreads();
            if (T0()) qslot[0] = (int)atomicAdd((unsigned*)(ctl + CW_QUEUE2 + 64 * qx), 1u);
            __syncthreads();
            ci = qslot[0];
            if (ci >= 64) break;
            const int qb = 31 - (ci >> 1), rr = 2 * qx + (ci & 1);
#pragma unroll 1
            for (int c = 0; c < 2; ++c) { const att::DiffRef R = mkref_diff(rr, c, qb); att::diff_block(R, (const att::bf16*)qkv, (att::bf16*)ws, 2048, (char*)lds_raw, wv); }
            asm volatile("s_waitcnt vmcnt(0)" ::: "memory"); __syncthreads();
            {   LANE_IDS();
                const float* lq1 = karg_f(6); const float* lk1 = karg_f(7); const float* lq2 = karg_f(8); const float* lk2 = karg_f(9); const float* subln_g = karg_f(10);
                const float s1 = wave_sum(lq1[lane] * lk1[lane] + lq1[lane + 64] * lk1[lane + 64], lane), s2 = wave_sum(lq2[lane] * lk2[lane] + lq2[lane + 64] * lk2[lane + 64], lane);
                const float lam = expf(s1) - expf(s2) + LAMBDA_INIT;
                const f32x4 gl = *(const f32x4*)(subln_g + 4 * lane) * (1.0f - LAMBDA_INIT);
                const int b = rr >> 3, h = rr & 7; const size_t m0 = (size_t)b * T + 256 * qb + 32 * wave;
#pragma unroll 4
                for (int r = 0; r < 32; ++r) { const size_t m = m0 + r;
                    const unsigned long long u0 = *((const GAS unsigned long long*)(part0 + m * 2048 + h * 256) + lane), u1 = *((const GAS unsigned long long*)(part1 + m * 2048 + h * 256) + lane);
                    f32x4 d; d.x = bf2f((unsigned)u0 & 0xffffu) - lam * bf2f((unsigned)u1 & 0xffffu); d.y = bf2f(((unsigned)u0 >> 16)) - lam * bf2f(((unsigned)u1 >> 16));
                    d.z = bf2f((unsigned)(u0 >> 32) & 0xffffu) - lam * bf2f((unsigned)(u1 >> 32) & 0xffffu); d.w = bf2f((unsigned)(u0 >> 48)) - lam * bf2f((unsigned)(u1 >> 48));
                    const float ss = wave_sum((d.x * d.x + d.y * d.y) + (d.z * d.z + d.w * d.w), lane);
                    const float rq = 1.f / sqrtf(ss * (1.f / 256.f) + SUBLN_EPS);
                    const f32x4 o = d * rq * gl;
                    *((GAS unsigned long long*)(mixb + ((m >> 8) * 512 + (m & 255)) * DM + h * 256) + lane) = (unsigned long long)pk2(o.x, o.y) | ((unsigned long long)pk2(o.z, o.w) << 32); }
            }
          }
        }
        if (((bx >> 3) & 1) == 1) { __syncthreads(); LANE_IDS(); late_weight_conv(karg_f(11), karg_f(14), karg_f(15), Wout, Wup, Wdn, (LAS float*)(lds + RING_OFF + wave * 16384), gw, lane, karg_f(12), karg_f(13), upart, cpart); __syncthreads(); }
#pragma unroll 1
        for (int kf = 0; kf < 8; ++kf) {
            const int qxf = ((int)(xb_xcc_id() & 7u) + kf) & 7;
            __syncthreads();
            if (T0()) QSLOT()[0] = (int)atomicAdd((unsigned*)(ctl + CW_QUEUE3 + 64 * qxf), 1u);
            __syncthreads();
            const int li0 = QSLOT()[0];
            if (li0 >= 128) continue;
            ci = ((li0 >> 2) << 5) | (4 * qxf + (li0 & 3));
            att::Seam<att::bf16> S; S.st_b = 0.f; int cj = fox_jlo(ci, cums, base_all, smax2_l, att::fresh_lane());
            { FoxRef cur; cur.idx = ci; cur.jlo_ = cj; att::causal_swa_prime<att::bf16, att::bf16, 1, FoxRef>(cur, AB, 1 << 30, (char*)lds_raw, S, wv); }
#pragma unroll 1
            for (;;) {
                FoxNext nf; nf.cidx = ci; nf.cjlo = cj; nf.nidx = 1024; nf.njlo = 0; nf.pulled = false; nf.wv_ = wv; nf.qx = qxf; nf.qh = (unsigned*)(ctl + CW_QUEUE3 + 64 * qxf); nf.slot = qslot; nf.cums = cums; nf.base_all = base_all; nf.smax2_l = smax2_l;
                { FoxRef cur; cur.idx = ci; cur.jlo_ = cj; att::causal_swa_block<att::bf16, att::bf16, 1, FoxRef, FoxNext>(cur, nf, AB, KVR, 1 << 30, (char*)lds_raw, S, wv); }
                if (nf.nidx >= 1024) break;
                ci = nf.nidx; cj = nf.njlo;
            }
        }
    }
    PCLK1(22);
    SEAM(2); PSTAMP(2);

    if (IN(3)) {
        {   LANE_IDS();
            LAS float* red = (LAS float*)(lds + LDSCTL_OFF + 4096);
            const int nl = tid & 63, ch = tid >> 6, n = bx * 64 + nl; float us = 0.f, cs = 0.f;
#pragma unroll
            for (int kb = 0; kb < 8; ++kb) { us += upart[(size_t)(8 * ch + kb) * FFW + n]; cs += cpart[(size_t)(8 * ch + kb) * FFW + n]; }
            red[ch * 64 + nl] = us; red[512 + ch * 64 + nl] = cs;
            __syncthreads();
            if (tid < 128) { const LAS float* r = red + (tid >> 6) * 512 + nl; float a = 0.f;
#pragma unroll
                for (int k2 = 0; k2 < 8; ++k2) a += r[k2 * 64];
                __hip_atomic_store((tid < 64 ? ucol : ccol) + n, a, RLX_AGENT); }
            asm volatile("s_waitcnt vmcnt(0)" ::: "memory"); __syncthreads();
            if (T0()) (void)xb_add((unsigned*)(ctl + CW_UC), 1u); }
        const float* x = karg_f(0); const float* ln_in_g = karg_f(2); const float* ln_in_b = karg_f(3);
        pg8::Gemm g{mixb, Wout, MR, DM, DM, 1}; pg8::StaticOrder S; S.init(MR, DM, G, bx);
        pg8::EpiOutS E{x, stats0, ln_in_g, ln_in_b, h1b, DM, DN_ALPHA, rpart};
        pg8::gemm_phase<pg8::EpiOutS, pg8::StaticOrder, PG8_ALIGN, PG8_SP2>(lds + RING_OFF, g, S, E, wv); PCOPY(18);
    }
    if (IN(3) && IN(5)) grp_barrier(ctl, 2, bx, T0());
    PSTAMP(3);

    PSTAMP(4);

    if (IN(5)) {
        pg8::Gemm g{h1b, Wup, MR, FFW, DM}; pg8::StaticOrder S; S.init(MR, FFW, G, bx);
        LAS float* st1 = (LAS float*)(lds + LDSCTL_OFF + 4096);
        {   LANE_IDS(); pg8::Unit u0; S.next(0, u0);
            const int rl = tid >> 1, hf = tid & 1, row = u0.pm * 256 + rl; const GAS f32x4* p = (const GAS f32x4*)(rpart + (size_t)row * 128 + 64 * hf);
            float s1 = 0.f, s2 = 0.f;
#pragma unroll
            for (int i = 0; i < 16; ++i) { const f32x4 v = p[i]; s1 += v.x + v.z; s2 += v.y + v.w; }
            s1 += lane_xor(s1, 1, lane); s2 += lane_xor(s2, 1, lane);
            const float mean = s1 * (1.f / DM), var = fmaxf(s2 * (1.f / DM) - mean * mean, 0.f), rstd = 1.f / sqrtf(var + LN_EPS);
            if (hf == 0) { st1[2 * rl] = mean; st1[2 * rl + 1] = rstd; if (bx < 64) { stats1[2 * row] = mean; stats1[2 * row + 1] = rstd; } }
            if (T0()) { unsigned* bar = (unsigned*)(ctl + CW_BAR); XB_SPIN(xb_ld((unsigned*)(ctl + CW_UC)) < 256u, bar); __builtin_amdgcn_fence(__ATOMIC_ACQUIRE, "agent"); asm volatile("s_waitcnt vmcnt(0)" ::: "memory"); }
            __syncthreads(); }
        pg8::EpiUpS E{actb, FFW, ucol, ccol, st1};
        xcd_stagger(STAG_BF);
        PCLK0();
        pg8::gemm_phase<pg8::EpiUpS, pg8::StaticOrder, PG8_ALIGN, PG8_SP2>(lds + RING_OFF, g, S, E, wv); PCOPY(19); PCLK1(21);
    }
    if (IN(5) && IN(6)) grp_barrier(ctl, 0, bx, T0());
    PSTAMP(5);

    if (IN(6)) {
        const float* ln_attn_g = karg_f(12); const float* ln_attn_b = karg_f(13);
        pg8::Gemm g{actb, Wdn, MR, DM, FFW}; pg8::StaticOrder S; S.init(MR, DM, G, bx);
        pg8::EpiDownB E{h1b, (bf16*)out + DM, stats1, ln_attn_g, ln_attn_b, DM, DN_ALPHA, 2 * DM};
        pg8::gemm_phase<pg8::EpiDownB, pg8::StaticOrder, PG8_ALIGN, PG8_SP2>(lds + RING_OFF, g, S, E, wv); PCOPY(20);
    }
    if (IN(6) && IN(7)) grp_barrier(ctl, 1, bx, T0());
    PSTAMP(6);

    if (IN(7)) { PCLK0(); LANE_IDS(); const float* ln_mlp_g = karg_f(16); const float* ln_mlp_b = karg_f(17);
        const int m0 = (8 * (bx & 7) + ((bx >> 3) & 7)) * 256 + 64 * (bx >> 6) + 8 * wave;
#pragma unroll 1
        for (int m = m0; m < m0 + 8; m += 2) ln_rows_b<2>((const bf16*)out + (size_t)m * (2 * DM) + DM, 2 * DM, ln_mlp_g, ln_mlp_b, lane, out + (size_t)m * DM, nullptr, nullptr, 0, DM); }
    PCLK1(23); PSTAMP(7);
#if defined(PROBE_SPIN)
#ifndef PROBE_MUL
#define PROBE_MUL 1
#endif
#ifndef PROBE_DIV
#define PROBE_DIV 1
#endif
    const unsigned PSEAM = __hip_atomic_load((unsigned*)(ctl + 2048), __ATOMIC_RELAXED, __HIP_MEMORY_SCOPE_AGENT); (void)PSEAM;
    const unsigned long long PMAXV = __hip_atomic_load((unsigned long long*)(ctl + 2052), __ATOMIC_RELAXED, __HIP_MEMORY_SCOPE_AGENT), PMINV = (1ull << 62) - __hip_atomic_load((unsigned long long*)(ctl + 2054), __ATOMIC_RELAXED, __HIP_MEMORY_SCOPE_AGENT);
    const unsigned long long PSPREAD = (PMAXV >> 10) - (PMINV >> 10), PLASTBLK = PMAXV & 1023ull, PFIRSTBLK = PMINV & 1023ull; (void)PSPREAD; (void)PLASTBLK; (void)PFIRSTBLK;
    if (bx == 0 && T0()) { const unsigned long long w = (unsigned long long)(PROBE_SPIN) * PROBE_MUL / PROBE_DIV, t0 = __builtin_amdgcn_s_memrealtime();
        while (__builtin_amdgcn_s_memrealtime() - t0 < w) __builtin_amdgcn_s_sleep(8); }
#endif
#undef IN
#undef SEAM
}

extern "C" void kernel_launch(void* const* d_in, const int* in_sizes, int n_in, void* d_out, int out_size, void* d_ws, size_t ws_size, hipStream_t stream) {
    static int grid = 0;
    if (grid == 0) {
        if (n_in != 18 || in_sizes[0] != MR * DM || out_size != MR * DM || ws_size < WS_END) { fprintf(stderr, "kernel_launch: shape/workspace mismatch (n_in %d, in0 %d, out %d, ws %zu < %zu)\n", n_in, n_in > 0 ? in_sizes[0] : -1, out_size, ws_size, (size_t)WS_END); grid = -1; return; }
        if (hipFuncSetAttribute((const void*)mk_fwd, hipFuncAttributeMaxDynamicSharedMemorySize, LDS_BYTES) != hipSuccess) { fprintf(stderr, "kernel_launch: hipFuncSetAttribute failed\n"); grid = -1; return; }
        int per_cu = 0;
        if (hipOccupancyMaxActiveBlocksPerMultiprocessor(&per_cu, (const void*)mk_fwd, NWAVES * 64, LDS_BYTES) != hipSuccess || per_cu < 1) fprintf(stderr, "kernel_launch: occupancy query reports %d\n", per_cu);
        (void)hipGetLastError();
        grid = 256;
    }
    if (grid < 0) return;
    if (hipMemsetAsync((char*)d_ws + WS_CTL, 0, CTL_ZERO_BYTES, stream) != hipSuccess) { fprintf(stderr, "kernel_launch: memset failed\n"); return; }
    Args a{};
    for (int i = 0; i < 18; ++i) a.in[i] = (const float*)d_in[i];
    a.out = (float*)d_out; a.ws = (unsigned char*)d_ws;
#if MK_FUSED
    a.ph_lo = 0; a.ph_hi = N_PHASES;
    hipLaunchKernelGGL(mk_fwd, dim3(grid), dim3(NWAVES * 64), LDS_BYTES, stream, a);
#else
    for (int p = 0; p < N_PHASES; ++p) { a.ph_lo = p; a.ph_hi = p + 1;
        for (int r = 0; r < ((p == REP_PHASE) ? 2 : 1); ++r) hipLaunchKernelGGL(mk_fwd, dim3(grid), dim3(NWAVES * 64), LDS_BYTES, stream, a); }
#endif
    const hipError_t le = hipPeekAtLastError();
    if (le != hipSuccess) fprintf(stderr, "kernel_launch: launch failed: %s\n", hipGetErrorName(le));
}
```

```cpp
#include <hip/hip_runtime.h>
#include <hip/hip_bf16.h>
#include <cstdio>
#include <cstdint>
#include <cmath>
#ifndef MK_FUSED
#define MK_FUSED 1
#endif
#ifndef REP_PHASE
#define REP_PHASE -1
#endif
#if 1
#endif
__device__ __forceinline__ int mk_lane_id() { return (int)__builtin_amdgcn_mbcnt_hi(~0u, __builtin_amdgcn_mbcnt_lo(~0u, 0u)); }
namespace pg8 {
#define PG8_LAS __attribute__((address_space(3)))
typedef unsigned short bf16_t;
typedef short bf16x8 __attribute__((ext_vector_type(8)));
typedef float f32x4 __attribute__((ext_vector_type(4)));
typedef unsigned u32x4 __attribute__((ext_vector_type(4)));
constexpr int BM = 256, BK = 64, HALF = 128, HTB = HALF * BK * 2  , STAGE_BYTES = 8 * HTB, NXCD = 8, WGM = 8;

__host__ __device__ __forceinline__ int lds_byte(int r, int c) { const int st = (r >> 4) * 2 + (c >> 5), rr = r & 15, cc = c & 31, ob = rr * 64 + cc * 2; return st * 1024 + (ob ^ (((ob >> 9) & 1) << 5)); }
__host__ __device__ __forceinline__ void stage_rc(int b, int& R, int& C) { const int st = b / 1024, sb = b % 1024, swz = sb ^ (((sb >> 9) & 1) << 5); R = (st >> 1) * 16 + swz / 64; C = (st & 1) * 32 + (swz % 64) / 2; }
__host__ __device__ __forceinline__ int perm32(int rho) { const int n = rho >> 4, i = rho & 15; return 8 * (i >> 2) + 4 * n + (i & 3); }

struct Unit { int pm, pn; };
struct Gemm { const bf16_t* A; const bf16_t* Bt; int M, N, K; int ashift; };

struct StaticOrder {
    int nM, nN, nwg, G, c;
    __host__ __device__ void init(int M, int N, int G_, int c_) { nM = M / BM; nN = N / BM; nwg = nM * nN; G = G_; c = c_; }
    __host__ __device__ bool next(int i, Unit& u) const {
        const long L = (long)i * G + c; if (L >= nwg) return false;
        int wgid = (int)L; { const int q = nwg / NXCD, r = nwg % NXCD, xcd = wgid % NXCD, off = wgid / NXCD; wgid = (xcd < r ? xcd * (q + 1) : r * (q + 1) + (xcd - r) * q) + off; }
        const int nig = WGM * nN, gid = wgid / nig, fm = gid * WGM, gsz = (nM - fm) < WGM ? (nM - fm) : WGM;
        u.pm = fm + ((wgid % nig) % gsz); u.pn = (wgid % nig) / gsz; return true;
    }
    __device__ __forceinline__ void a_ready(const Unit&) const {}
    __device__ __forceinline__ void done(const Unit&) const {}
};

__device__ __forceinline__ unsigned cvt_pk_bf16(float lo, float hi) { unsigned r; asm volatile("v_cvt_pk_bf16_f32 %0, %1, %2" : "=v"(r) : "v"(lo), "v"(hi)); return r; }
__device__ __forceinline__ u32x4 pack8bf(const f32x4 v0, const f32x4 v1) { u32x4 w; w.x = cvt_pk_bf16(v0[0], v0[1]); w.y = cvt_pk_bf16(v0[2], v0[3]); w.z = cvt_pk_bf16(v1[0], v1[1]); w.w = cvt_pk_bf16(v1[2], v1[3]); return w; }

struct EpiProj {
    static constexpr bool PERM = true, AFTER_DRAIN = false;
    bf16_t* QKV; const float* ropeC; const float* ropeS; int kvr, nb; unsigned* nrm;
    __device__ __forceinline__ void operator()(const f32x4 (&acc)[2][2][4][2], const Unit& u, int wr, int wc, int fr, int fq) const {
        const int m0 = u.pm * BM, b = m0 >> 13, t0 = (m0 & 8191) + wr * 64 + fr;
        if (u.pn < 16) {
            const int hh = wc >> 1, dl0 = 32 * (wc & 1) + 8 * fq, g = 2 * u.pn + hh;
            bf16_t* base = QKV + ((size_t)(g * nb + b) * kvr + 64) * 128 + dl0;
#pragma unroll
            for (int ai = 0; ai < 2; ++ai)
#pragma unroll
                for (int m = 0; m < 4; ++m) { const int t = t0 + ai * HALF + m * 16; const float* cp = ropeC + (size_t)(16 + t) * 64 + dl0; const float* sp = ropeS + (size_t)(16 + t) * 64 + dl0;
                    const f32x4 c0 = *(const f32x4*)cp, c1 = *(const f32x4*)(cp + 4), s0 = *(const f32x4*)sp, s1 = *(const f32x4*)(sp + 4);
                    const f32x4 x1a = acc[ai][0][m][0], x1b = acc[ai][0][m][1], x2a = acc[ai][1][m][0], x2b = acc[ai][1][m][1];
                    const f32x4 o1a = x1a * c0 - x2a * s0, o1b = x1b * c1 - x2b * s1, o2a = x2a * c0 + x1a * s0, o2b = x2b * c1 + x1b * s1;
                    bf16_t* rowp = base + (size_t)t * 128;
                    *(u32x4*)rowp = pack8bf(o1a, o1b); *(u32x4*)(rowp + 64) = pack8bf(o2a, o2b); }
        } else {
#pragma unroll
            for (int bj = 0; bj < 2; ++bj) { const int g = 2 * u.pn + bj; bf16_t* base = QKV + ((size_t)(g * nb + b) * kvr + 64) * 128 + 32 * wc + 8 * fq;
#pragma unroll
                for (int ai = 0; ai < 2; ++ai)
#pragma unroll
                    for (int m = 0; m < 4; ++m) { const int t = t0 + ai * HALF + m * 16; *(u32x4*)(base + (size_t)t * 128) = pack8bf(acc[ai][bj][m][0], acc[ai][bj][m][1]); } }
            if (u.pn >= 24 && u.pn < 40) {
#pragma unroll
                for (int bj = 0; bj < 2; ++bj) { float mx = 0.f;
#pragma unroll
                    for (int ai = 0; ai < 2; ++ai)
#pragma unroll
                        for (int m = 0; m < 4; ++m) { const f32x4 a = acc[ai][bj][m][0], c = acc[ai][bj][m][1];
                            float ss = (a[0] * a[0] + a[1] * a[1]) + (a[2] * a[2] + a[3] * a[3]) + (c[0] * c[0] + c[1] * c[1]) + (c[2] * c[2] + c[3] * c[3]);
                            ss += __shfl_xor(ss, 16); ss += __shfl_xor(ss, 32); mx = fmaxf(mx, ss); }
                    mx = fmaxf(mx, __shfl_xor(mx, 1)); mx = fmaxf(mx, __shfl_xor(mx, 2)); mx = fmaxf(mx, __shfl_xor(mx, 4)); mx = fmaxf(mx, __shfl_xor(mx, 8));
                    if (fr == 0 && fq == 0) atomicMax(nrm + ((2 * u.pn + bj - 48) * nb + b) * 16 + wc, __float_as_uint(mx * 1.02f)); }
            }
        }
    }
};
struct EpiOut {
    static constexpr bool PERM = false, AFTER_DRAIN = false;
    const float* X; const float* stats; const float* g; const float* bta; float* Y; int ldc; float alpha;
    __device__ __forceinline__ void operator()(const f32x4 (&acc)[2][2][4][2], const Unit& u, int wr, int wc, int fr, int fq) const {
        const int row0 = u.pm * BM + wr * 64 + fr, col0 = u.pn * BM + wc * 32 + 4 * fq;
        f32x4 gv[2][2], bv[2][2];
#pragma unroll
        for (int bj = 0; bj < 2; ++bj)
#pragma unroll
            for (int n = 0; n < 2; ++n) { gv[bj][n] = *(const f32x4*)(g + col0 + bj * HALF + n * 16); bv[bj][n] = *(const f32x4*)(bta + col0 + bj * HALF + n * 16); }
#pragma unroll
        for (int ai = 0; ai < 2; ++ai)
#pragma unroll
            for (int m = 0; m < 4; ++m) { const int r = row0 + ai * HALF + m * 16; const float mu = stats[2 * r], rs = stats[2 * r + 1] * alpha; const size_t off = (size_t)r * ldc + col0;
#pragma unroll
                for (int bj = 0; bj < 2; ++bj)
#pragma unroll
                    for (int n = 0; n < 2; ++n) { const f32x4 xv = *(const f32x4*)(X + off + bj * HALF + n * 16);
                        *(f32x4*)(Y + off + bj * HALF + n * 16) = (xv - mu) * rs * gv[bj][n] + bv[bj][n] * alpha + acc[ai][bj][m][n]; }
                if (m & 1) asm volatile("" ::: "memory"); }
    }
};
struct EpiUp {
    static constexpr bool PERM = true, AFTER_DRAIN = false;
    bf16_t* O; int ldc;
    __device__ __forceinline__ void operator()(const f32x4 (&acc)[2][2][4][2], const Unit& u, int wr, int wc, int fr, int fq) const {
        const int row0 = u.pm * BM + wr * 64 + fr, col0 = u.pn * BM + wc * 32 + 8 * fq;
#pragma unroll
        for (int ai = 0; ai < 2; ++ai)
#pragma unroll
            for (int m = 0; m < 4; ++m) { bf16_t* rowp = O + (size_t)(row0 + ai * HALF + m * 16) * ldc + col0;
#pragma unroll
                for (int bj = 0; bj < 2; ++bj) { f32x4 v0 = acc[ai][bj][m][0], v1 = acc[ai][bj][m][1];
#pragma unroll
                    for (int e = 0; e < 4; ++e) { const float a = fmaxf(v0[e], 0.f), c = fmaxf(v1[e], 0.f); v0[e] = a * a; v1[e] = c * c; }
                    *(u32x4*)(rowp + bj * HALF) = pack8bf(v0, v1); } }
    }
};
struct EpiDown {
    static constexpr bool PERM = false, AFTER_DRAIN = false;
    float* Y; const float* stats; const float* g; const float* bta; int ldc; float alpha;
    __device__ __forceinline__ void operator()(const f32x4 (&acc)[2][2][4][2], const Unit& u, int wr, int wc, int fr, int fq) const {
        const int row0 = u.pm * BM + wr * 64 + fr, col0 = u.pn * BM + wc * 32 + 4 * fq;
        f32x4 gv[2][2], bv[2][2];
#pragma unroll
        for (int bj = 0; bj < 2; ++bj)
#pragma unroll
            for (int n = 0; n < 2; ++n) { gv[bj][n] = *(const f32x4*)(g + col0 + bj * HALF + n * 16); bv[bj][n] = *(const f32x4*)(bta + col0 + bj * HALF + n * 16); }
#pragma unroll
        for (int ai = 0; ai < 2; ++ai)
#pragma unroll
            for (int m = 0; m < 4; ++m) { const int r = row0 + ai * HALF + m * 16; const float mu = stats[2 * r], rs = stats[2 * r + 1] * alpha; const size_t off = (size_t)r * ldc + col0;
#pragma unroll
                for (int bj = 0; bj < 2; ++bj)
#pragma unroll
                    for (int n = 0; n < 2; ++n) { float* p = Y + off + bj * HALF + n * 16; const f32x4 yv = *(const f32x4*)p;
                        *(f32x4*)p = (yv - mu) * rs * gv[bj][n] + bv[bj][n] * alpha + acc[ai][bj][m][n]; }
                if (m & 1) asm volatile("" ::: "memory"); }
    }
};

__device__ __forceinline__ void unpack8bf(const u32x4 w, f32x4& lo, f32x4& hi) {
    lo[0] = __builtin_bit_cast(float, w.x << 16); lo[1] = __builtin_bit_cast(float, w.x & 0xffff0000u); lo[2] = __builtin_bit_cast(float, w.y << 16); lo[3] = __builtin_bit_cast(float, w.y & 0xffff0000u);
    hi[0] = __builtin_bit_cast(float, w.z << 16); hi[1] = __builtin_bit_cast(float, w.z & 0xffff0000u); hi[2] = __builtin_bit_cast(float, w.w << 16); hi[3] = __builtin_bit_cast(float, w.w & 0xffff0000u);
}
struct EpiOutB {
    static constexpr bool PERM = true, AFTER_DRAIN = false;
    const float* X; const float* stats; const float* g; const float* bta; bf16_t* Yb; int ldc; float alpha;
    __device__ __forceinline__ void operator()(const f32x4 (&acc)[2][2][4][2], const Unit& u, int wr, int wc, int fr, int fq) const {
        const int row0 = u.pm * BM + wr * 64 + fr, col0 = u.pn * BM + wc * 32 + 8 * fq;
        f32x4 gv[2][2], bv[2][2];
#pragma unroll
        for (int bj = 0; bj < 2; ++bj)
#pragma unroll
            for (int n = 0; n < 2; ++n) { gv[bj][n] = *(const f32x4*)(g + col0 + bj * HALF + n * 4); bv[bj][n] = *(const f32x4*)(bta + col0 + bj * HALF + n * 4) * alpha; }
#pragma unroll
        for (int ai = 0; ai < 2; ++ai)
#pragma unroll
            for (int m = 0; m < 4; ++m) { const int r = row0 + ai * HALF + m * 16; const float mu = stats[2 * r], rs = stats[2 * r + 1] * alpha; const size_t off = (size_t)r * ldc + col0;
#pragma unroll
                for (int bj = 0; bj < 2; ++bj) { const f32x4 x0 = *(const f32x4*)(X + off + bj * HALF), x1 = *(const f32x4*)(X + off + bj * HALF + 4);
                    const f32x4 y0 = (x0 - mu) * rs * gv[bj][0] + bv[bj][0] + acc[ai][bj][m][0], y1 = (x1 - mu) * rs * gv[bj][1] + bv[bj][1] + acc[ai][bj][m][1];
                    *(u32x4*)(Yb + off + bj * HALF) = pack8bf(y0, y1); }
                if (m & 1) asm volatile("" ::: "memory"); }
    }
};
struct EpiOutS {
    static constexpr bool PERM = true, AFTER_DRAIN = false;
    const float* X; const float* stats; const float* g; const float* bta; bf16_t* Yb; int ldc; float alpha; float* rpart;
    __device__ __forceinline__ void operator()(const f32x4 (&acc)[2][2][4][2], const Unit& u, int wr, int wc, int fr, int fq) const {
        const int row0 = u.pm * BM + wr * 64 + fr, col0 = u.pn * BM + wc * 32 + 8 * fq, lane = fq * 16 + fr;
        f32x4 gv[2][2], bv[2][2];
#pragma unroll
        for (int bj = 0; bj < 2; ++bj)
#pragma unroll
            for (int n = 0; n < 2; ++n) { gv[bj][n] = *(const f32x4*)(g + col0 + bj * HALF + n * 4); bv[bj][n] = *(const f32x4*)(bta + col0 + bj * HALF + n * 4) * alpha; }
#pragma unroll
        for (int ai = 0; ai < 2; ++ai)
#pragma unroll
            for (int m = 0; m < 4; ++m) { const int r = row0 + ai * HALF + m * 16; const float mu = stats[2 * r], rs = stats[2 * r + 1] * alpha; const size_t off = (size_t)r * ldc + col0;
                float s1 = 0.f, s2 = 0.f;
#pragma unroll
                for (int bj = 0; bj < 2; ++bj) { const f32x4 x0 = *(const f32x4*)(X + off + bj * HALF), x1 = *(const f32x4*)(X + off + bj * HALF + 4);
                    const f32x4 y0 = (x0 - mu) * rs * gv[bj][0] + bv[bj][0] + acc[ai][bj][m][0], y1 = (x1 - mu) * rs * gv[bj][1] + bv[bj][1] + acc[ai][bj][m][1];
                    s1 += ((y0[0] + y0[1]) + (y0[2] + y0[3])) + ((y1[0] + y1[1]) + (y1[2] + y1[3]));
                    s2 += ((y0[0] * y0[0] + y0[1] * y0[1]) + (y0[2] * y0[2] + y0[3] * y0[3])) + ((y1[0] * y1[0] + y1[1] * y1[1]) + (y1[2] * y1[2] + y1[3] * y1[3]));
                    *(u32x4*)(Yb + off + bj * HALF) = pack8bf(y0, y1); }
#pragma unroll
                for (int x = 16; x < 64; x <<= 1) { s1 += __builtin_bit_cast(float, __builtin_amdgcn_ds_bpermute((lane ^ x) << 2, __builtin_bit_cast(int, s1))); s2 += __builtin_bit_cast(float, __builtin_amdgcn_ds_bpermute((lane ^ x) << 2, __builtin_bit_cast(int, s2))); }
                if (fq == 0) { typedef float f32x2v __attribute__((ext_vector_type(2))); *(f32x2v*)(rpart + ((size_t)r * 64 + u.pn * 4 + wc) * 2) = (f32x2v){s1, s2}; }
                if (m & 1) asm volatile("" ::: "memory"); }
    }
};
struct EpiUpS {
    static constexpr bool PERM = true, AFTER_DRAIN = false;
    bf16_t* O; int ldc; const float* ucol; const float* ccol; const PG8_LAS float* st;
    __device__ __forceinline__ void operator()(const f32x4 (&acc)[2][2][4][2], const Unit& u, int wr, int wc, int fr, int fq) const {
        typedef float f32x2v __attribute__((ext_vector_type(2)));
        const int rl0 = wr * 64 + fr, row0 = u.pm * BM + rl0, col0 = u.pn * BM + wc * 32 + 8 * fq;
        f32x4 uv[2][2], cv[2][2];
#pragma unroll
        for (int bj = 0; bj < 2; ++bj)
#pragma unroll
            for (int n = 0; n < 2; ++n) { uv[bj][n] = *(const f32x4*)(ucol + col0 + bj * HALF + n * 4); cv[bj][n] = *(const f32x4*)(ccol + col0 + bj * HALF + n * 4); }
#pragma unroll
        for (int ai = 0; ai < 2; ++ai)
#pragma unroll
            for (int m = 0; m < 4; ++m) { bf16_t* rowp = O + (size_t)(row0 + ai * HALF + m * 16) * ldc + col0; const f32x2v sr = *(const PG8_LAS f32x2v*)(st + 2 * (rl0 + ai * HALF + m * 16));
#pragma unroll
                for (int bj = 0; bj < 2; ++bj) { f32x4 v0 = (acc[ai][bj][m][0] - sr.x * uv[bj][0]) * sr.y + cv[bj][0], v1 = (acc[ai][bj][m][1] - sr.x * uv[bj][1]) * sr.y + cv[bj][1];
#pragma unroll
                    for (int e = 0; e < 4; ++e) { const float a = fmaxf(v0[e], 0.f), c = fmaxf(v1[e], 0.f); v0[e] = a * a; v1[e] = c * c; }
                    *(u32x4*)(rowp + bj * HALF) = pack8bf(v0, v1); } }
    }
};
struct EpiDownB {
    static constexpr bool PERM = true, AFTER_DRAIN = false;
    const bf16_t* Y1b; bf16_t* Y2b; const float* stats; const float* g; const float* bta; int ldc; float alpha; int ldy;
    __device__ __forceinline__ void operator()(const f32x4 (&acc)[2][2][4][2], const Unit& u, int wr, int wc, int fr, int fq) const {
        const int row0 = u.pm * BM + wr * 64 + fr, col0 = u.pn * BM + wc * 32 + 8 * fq;
        f32x4 gv[2][2], bv[2][2];
#pragma unroll
        for (int bj = 0; bj < 2; ++bj)
#pragma unroll
            for (int n = 0; n < 2; ++n) { gv[bj][n] = *(const f32x4*)(g + col0 + bj * HALF + n * 4); bv[bj][n] = *(const f32x4*)(bta + col0 + bj * HALF + n * 4) * alpha; }
#pragma unroll
        for (int ai = 0; ai < 2; ++ai)
#pragma unroll
            for (int m = 0; m < 4; ++m) { const int r = row0 + ai * HALF + m * 16; const float mu = stats[2 * r], rs = stats[2 * r + 1] * alpha; const size_t off = (size_t)r * ldc + col0;
#pragma unroll
                for (int bj = 0; bj < 2; ++bj) { f32x4 x0, x1; unpack8bf(*(const u32x4*)(Y1b + off + bj * HALF), x0, x1);
                    const f32x4 y0 = (x0 - mu) * rs * gv[bj][0] + bv[bj][0] + acc[ai][bj][m][0], y1 = (x1 - mu) * rs * gv[bj][1] + bv[bj][1] + acc[ai][bj][m][1];
                    *(u32x4*)(Y2b + (size_t)r * ldy + col0 + bj * HALF) = pack8bf(y0, y1); }
                if (m & 1) asm volatile("" ::: "memory"); }
    }
};

template <class Epi, class Sched, bool ALIGN_EPI = false, bool SP2 = false>
__device__ __forceinline__ void gemm_phase(PG8_LAS unsigned char* lds, const Gemm g, const Sched& S, const Epi& E, const int wv  ) {
    const int lane = mk_lane_id(), wid = wv, tid = wv * 64 + lane, wr = wid >> 2, wc = wid & 3, fr = lane & 15, fq = lane >> 4;
    const int K = g.K, nt = K / BK;
    unsigned voffA[2], voffB[2];
#pragma unroll
    for (int i = 0; i < 2; ++i) { int R, C; stage_rc(tid * 16 + i * 8192, R, C); const int Rb = Epi::PERM ? ((R & ~31) + perm32(R & 31)) : R;
        voffA[i] = (unsigned)(R * K + C) * 2u; voffB[i] = (unsigned)(Rb * K + C) * 2u; }
    const size_t kstep = (size_t)(BK * 2);
    const size_t hstep = (size_t)HALF * K * 2;
    const size_t tstep = 2 * hstep;
    const unsigned ldsw = (unsigned)wid * 1024u;
    const int aoff = lds_byte(wr * 64 + fr, fq * 8), boff = lds_byte(wc * 32 + fr, fq * 8);
#define PG8_SA(b, h) (((b) * 2 + (h)) * HTB)
#define PG8_SB(b, h) ((4 + (b) * 2 + (h)) * HTB)
#define PG8_STAGE(bufoff, gbase, voff) do { _Pragma("unroll") for (int _i = 0; _i < 2; ++_i) \
        __builtin_amdgcn_global_load_lds((const unsigned*)((const char*)(gbase) + (voff)[_i]), (PG8_LAS unsigned*)(lds + (bufoff) + ldsw + _i * 8192), 16, 0, 0); } while (0)
#define PG8_LDA(dst, b, h) do { _Pragma("unroll") for (int m = 0; m < 4; ++m) _Pragma("unroll") for (int k = 0; k < 2; ++k) dst[m][k] = *(const PG8_LAS bf16x8*)(lds + PG8_SA(b, h) + aoff + m * 2048 + k * 1024); } while (0)
#define PG8_LDB(dst, b, h) do { _Pragma("unroll") for (int n = 0; n < 2; ++n) _Pragma("unroll") for (int k = 0; k < 2; ++k) dst[n][k] = *(const PG8_LAS bf16x8*)(lds + PG8_SB(b, h) + boff + n * 2048 + k * 1024); } while (0)
#define PG8_MMA(ai, bj, At, Bt) do { __builtin_amdgcn_s_setprio(1); _Pragma("unroll") for (int m = 0; m < 4; ++m) _Pragma("unroll") for (int n = 0; n < 2; ++n) _Pragma("unroll") for (int k = 0; k < 2; ++k) \
        acc[ai][bj][m][n] = __builtin_amdgcn_mfma_f32_16x16x32_bf16(Bt[n][k], At[m][k], acc[ai][bj][m][n], 0, 0, 0); __builtin_amdgcn_s_setprio(0); } while (0)
#define PG8_WAIT_V(n) asm volatile("s_waitcnt vmcnt(" #n ")" ::: "memory")
#define PG8_WAIT_L(n) asm volatile("s_waitcnt lgkmcnt(" #n ")" ::: "memory")
#define PG8_BAR __builtin_amdgcn_s_barrier()
#define PG8_SCHED __builtin_amdgcn_sched_barrier(0)
    Unit cur, nxt; int ui = 0;
#if defined(PROBE_EPI)
    unsigned long long pe_acc = 0ull;
#endif
    if (!S.next(0, cur)) return;
    f32x4 acc[2][2][4][2];
#pragma unroll
    for (int a = 0; a < 2; ++a)
#pragma unroll
        for (int b = 0; b < 2; ++b)
#pragma unroll
            for (int m = 0; m < 4; ++m)
#pragma unroll
                for (int n = 0; n < 2; ++n) acc[a][b][m][n] = (f32x4){0.f, 0.f, 0.f, 0.f};
    bf16x8 At[4][2], B0[2][2], B1[2][2];
    const char* cA = (const char*)g.A + (((size_t)cur.pm * tstep) << g.ashift); const char* cB = (const char*)g.Bt + (size_t)cur.pn * tstep;
    S.a_ready(cur);
    if constexpr (SP2) {
        PG8_STAGE(PG8_SB(0, 0), cB, voffB); PG8_STAGE(PG8_SB(0, 1), cB + hstep, voffB); PG8_STAGE(PG8_SA(0, 0), cA, voffA); PG8_STAGE(PG8_SA(0, 1), cA + hstep, voffA);
        if (wr == 1) PG8_BAR;
        PG8_WAIT_V(2); PG8_BAR;
        PG8_STAGE(PG8_SB(1, 0), cB + kstep, voffB); PG8_STAGE(PG8_SA(1, 0), cA + kstep, voffA); PG8_STAGE(PG8_SB(1, 1), cB + hstep + kstep, voffB);
        PG8_WAIT_V(6); PG8_BAR;
    } else {
        PG8_STAGE(PG8_SB(0, 0), cB, voffB); PG8_STAGE(PG8_SA(0, 0), cA, voffA); PG8_STAGE(PG8_SB(0, 1), cB + hstep, voffB); PG8_STAGE(PG8_SA(0, 1), cA + hstep, voffA);
        if (wr == 1) PG8_BAR;
        PG8_WAIT_V(4); PG8_BAR;
        PG8_STAGE(PG8_SB(1, 0), cB + kstep, voffB); PG8_STAGE(PG8_SA(1, 0), cA + kstep, voffA); PG8_STAGE(PG8_SB(1, 1), cB + hstep + kstep, voffB);
        PG8_WAIT_V(6); PG8_BAR;
    }
    for (;;) {
        const bool has_next = S.next(ui + 1, nxt);
        const char* nA = has_next ? (const char*)g.A + (((size_t)nxt.pm * tstep) << g.ashift) : cA; const char* nB = has_next ? (const char*)g.Bt + (size_t)nxt.pn * tstep : cB;
        for (int t = 0; t < nt; t += 2) {
            const bool last = (t == nt - 2);
            const char* a1 = cA + (size_t)(t + 1) * kstep;
            const char* a2 = last ? nA : cA + (size_t)(t + 2) * kstep; const char* b2 = last ? nB : cB + (size_t)(t + 2) * kstep;
            const char* a3 = a2 + kstep; const char* b3 = b2 + kstep;
            if (last && has_next) S.a_ready(nxt);
            if constexpr (SP2) {
            PG8_LDB(B0, 0, 0); PG8_LDB(B1, 0, 1); PG8_SCHED; PG8_LDA(At, 0, 0); PG8_STAGE(PG8_SA(1, 1), a1 + hstep, voffA);
            PG8_WAIT_V(8); PG8_WAIT_L(0); PG8_BAR; PG8_MMA(0, 0, At, B0); PG8_MMA(0, 1, At, B1); PG8_BAR; PG8_SCHED;
            PG8_LDA(At, 0, 1); PG8_STAGE(PG8_SB(0, 0), b2, voffB); PG8_STAGE(PG8_SB(0, 1), b2 + hstep, voffB); PG8_STAGE(PG8_SA(0, 0), a2, voffA);
            PG8_WAIT_V(8); PG8_WAIT_L(0); PG8_BAR; PG8_MMA(1, 0, At, B0); PG8_MMA(1, 1, At, B1); PG8_BAR; PG8_SCHED;
            PG8_LDB(B0, 1, 0); PG8_LDB(B1, 1, 1); PG8_SCHED; PG8_LDA(At, 1, 0); PG8_STAGE(PG8_SA(0, 1), a2 + hstep, voffA);
            PG8_WAIT_V(8); PG8_WAIT_L(0); PG8_BAR; PG8_MMA(0, 0, At, B0); PG8_MMA(0, 1, At, B1); PG8_BAR; PG8_SCHED;
            PG8_LDA(At, 1, 1); PG8_STAGE(PG8_SB(1, 0), b3, voffB); PG8_STAGE(PG8_SB(1, 1), b3 + hstep, voffB); PG8_STAGE(PG8_SA(1, 0), a3, voffA);
            PG8_WAIT_V(8); PG8_WAIT_L(0); PG8_BAR; PG8_MMA(1, 0, At, B0); PG8_MMA(1, 1, At, B1); PG8_BAR; PG8_SCHED;
            } else {
            PG8_LDB(B0, 0, 0); PG8_SCHED; PG8_LDA(At, 0, 0); PG8_STAGE(PG8_SA(1, 1), a1 + hstep, voffA);
            PG8_WAIT_L(8); PG8_BAR; PG8_WAIT_L(0); PG8_MMA(0, 0, At, B0); PG8_BAR; PG8_SCHED;
            PG8_LDB(B1, 0, 1); PG8_STAGE(PG8_SB(0, 0), b2, voffB);
            PG8_BAR; PG8_WAIT_L(0); PG8_MMA(0, 1, At, B1); PG8_BAR;
            PG8_LDA(At, 0, 1); PG8_STAGE(PG8_SA(0, 0), a2, voffA);
            PG8_BAR; PG8_WAIT_L(0); PG8_MMA(1, 0, At, B0); PG8_BAR; PG8_SCHED;
            PG8_STAGE(PG8_SB(0, 1), b2 + hstep, voffB);
            PG8_WAIT_V(6); PG8_BAR; PG8_MMA(1, 1, At, B1); PG8_BAR;
            PG8_LDB(B0, 1, 0); PG8_SCHED; PG8_LDA(At, 1, 0); PG8_STAGE(PG8_SA(0, 1), a2 + hstep, voffA);
            PG8_WAIT_L(8); PG8_BAR; PG8_WAIT_L(0); PG8_MMA(0, 0, At, B0); PG8_BAR; PG8_SCHED;
            PG8_LDB(B1, 1, 1); PG8_STAGE(PG8_SB(1, 0), b3, voffB);
            PG8_BAR; PG8_WAIT_L(0); PG8_MMA(0, 1, At, B1); PG8_BAR;
            PG8_LDA(At, 1, 1); PG8_STAGE(PG8_SA(1, 0), a3, voffA);
            PG8_BAR; PG8_WAIT_L(0); PG8_MMA(1, 0, At, B0); PG8_BAR; PG8_SCHED;
            PG8_STAGE(PG8_SB(1, 1), b3 + hstep, voffB);
            PG8_WAIT_V(6); PG8_BAR; PG8_MMA(1, 1, At, B1); PG8_BAR;
            }
        }
        if constexpr (ALIGN_EPI) { if (wr == 0) PG8_BAR; }
#if defined(PROBE_EPI)
        { const unsigned long long pe0_ = __builtin_amdgcn_s_memrealtime(); if constexpr (!Epi::AFTER_DRAIN) { E(acc, cur, wr, wc, fr, fq); S.done(cur); } pe_acc += __builtin_amdgcn_s_memrealtime() - pe0_; }
#else
        if constexpr (!Epi::AFTER_DRAIN) { E(acc, cur, wr, wc, fr, fq); S.done(cur); }
#endif
        if (!has_next) break;
#pragma unroll
        for (int a = 0; a < 2; ++a)
#pragma unroll
            for (int b = 0; b < 2; ++b)
#pragma unroll
                for (int m = 0; m < 4; ++m)
#pragma unroll
                    for (int n = 0; n < 2; ++n) acc[a][b][m][n] = (f32x4){0.f, 0.f, 0.f, 0.f};
        cur = nxt; cA = nA; cB = nB; ++ui;
        if constexpr (ALIGN_EPI) { if (wr == 1) PG8_BAR; }
    }
    PG8_WAIT_V(0);
    if constexpr (!ALIGN_EPI) { if (wr == 0) PG8_BAR; }
    PG8_BAR;
    if constexpr (Epi::AFTER_DRAIN) { E.fused(acc, cur, wr, wc, fr, fq, lds, wid, lane); S.done(cur); }
#if defined(PROBE_EPI)
    if (blockIdx.x == 0 && tid == 0) *(volatile PG8_LAS unsigned long long*)(lds + 131072 + 1024 + 8 * 16) = pe_acc;
#endif
#undef PG8_SA
#undef PG8_SB
#undef PG8_STAGE
#undef PG8_LDA
#undef PG8_LDB
#undef PG8_MMA
#undef PG8_WAIT_V
#undef PG8_WAIT_L
#undef PG8_BAR
#undef PG8_SCHED
}
}

#ifndef PG8_SP2
#define PG8_SP2 true
#endif
#ifndef PG8_ALIGN
#define PG8_ALIGN true
#endif
#include <hip/hip_bf16.h>
namespace att {
__device__ __forceinline__ int fresh_lane() { int l; asm volatile("v_mbcnt_lo_u32_b32 %0, -1, 0\n\tv_mbcnt_hi_u32_b32 %0, -1, %0" : "=v"(l)); return l; }
__device__ __forceinline__ int fresh_tid(int wv) { return wv * 64 + fresh_lane(); }
constexpr int D = 128;
constexpr float THR = 8.f;
constexpr bool WSKIP = true;
constexpr float SCALE = 0.08838834764831845f;
constexpr float RSCALE = 11.313708498984761f;
constexpr int NW = 8, QBLK = 32, KVBLK = 64, QB = NW * QBLK;
constexpr int SHM_V = KVBLK * D * 2, SHM_K = KVBLK * D * 2;
constexpr int LDS_BIAS = 2 * SHM_V + 2 * SHM_K + NW * 64 * 4;
constexpr int LDS_OST = LDS_BIAS + 2 * 64 * 4;
constexpr int LDS_BYTES = LDS_OST + NW * 4096;

using bf16 = __hip_bfloat16;
typedef short bf16x8 __attribute__((ext_vector_type(8)));
typedef short s16x4 __attribute__((ext_vector_type(4)));
typedef float f32x16 __attribute__((ext_vector_type(16)));
typedef float f32x4 __attribute__((ext_vector_type(4)));
typedef unsigned u32x4 __attribute__((ext_vector_type(4)));
template <class A, class Bt> struct same_t { static constexpr bool v = false; };
template <class A> struct same_t<A, A> { static constexpr bool v = true; };

#define KSWZ(row, colB) ((row) * 256 + ((colB) ^ (((row) & 7) << 4)))
#define SBAR() __builtin_amdgcn_sched_barrier(0)
__device__ __forceinline__ int v_st(int k, int c) { const int kk = (k & ~0xC) | ((k & 4) << 1) | ((k & 8) >> 1); return ((kk >> 3) * 4 + (c >> 5)) * 512 + ((kk & 7) * 32 + (c & 31)) * 2; }
__device__ __forceinline__ int v_rd_base(int lane) { return ((lane & 3) << 3) | (((lane >> 2) & 3) << 6) | (((lane >> 4) & 1) << 5) | (((lane >> 5) & 1) << 8); }
constexpr int v_rd_off(int d0, int ks, int half) { return d0 * 512 + ks * 4096 + half * 2048; }
__device__ __forceinline__ int crow(int r, int hi) { return (r & 3) + 8 * (r >> 2) + 4 * hi; }
__device__ __forceinline__ unsigned cvtpk(float lo, float hi) {
    unsigned r; asm volatile("v_cvt_pk_bf16_f32 %0, %1, %2" : "=v"(r) : "v"(lo), "v"(hi)); return r;
}
__device__ __forceinline__ bf16x8 pack8(f32x4 a, f32x4 b) {
    u32x4 w = {cvtpk(a[0], a[1]), cvtpk(a[2], a[3]), cvtpk(b[0], b[1]), cvtpk(b[2], b[3])};
    return *reinterpret_cast<bf16x8*>(&w);
}
template <class T> __device__ __forceinline__ bf16x8 load8(const T* p) {
    if constexpr (same_t<T, float>::v) { return pack8(*(const f32x4*)p, *(const f32x4*)(p + 4)); }
    else { return *reinterpret_cast<const bf16x8*>(p); }
}
__device__ __forceinline__ void mask_tile(f32x16& p0, f32x16& p1, int dq, unsigned W) {
    const float NEG = -__builtin_inff();
#pragma unroll
    for (int r = 0; r < 16; ++r) {
        const int c = (r & 3) + 8 * (r >> 2);
        if ((unsigned)(dq - c) >= W) p0[r] = NEG;
        if ((unsigned)(dq - c - 32) >= W) p1[r] = NEG;
    }
}
__device__ __forceinline__ void partialSM(f32x16& p0, f32x16& p1, float& m_reg, float& mn, float& alpha) {
    float pmax = p0[0]; for (int r = 1; r < 16; ++r) pmax = fmaxf(pmax, p0[r]); for (int r = 0; r < 16; ++r) pmax = fmaxf(pmax, p1[r]);
    { auto rr = __builtin_amdgcn_permlane32_swap(__float_as_uint(pmax), __float_as_uint(pmax), false, false);
      pmax = fmaxf(__uint_as_float(rr[0]), __uint_as_float(rr[1])); }
    constexpr float C2 = 1.4426950408889634f * SCALE;
    if (__builtin_expect(__all((pmax - m_reg) * SCALE <= THR), 1)) { mn = m_reg; alpha = 1.f; }
    else { mn = fmaxf(m_reg, pmax); alpha = __builtin_amdgcn_exp2f((m_reg - mn) * C2); m_reg = mn; }
    const float mnL = -mn * C2;
    for (int r = 0; r < 16; ++r) p0[r] = fmaf(p0[r], C2, mnL); for (int r = 0; r < 16; ++r) p1[r] = fmaf(p1[r], C2, mnL);
    for (int r = 0; r < 16; ++r) p0[r] = __builtin_amdgcn_exp2f(p0[r]);
}
__device__ __forceinline__ void finishSM(f32x16& p0, f32x16& p1, float alpha, float& l_reg, bf16x8& pa0, bf16x8& pa1, bf16x8& pa2, bf16x8& pa3) {
    for (int r = 0; r < 16; ++r) p1[r] = __builtin_amdgcn_exp2f(p1[r]);
    float ps = 0; for (int r = 0; r < 16; ++r) ps += p0[r]; for (int r = 0; r < 16; ++r) ps += p1[r];
    { auto rr = __builtin_amdgcn_permlane32_swap(__float_as_uint(ps), __float_as_uint(ps), false, false);
      ps = __uint_as_float(rr[0]) + __uint_as_float(rr[1]); }
    l_reg = l_reg * alpha + ps;
#define PK4(P, B_, OUT) do { unsigned a0 = cvtpk(P[B_+0], P[B_+1]), a1 = cvtpk(P[B_+2], P[B_+3]);                          \
        unsigned b0 = cvtpk(P[B_+4], P[B_+5]), b1 = cvtpk(P[B_+6], P[B_+7]);                                             \
        auto r0 = __builtin_amdgcn_permlane32_swap(a0, b0, false, false); auto r1 = __builtin_amdgcn_permlane32_swap(a1, b1, false, false); \
        u32x4 w = {r0[0], r1[0], r0[1], r1[1]}; OUT = *reinterpret_cast<bf16x8*>(&w); } while (0)
    PK4(p0, 0, pa0); PK4(p0, 8, pa1); PK4(p1, 0, pa2); PK4(p1, 8, pa3);
#undef PK4
}
template <int KB, bool SK>
__device__ __forceinline__ void qkt(f32x16& p0, f32x16& p1, const char* K_lds, int r32, int hi, const bf16x8* qr, bool act) {
    if (SK && !act) { const float NEG = -__builtin_inff();
#pragma unroll
        for (int r = 0; r < 16; ++r) { p0[r] = NEG; p1[r] = NEG; } return; }
    p0 = f32x16{}; p1 = f32x16{};
    const char* kb[4];
#pragma unroll
    for (int dd = 0; dd < 4; ++dd) kb[dd] = K_lds + KB * SHM_K + KSWZ(r32, (dd * 16 + hi * 8) * 2);
#pragma unroll
    for (int d0 = 0; d0 < 8; ++d0) { const char* a = kb[d0 & 3] + (d0 >> 2) * 128;
        bf16x8 b0 = *reinterpret_cast<const bf16x8*>(a);
        bf16x8 b1 = *reinterpret_cast<const bf16x8*>(a + 32 * 256);
        p0 = __builtin_amdgcn_mfma_f32_32x32x16_bf16(b0, qr[d0], p0, 0, 0, 0);
        p1 = __builtin_amdgcn_mfma_f32_32x32x16_bf16(b1, qr[d0], p1, 0, 0, 0); }
}
template <int VB, bool SK>
__device__ __forceinline__ void pv_tile(f32x16* o, int vb0, bf16x8 pa0, bf16x8 pa1, bf16x8 pa2, bf16x8 pa3, bool act) {
    if (SK && !act) return;
#define TRRD(dst, off) asm volatile("ds_read_b64_tr_b16 %0, %1 offset:%2" : "=&v"(dst) : "v"(vb0), "i"(off) : "memory")
#define PV_D0(d0) do { s16x4 l0, l1, l2, l3, h0, h1, h2, h3; constexpr int b_ = VB * SHM_V + v_rd_off(d0, 0, 0);     \
        TRRD(l0, b_); TRRD(h0, b_ + 2048); TRRD(l1, b_ + 4096); TRRD(h1, b_ + 6144); TRRD(l2, b_ + 8192); TRRD(h2, b_ + 10240); TRRD(l3, b_ + 12288); TRRD(h3, b_ + 14336); \
        asm volatile("s_waitcnt lgkmcnt(0)" ::: "memory"); SBAR();                 \
        o[d0] = __builtin_amdgcn_mfma_f32_32x32x16_bf16(pa0, (bf16x8){l0[0], l0[1], l0[2], l0[3], h0[0], h0[1], h0[2], h0[3]}, o[d0], 0, 0, 0);   \
        o[d0] = __builtin_amdgcn_mfma_f32_32x32x16_bf16(pa1, (bf16x8){l1[0], l1[1], l1[2], l1[3], h1[0], h1[1], h1[2], h1[3]}, o[d0], 0, 0, 0);   \
        o[d0] = __builtin_amdgcn_mfma_f32_32x32x16_bf16(pa2, (bf16x8){l2[0], l2[1], l2[2], l2[3], h2[0], h2[1], h2[2], h2[3]}, o[d0], 0, 0, 0);   \
        o[d0] = __builtin_amdgcn_mfma_f32_32x32x16_bf16(pa3, (bf16x8){l3[0], l3[1], l3[2], l3[3], h3[0], h3[1], h3[2], h3[3]}, o[d0], 0, 0, 0); } while (0)
    PV_D0(0); PV_D0(1); PV_D0(2); PV_D0(3);
#undef PV_D0
#undef TRRD
}


template <int NB>
__device__ __forceinline__ void o_rows_store(const f32x16* o, const float (&rl)[16], char* stg, bf16* Ow, const int ldo, const int col0, const int r32, const int hi, const int lane) {
    constexpr int PITCH = NB * 64, CPR = PITCH / 16;
#pragma unroll
    for (int r = 0; r < 16; ++r) { char* rp = stg + crow(r, hi) * PITCH + r32 * 2;
#pragma unroll
        for (int b = 0; b < NB; ++b) { const float v = o[b][r] * rl[r]; *(unsigned short*)(rp + b * 64) = (unsigned short)cvtpk(v, v); } }
    asm volatile("s_waitcnt lgkmcnt(0)" ::: "memory");
#pragma unroll
    for (int k = 0; k < 2 * NB; ++k) { const int c = lane + 64 * k, row = c / CPR, ch = c % CPR;
        const u32x4 w = *(const u32x4*)(stg + c * 16);
        *(u32x4*)(Ow + (size_t)row * ldo + col0 + ch * 8) = w; }
}
template <class TIn, class TOut> struct BlockRef { unsigned qoff, koff, voff, ooff, coff; int P0; int ldo; int boff; int jlo; };
template <class TIn, class TOut> struct Bases { const TIn* qkv; TOut* o; const float* c; };
template <class TIn> struct Seam {
    bf16x8 qr[8];
    bf16x8 st_v0, st_v1, st_k0, st_k1; f32x4 sf0, sf1, sf2, sf3;
    f32x4 tq[16];
    float st_b;
};
__device__ __forceinline__ int swa_jlo(int P0, int W) { const int lowk = P0 - W + 1; return lowk > 0 ? lowk / KVBLK : 0; }
#define ROW(p, k0, rr) ((p) + (size_t)((k0) + (rr)) * D + sc)
#define VMW() asm volatile("s_waitcnt vmcnt(0)" ::: "memory")
#define VMWN(n) asm volatile("s_waitcnt vmcnt(%0)" :: "i"(n) : "memory")
#define SLOAD_H(Kp, Vp, Cp, k0) do { S.st_v0 = load8<TIn>(ROW(Vp, k0, sr)); S.st_v1 = load8<TIn>(ROW(Vp, k0, 32 + sr));              \
                         S.st_k0 = load8<TIn>(ROW(Kp, k0, sr)); S.st_k1 = load8<TIn>(ROW(Kp, k0, 32 + sr));                       \
                         if constexpr (MODE == 1) { if (tid < 64) S.st_b = (Cp)[(k0) + tid]; } } while (0)
#define SWRITE_HK(bf, cref) do { *(bf16x8*)(K_lds + (bf) * SHM_K + kws) = S.st_k0; *(bf16x8*)(K_lds + (bf) * SHM_K + kws + 32 * 256) = S.st_k1; \
                         if constexpr (MODE == 1) { if (tid < 64) bias_l[(bf) * 64 + tid] = ((cref) - S.st_b) * RSCALE; } } while (0)
#define SWRITE_HV(bf) do { *(bf16x8*)(V_lds + (bf) * SHM_V + vst0) = S.st_v0; *(bf16x8*)(V_lds + (bf) * SHM_V + vst1) = S.st_v1; } while (0)
#define SWRITE_H(bf, cref) do { SWRITE_HV(bf); SWRITE_HK(bf, cref); } while (0)
#define BIASADD(P0_, P1_, kb) do { if constexpr (MODE == 1) { const float* bp_ = bias_l + (kb) * 64 + 4 * hi;                    \
        _Pragma("unroll") for (int g_ = 0; g_ < 4; ++g_) { const f32x4 b0_ = *(const f32x4*)(bp_ + 8 * g_), b1_ = *(const f32x4*)(bp_ + 32 + 8 * g_); \
            _Pragma("unroll") for (int e_ = 0; e_ < 4; ++e_) { P0_[4 * g_ + e_] += b0_[e_]; P1_[4 * g_ + e_] += b1_[e_]; } } } } while (0)
#define PADMASK(P0_, P1_) do { const float NEG_ = -__builtin_inff(); _Pragma("unroll") for (int r_ = 0; r_ < 16; ++r_) { if (r_ >= 8) P0_[r_] = NEG_; P1_[r_] = NEG_; } } while (0)
#define SLOAD_F(p, k0) do { S.sf0 = *(const f32x4*)ROW(p, k0, sr); S.sf1 = *(const f32x4*)(ROW(p, k0, sr) + 4);                \
                            S.sf2 = *(const f32x4*)ROW(p, k0, 32 + sr); S.sf3 = *(const f32x4*)(ROW(p, k0, 32 + sr) + 4); } while (0)
#define SWRITE_KF(bf) do { *(bf16x8*)(K_lds + (bf) * SHM_K + kws) = pack8(S.sf0, S.sf1); *(bf16x8*)(K_lds + (bf) * SHM_K + kws + 32 * 256) = pack8(S.sf2, S.sf3); } while (0)
#define SWRITE_VF(bf) do { *(bf16x8*)(V_lds + (bf) * SHM_V + vst0) = pack8(S.sf0, S.sf1); *(bf16x8*)(V_lds + (bf) * SHM_V + vst1) = pack8(S.sf2, S.sf3); } while (0)
template <class TIn, class TOut, int MODE  , class Ref>
__device__ __forceinline__ void causal_swa_prime(const Ref& cur, const Bases<TIn, TOut>& B, int W, char* lds, Seam<TIn>& S, const int wv) {
    constexpr bool F32 = same_t<TIn, float>::v;
    const int tid = fresh_tid(wv), wid = wv, lane = tid & 63, r32 = lane & 31, hi = lane >> 5;
    const int sr = tid >> 4, sc = (tid & 15) * 8, kws = KSWZ(sr, sc * 2); char* K_lds = lds + 2 * SHM_V; float* bias_l = (float*)(lds + LDS_BIAS);
    float cref_cur = 0.f; if constexpr (MODE == 1) cref_cur = __uint_as_float(__builtin_amdgcn_readfirstlane(__float_as_uint(((const float*)(lds + cur.boff()))[(cur.P0() - 64) >> 7] + (B.c + cur.coff())[cur.P0()])));
    const int kb0 = cur.jlo() * KVBLK;
    if constexpr (MODE == 1) { if (kb0 >= 64) cref_cur -= __uint_as_float(__builtin_amdgcn_readfirstlane(__float_as_uint(((const float*)(lds + cur.boff()))[(kb0 - 64) >> 7]))); }
    for (int d0 = 0; d0 < 8; ++d0) S.qr[d0] = load8<TIn>(B.qkv + cur.qoff() + (size_t)(wid * QBLK + r32) * D + d0 * 16 + hi * 8);
    if constexpr (F32) { SLOAD_F((const float*)(B.qkv + cur.koff()), kb0); VMW(); SWRITE_KF(0); SBAR(); SLOAD_F((const float*)(B.qkv + cur.voff()), kb0); }
    else { SLOAD_H(B.qkv + cur.koff(), B.qkv + cur.voff(), B.c + cur.coff(), kb0); VMW(); SWRITE_HK(0, cref_cur); }
    __syncthreads();
}
template <class TIn, class TOut, int MODE, class Ref, class NxtFn>
__device__ __forceinline__ void causal_swa_block(const Ref& cur, NxtFn& nxtfn, const Bases<TIn, TOut>& B, int skv, int W, char* lds, Seam<TIn>& S, const int wv) {
    constexpr bool F32 = same_t<TIn, float>::v;
    const int tid = fresh_tid(wv), wid = wv, lane = tid & 63, r32 = lane & 31, hi = lane >> 5;
    const int j_lo = cur.jlo();
    int j_hi = (cur.P0() + QB - 1) / KVBLK + 1; if (j_hi > skv / KVBLK) j_hi = skv / KVBLK;
    const int NT = j_hi - j_lo;
    const int qlo_r = cur.P0() + wid * QBLK, qlo = (MODE == 0) ? (qlo_r | 63) : qlo_r, qm = (MODE == 0) ? (qlo - 4 * hi) : (qlo_r + r32 - 4 * hi);
    char* V_lds = lds; char* K_lds = lds + 2 * SHM_V; float* bias_l = (float*)(lds + LDS_BIAS);
    const float* base_l = (const float*)(lds + cur.boff());
    float cref_cur = 0.f; if constexpr (MODE == 1) { cref_cur = __uint_as_float(__builtin_amdgcn_readfirstlane(__float_as_uint(base_l[(cur.P0() - 64) >> 7] + (B.c + cur.coff())[cur.P0()]))); }
    const float* Ch = B.c + cur.coff();
#define CADJ(k0) ((MODE == 1) ? (cref_cur - (((k0) >= 64) ? __uint_as_float(__builtin_amdgcn_readfirstlane(__float_as_uint(base_l[((k0) - 64) >> 7]))) : 0.f)) : 0.f)
    float* ws = (float*)(lds + 2 * SHM_V + 2 * SHM_K) + wid * 64; float* li_l = ws, * al_l = ws + 32;
    float m_reg = -1e30f, l_reg = 0; f32x16 o[4] = {};
    const int sr = tid >> 4, sc = (tid & 15) * 8, vst0 = v_st(sr, sc), vst1 = v_st(32 + sr, sc), kws = KSWZ(sr, sc * 2);
    const int vb0 = (int)(uintptr_t)V_lds + v_rd_base(lane);
    const TIn* Kh = B.qkv + cur.koff(); const TIn* Vh = B.qkv + cur.voff();
#define RESC(a) do { if (__any((a) < 1.f)) { if (hi == 0) al_l[r32] = (a); asm volatile("s_waitcnt lgkmcnt(0)" ::: "memory");              \
                     for (int d_ = 0; d_ < 4; ++d_) for (int r = 0; r < 16; ++r) o[d_][r] *= al_l[crow(r, hi)]; } } while (0)
#define KBASE(t) ((j_lo + (t)) * KVBLK)
#define ACT(t) (KBASE(t) <= qlo + QBLK - 1 && KBASE(t) + KVBLK - 1 >= qlo - W + 1)
#define MASKT(P0_, P1_, t) do { const int kb_ = KBASE(t); if ((!SK || ACT(t)) && (kb_ + KVBLK - 1 > qlo || kb_ <= qlo + QBLK - 1 - W)) mask_tile(P0_, P1_, qm - kb_, (unsigned)W); } while (0)
    constexpr int NQL = F32 ? 16 : 8;
    constexpr bool SK = WSKIP && !F32;
#define SEAM_K0() do { VMWN(NQL); if constexpr (F32) { SWRITE_KF(0); SBAR(); SLOAD_F((const float*)(B.qkv + nxt.voff()), kbn); } else { SWRITE_HK(0, cref_nxt); } SBAR(); } while (0)
    f32x16 pA0, pA1, pB0, pB1; float mnA, mnB, alA, alB; bf16x8 pa0, pa1, pa2, pa3;
    if constexpr (F32) { VMW(); SWRITE_VF(0); SBAR(); } else { SWRITE_HV(0); SBAR(); }
    if (NT > 1) { if constexpr (F32) SLOAD_F((const float*)Kh, KBASE(1)); else SLOAD_H(Kh, Vh, Ch, KBASE(1)); }
    SBAR(); qkt<0, SK>(pA0, pA1, K_lds, r32, hi, S.qr, ACT(0));
    if constexpr (F32) { if (NT > 1) { VMW(); SWRITE_KF(1); SBAR(); SLOAD_F((const float*)Vh, KBASE(1)); } }
    BIASADD(pA0, pA1, 0); if (j_lo == 0) PADMASK(pA0, pA1); MASKT(pA0, pA1, 0); partialSM(pA0, pA1, m_reg, mnA, alA);
    if (NT > 1) { VMW(); if constexpr (F32) { SWRITE_VF(1); SBAR(); if (NT > 2) SLOAD_F((const float*)Kh, KBASE(2)); } else SWRITE_H(1, CADJ(KBASE(1))); }
    __syncthreads();
#define HALF_STEP(PX0, PX1, mnX, alX, PY0, PY1, alY, t, KB, VB, SB) do {                                                      \
        SBAR(); qkt<KB, SK>(PX0, PX1, K_lds, r32, hi, S.qr, ACT(t));                                             \
        finishSM(PY0, PY1, alY, l_reg, pa0, pa1, pa2, pa3); SBAR();                                                           \
        if ((t) + 1 < NT) { if constexpr (F32) { VMW(); SWRITE_KF(SB); SBAR(); SLOAD_F((const float*)Vh, KBASE((t) + 1)); }  \
                            else { SLOAD_H(Kh, Vh, Ch, KBASE((t) + 1)); } SBAR(); }                                               \
        pv_tile<VB, SK>(o, vb0, pa0, pa1, pa2, pa3, ACT((t) - 1)); BIASADD(PX0, PX1, KB); MASKT(PX0, PX1, (t)); partialSM(PX0, PX1, m_reg, mnX, alX);                                        \
        __syncthreads();                                                                                                      \
        if ((t) + 1 < NT) { VMW(); if constexpr (F32) { SWRITE_VF(SB); SBAR(); if ((t) + 2 < NT) SLOAD_F((const float*)Kh, KBASE((t) + 2)); } \
                            else { SWRITE_H(SB, CADJ(KBASE((t) + 1))); } }                                                                          \
        RESC(alX); __syncthreads(); } while (0)
    for (int t = 1; t + 1 < NT; t += 2) {
        nxtfn.early(t, NT);
        HALF_STEP(pB0, pB1, mnB, alB, pA0, pA1, alA, t, 1, 0, 0);
        HALF_STEP(pA0, pA1, mnA, alA, pB0, pB1, alB, t + 1, 0, 1, 1);
    }
    const Ref nxt = nxtfn();
    const int kbn = nxt.jlo() * KVBLK;
    float cref_nxt = 0.f; if constexpr (MODE == 1) { const float* bn_ = (const float*)(lds + nxt.boff());
        cref_nxt = __uint_as_float(__builtin_amdgcn_readfirstlane(__float_as_uint(bn_[(nxt.P0() - 64) >> 7] + (B.c + nxt.coff())[nxt.P0()] - ((kbn >= 64) ? bn_[(kbn - 64) >> 7] : 0.f)))); }
    const bool even = (NT & 1) == 0;
    if (even) { SBAR(); qkt<1, SK>(pB0, pB1, K_lds, r32, hi, S.qr, ACT(NT - 1)); SBAR(); }
#define QROW(e) (B.qkv + nxt.qoff() + (size_t)(wid * QBLK + r32) * D + ((e) >> 1) * 16 + hi * 8 + ((e) & 1) * 4)
    if constexpr (F32) { SLOAD_F((const float*)(B.qkv + nxt.koff()), kbn); SBAR();
#pragma unroll
        for (int e = 0; e < 8; ++e) S.tq[e] = *(const f32x4*)QROW(e); }
    else { SLOAD_H(B.qkv + nxt.koff(), B.qkv + nxt.voff(), B.c + nxt.coff(), kbn); SBAR();
#pragma unroll
        for (int d0 = 0; d0 < 8; ++d0) S.qr[d0] = load8<TIn>(B.qkv + nxt.qoff() + (size_t)(wid * QBLK + r32) * D + d0 * 16 + hi * 8); }
    SBAR();
    finishSM(pA0, pA1, alA, l_reg, pa0, pa1, pa2, pa3); SBAR();
    if constexpr (F32) {
#pragma unroll
        for (int e = 8; e < 16; ++e) S.tq[e] = *(const f32x4*)QROW(e); SBAR(); }
#undef QROW
    pv_tile<0, SK>(o, vb0, pa0, pa1, pa2, pa3, ACT(even ? NT - 2 : NT - 1));
    if (even) { BIASADD(pB0, pB1, 1); MASKT(pB0, pB1, NT - 1); partialSM(pB0, pB1, m_reg, mnB, alB); __syncthreads(); RESC(alB);
        finishSM(pB0, pB1, alB, l_reg, pa0, pa1, pa2, pa3); SBAR(); pv_tile<1, SK>(o, vb0, pa0, pa1, pa2, pa3, ACT(NT - 1)); }
    SBAR(); SEAM_K0();
    if (hi == 0) li_l[r32] = l_reg; asm volatile("s_waitcnt lgkmcnt(0)" ::: "memory");
    float rli[16];
#pragma unroll
    for (int r = 0; r < 16; ++r) rli[r] = __builtin_amdgcn_rcpf(li_l[crow(r, hi)]);
    TOut* Ow = B.o + cur.ooff() + (size_t)(wid * QBLK) * cur.ldo(); const int ldo = cur.ldo();
    if constexpr (same_t<TOut, float>::v) {
#pragma unroll
        for (int r = 0; r < 16; ++r) { const int orow = crow(r, hi);
#pragma unroll
            for (int d0 = 0; d0 < 4; ++d0) Ow[(size_t)orow * ldo + d0 * 32 + r32] = o[d0][r] * rli[r]; }
    } else {
        char* stg = lds + LDS_OST + wid * 4096;
        o_rows_store<2>(o, rli, stg, (bf16*)Ow, ldo, 0, r32, hi, lane);
        o_rows_store<2>(o + 2, rli, stg, (bf16*)Ow, ldo, 64, r32, hi, lane);
    }
    if constexpr (F32) {
#pragma unroll
        for (int d0 = 0; d0 < 8; ++d0) S.qr[d0] = pack8(S.tq[2 * d0], S.tq[2 * d0 + 1]); }
    __syncthreads();
#undef RESC
#undef CADJ
#undef KBASE
#undef ACT
#undef MASKT
#undef SEAM_K0
#undef HALF_STEP
}
#undef ROW
#undef VMW
#undef VMWN
#undef SLOAD_H
#undef SWRITE_HK
#undef SWRITE_HV
#undef SWRITE_H
#undef SLOAD_F
#undef SWRITE_KF
#undef SWRITE_VF
#undef BIASADD
#undef PADMASK


__device__ __forceinline__ void pv256(f32x16* o, int vb0, bf16x8 pa0, bf16x8 pa1, bf16x8 pa2, bf16x8 pa3) {
#define TRRD(dst, off) asm volatile("ds_read_b64_tr_b16 %0, %1 offset:%2" : "=&v"(dst) : "v"(vb0), "i"(off) : "memory")
#define RD8(S, g) do { constexpr int b_ = ((g) >> 2) * SHM_V + v_rd_off((g) & 3, 0, 0);                                                                   \
        TRRD(S##l0, b_); TRRD(S##h0, b_ + 2048); TRRD(S##l1, b_ + 4096); TRRD(S##h1, b_ + 6144); TRRD(S##l2, b_ + 8192); TRRD(S##h2, b_ + 10240); TRRD(S##l3, b_ + 12288); TRRD(S##h3, b_ + 14336); } while (0)
#define MM4(S, g) do {                                                                                                                                     \
        o[g] = __builtin_amdgcn_mfma_f32_32x32x16_bf16(pa0, (bf16x8){S##l0[0], S##l0[1], S##l0[2], S##l0[3], S##h0[0], S##h0[1], S##h0[2], S##h0[3]}, o[g], 0, 0, 0); \
        o[g] = __builtin_amdgcn_mfma_f32_32x32x16_bf16(pa1, (bf16x8){S##l1[0], S##l1[1], S##l1[2], S##l1[3], S##h1[0], S##h1[1], S##h1[2], S##h1[3]}, o[g], 0, 0, 0); \
        o[g] = __builtin_amdgcn_mfma_f32_32x32x16_bf16(pa2, (bf16x8){S##l2[0], S##l2[1], S##l2[2], S##l2[3], S##h2[0], S##h2[1], S##h2[2], S##h2[3]}, o[g], 0, 0, 0); \
        o[g] = __builtin_amdgcn_mfma_f32_32x32x16_bf16(pa3, (bf16x8){S##l3[0], S##l3[1], S##l3[2], S##l3[3], S##h3[0], S##h3[1], S##h3[2], S##h3[3]}, o[g], 0, 0, 0); } while (0)
#define LW() do { asm volatile("s_waitcnt lgkmcnt(0)" ::: "memory"); SBAR(); } while (0)
    s16x4 Al0, Al1, Al2, Al3, Ah0, Ah1, Ah2, Ah3, Bl0, Bl1, Bl2, Bl3, Bh0, Bh1, Bh2, Bh3;
    RD8(A, 0);
    LW(); RD8(B, 1); SBAR(); MM4(A, 0); SBAR();
    LW(); RD8(A, 2); SBAR(); MM4(B, 1); SBAR();
    LW(); RD8(B, 3); SBAR(); MM4(A, 2); SBAR();
    LW(); RD8(A, 4); SBAR(); MM4(B, 3); SBAR();
    LW(); RD8(B, 5); SBAR(); MM4(A, 4); SBAR();
    LW(); RD8(A, 6); SBAR(); MM4(B, 5); SBAR();
    LW(); RD8(B, 7); SBAR(); MM4(A, 6); SBAR();
    LW(); MM4(B, 7);
#undef TRRD
#undef RD8
#undef MM4
#undef LW
}

__device__ __forceinline__ void qk64(f32x16& p0, f32x16& p1, const char* K_lds, const char* Q_w, int r32, int hi) {
    p0 = f32x16{}; p1 = f32x16{};
    int ka[4], qa[4];
#pragma unroll
    for (int dd = 0; dd < 4; ++dd) { const int off = KSWZ(r32, (dd * 16 + hi * 8) * 2); ka[dd] = (int)(uintptr_t)K_lds + off; qa[dd] = (int)(uintptr_t)Q_w + off; }
#define LDR(dst, addr, off) asm volatile("ds_read_b128 %0, %1 offset:%2" : "=&v"(dst) : "v"(addr), "i"(off) : "memory")
#define RDS(S, d0) do { LDR(S##q, qa[(d0) & 3], ((d0) >> 2) * 128); LDR(S##a, ka[(d0) & 3], ((d0) >> 2) * 128); LDR(S##b, ka[(d0) & 3], ((d0) >> 2) * 128 + 32 * 256); } while (0)
#define MMS(S) do { p0 = __builtin_amdgcn_mfma_f32_32x32x16_bf16(S##a, S##q, p0, 0, 0, 0); p1 = __builtin_amdgcn_mfma_f32_32x32x16_bf16(S##b, S##q, p1, 0, 0, 0); } while (0)
#define LWN(n) do { asm volatile("s_waitcnt lgkmcnt(" #n ")" ::: "memory"); SBAR(); } while (0)
    bf16x8 Aq, Aa, Ab, Bq, Ba, Bb;
    RDS(A, 0); RDS(B, 1);
    LWN(3); MMS(A); SBAR(); RDS(A, 2);
    LWN(3); MMS(B); SBAR(); RDS(B, 3);
    LWN(3); MMS(A); SBAR(); RDS(A, 4);
    LWN(3); MMS(B); SBAR(); RDS(B, 5);
    LWN(3); MMS(A); SBAR(); RDS(A, 6);
    LWN(3); MMS(B); SBAR(); RDS(B, 7);
    LWN(3); MMS(A); SBAR();
    LWN(0); MMS(B);
#undef LDR
#undef RDS
#undef MMS
#undef LWN
}
constexpr int DLDS_K = 2 * SHM_V, DLDS_Q = DLDS_K + SHM_K, DLDS_WS = DLDS_Q + NW * 8192, DLDS_BYTES = DLDS_WS + NW * 64 * 4;
struct DiffRef { unsigned qoff, koff, v0off, v1off, ooff; int qb; };
__device__ __forceinline__ void diff_block(const DiffRef& R, const bf16* qkv, bf16* obase, int ldo, char* lds, const int wv) {
    const int tid = fresh_tid(wv), wid = wv, lane = tid & 63, r32 = lane & 31, hi = lane >> 5;
    char* V_lds = lds; char* K_lds = lds + DLDS_K; char* Q_lds = lds + DLDS_Q + wid * 8192;
    float* ws = (float*)(lds + DLDS_WS) + wid * 64; float* li_l = ws, * al_l = ws + 32;
    const int NT = 4 * R.qb + 5, myNT = 4 * R.qb + 2 + (wid >> 1);
    const int sr = tid >> 4, sc = (tid & 15) * 8, vst0 = v_st(sr, sc), vst1 = v_st(32 + sr, sc), kws = KSWZ(sr, sc * 2);
    const int vb0 = (int)(uintptr_t)V_lds + v_rd_base(lane);
    const bf16* Kh = qkv + R.koff; const bf16* V0h = qkv + R.v0off; const bf16* V1h = qkv + R.v1off;
    const int qsw = KSWZ(r32, hi * 16);
#define QCH(d0) (KSWZ(r32, ((d0) * 16 + hi * 8) * 2))
    {
        const bf16* Qp = qkv + R.qoff + (size_t)(wid * QBLK + r32) * D + hi * 8; bf16x8 q[8];
#pragma unroll
        for (int d0 = 0; d0 < 8; ++d0) q[d0] = load8<bf16>(Qp + d0 * 16);
#pragma unroll
        for (int d0 = 0; d0 < 8; ++d0) *(bf16x8*)(Q_lds + QCH(d0)) = q[d0];
    }
    (void)qsw;
    bf16x8 sk0, sk1, sv0, sv1, sv2, sv3;
    const unsigned lo0 = (unsigned)(sr * D + sc), lo1 = lo0 + 32u * D;
#define DLOAD(k0) do { const bf16* kp_ = Kh + (size_t)(k0) * D; const bf16* v0_ = V0h + (size_t)(k0) * D; const bf16* v1_ = V1h + (size_t)(k0) * D;          \
                       sk0 = load8<bf16>(kp_ + lo0); sk1 = load8<bf16>(kp_ + lo1); sv0 = load8<bf16>(v0_ + lo0); sv1 = load8<bf16>(v0_ + lo1);           \
                       sv2 = load8<bf16>(v1_ + lo0); sv3 = load8<bf16>(v1_ + lo1); } while (0)
#define DWRITE() do { *(bf16x8*)(K_lds + kws) = sk0; *(bf16x8*)(K_lds + kws + 32 * 256) = sk1;                                                 \
                      *(bf16x8*)(V_lds + vst0) = sv0; *(bf16x8*)(V_lds + vst1) = sv1; *(bf16x8*)(V_lds + SHM_V + vst0) = sv2; *(bf16x8*)(V_lds + SHM_V + vst1) = sv3; } while (0)
    DLOAD(0);
    float m_reg = -1e30f, l_reg = 0; f32x16 o[8] = {};
#pragma unroll 1
    for (int t = 0; t < NT; ++t) {
        asm volatile("s_waitcnt vmcnt(0)" ::: "memory");
        __syncthreads();
        DWRITE();
        __syncthreads();
        if (t + 1 < NT) DLOAD((t + 1) * KVBLK);
        SBAR();
        if (t < myNT) {
            f32x16 p0, p1; float mn, al; bf16x8 pa0, pa1, pa2, pa3;
            qk64(p0, p1, K_lds, Q_lds, r32, hi);
            if (t == 0) { const float NEG_ = -__builtin_inff();
#pragma unroll
                for (int r_ = 0; r_ < 16; ++r_) { if (r_ >= 8) p0[r_] = NEG_; p1[r_] = NEG_; } }
            partialSM(p0, p1, m_reg, mn, al);
            finishSM(p0, p1, al, l_reg, pa0, pa1, pa2, pa3);
            if (__any(al < 1.f)) { if (hi == 0) al_l[r32] = al; asm volatile("s_waitcnt lgkmcnt(0)" ::: "memory");
#pragma unroll
                for (int d_ = 0; d_ < 8; ++d_)
#pragma unroll
                    for (int r = 0; r < 16; ++r) o[d_][r] *= al_l[crow(r, hi)]; }
            SBAR();
            pv256(o, vb0, pa0, pa1, pa2, pa3);
        }
    }
    if (hi == 0) li_l[r32] = l_reg; asm volatile("s_waitcnt lgkmcnt(0)" ::: "memory");
    bf16* Ow = obase + R.ooff + (size_t)(wid * QBLK) * ldo;
    float rl[16];
#pragma unroll
    for (int r = 0; r < 16; ++r) rl[r] = __builtin_amdgcn_rcpf(li_l[crow(r, hi)]);
    o_rows_store<4>(o, rl, Q_lds, Ow, ldo, 0, r32, hi, lane);
    o_rows_store<4>(o + 4, rl, Q_lds, Ow, ldo, 128, r32, hi, lane);
#undef QCH
#undef DLOAD
#undef DWRITE
}

}


constexpr int NWAVES = 8;
constexpr int NB = 2, T = 8192, DM = 4096, NMETA = 16, LSEQ = NMETA + T;
constexpr int MR = NB * T;
constexpr int KVR = 64 + T;
constexpr int NPROJ = 12288, INW = 12304, FFW = 16384, NGRP = 96;
constexpr int NFH = 16;
constexpr float LN_EPS = 1e-5f, SUBLN_EPS = 1e-5f;
constexpr float DN_ALPHA = 1.189207115002721f;
constexpr float LAMBDA_INIT = 0.2f;

constexpr size_t MiB = 1u << 20;
constexpr size_t WS_CTL = 0, CTL_ZERO_BYTES = 1 * MiB;
constexpr size_t WS_STATS0 = 1 * MiB, WS_STATS1 = WS_STATS0 + 131072, WS_HMETA = WS_STATS1 + 131072, WS_WFF = WS_HMETA + 131072;
constexpr size_t WS_ZF = 2 * MiB;
constexpr size_t WS_CUMS = 4 * MiB;
constexpr size_t WS_ROPE = 6 * MiB;
constexpr size_t WS_WUP = 16 * MiB, WS_WDN = 144 * MiB, WS_WOUT = 272 * MiB, WS_WIN = 304 * MiB;
constexpr size_t WS_H0B = 400 * MiB;
constexpr size_t WS_QKV = 528 * MiB;
constexpr size_t WS_PART0 = 304 * MiB, WS_PART1 = 915 * MiB;
constexpr size_t WS_H1B = 304 * MiB;
constexpr size_t WS_ACT = 432 * MiB;
constexpr size_t WS_RPART = 980 * MiB;
constexpr size_t WS_UPART = 988 * MiB, WS_CPART = 992 * MiB;
constexpr size_t WS_UCOL = 996 * MiB, WS_CCOL = WS_UCOL + 65536;
constexpr size_t WS_END = 997 * MiB;
static_assert(WS_ZF + (size_t)NB * KVR * 16 * 4 <= WS_CUMS && WS_CUMS + (size_t)NB * 16 * KVR * 4 <= WS_ROPE && WS_ROPE + (size_t)2 * LSEQ * 64 * 4 <= WS_WUP, "small regions");
static_assert(WS_QKV + (size_t)NGRP * NB * KVR * 128 * 2 <= WS_PART1 && WS_PART1 + (size_t)MR * 2048 * 2 <= WS_END && WS_ACT + (size_t)MR * FFW * 2 <= WS_END, "big regions");
static_assert(WS_H1B + (size_t)MR * DM * 2 <= WS_ACT && WS_WIN + (size_t)NPROJ * DM * 2 <= WS_H0B && WS_PART0 + (size_t)MR * 2048 * 2 <= WS_H0B, "overlays");
constexpr int CW_TMO = 0, CW_CODE = 1;
constexpr int CW_BAR = 4096;
constexpr int CW_QUEUE = 64, CW_QUEUE2 = 128, CW_QUEUE3 = 1024;
constexpr int CW_UC = 13312;
constexpr int CW_GRP = 12800;
constexpr int CW_NRM = 8192;

constexpr int RING_OFF = 0, RING_BYTES = 131072;
constexpr int LDSCTL_OFF = RING_BYTES, MISC_OFF = LDSCTL_OFF + 320;
constexpr int LDS_BYTES = 147456;
static_assert(MISC_OFF + 128 <= LDS_BYTES, "LDS map");
static_assert(att::LDS_BYTES <= RING_BYTES && att::DLDS_BYTES <= RING_BYTES, "attention LDS");

#define GAS __attribute__((address_space(1)))
#define LAS __attribute__((address_space(3)))
typedef unsigned short bf16;
typedef unsigned v4u __attribute__((ext_vector_type(4)));
typedef float f32x4 __attribute__((ext_vector_type(4)));
typedef short bf16x8 __attribute__((ext_vector_type(8)));
typedef GAS unsigned gu32;
typedef GAS unsigned long long gu64;
#define RLX_AGENT __ATOMIC_RELAXED, __HIP_MEMORY_SCOPE_AGENT
#define LDS_WAIT() asm volatile("s_waitcnt lgkmcnt(0)" ::: "memory")
#define VM_WAIT() asm volatile("s_waitcnt vmcnt(0)" ::: "memory")
__device__ __forceinline__ unsigned long long rt() { return __builtin_amdgcn_s_memrealtime(); }
__device__ __forceinline__ unsigned f2bf(float f) { unsigned u = __builtin_bit_cast(unsigned, f); return (u + 0x7fffu + ((u >> 16) & 1u)) >> 16; }
__device__ __forceinline__ unsigned pk2(float lo, float hi) { return f2bf(lo) | (f2bf(hi) << 16); }

#define XB_TMO      128
#define XB_XCNT(j)  (256  + 64 * (j))
#define XB_XSUB(j)  (1280 + 64 * (j))
#define XB_XGEN(j)  (2304 + 64 * (j))
#define XB_TOP      3328
#define XB_TOPGEN   3392
#define XCD_BAR_WORDS 3456
#define XB_SPIN_CAP (1u << 18)

__device__ __forceinline__ unsigned xb_ld(unsigned* p)              { return __hip_atomic_load(p, __ATOMIC_RELAXED, __HIP_MEMORY_SCOPE_AGENT); }
__device__ __forceinline__ unsigned xb_add(unsigned* p, unsigned v) { return __hip_atomic_fetch_add(p, v, __ATOMIC_RELAXED, __HIP_MEMORY_SCOPE_AGENT); }
__device__ __forceinline__ unsigned xb_xcc_id() { return (unsigned)__builtin_amdgcn_s_getreg((3 << 11) | 20) & 0xFu; }
#define XB_SPIN(cond, bar) do { unsigned _sp = 0; while (cond) { __builtin_amdgcn_s_sleep(1); \
    if ((++_sp & 255u) == 0u) { if (xb_ld(&(bar)[XB_TMO])) break; if (_sp > XB_SPIN_CAP) { atomicAdd(&(bar)[XB_TMO], 1u); break; } } } } while (0)

struct XcdBarrier {
    unsigned* bar; unsigned x;
    volatile LAS unsigned* st;
};

__device__ __forceinline__ XcdBarrier xcd_barrier_post(unsigned* bar, volatile LAS unsigned* st, const bool t0  ) {
    XcdBarrier b; b.bar = bar; b.x = xb_xcc_id(); b.st = st;
    if (t0) (void)xb_add(&bar[XB_XCNT(b.x)], 1u);
    return b;
}
__device__ __forceinline__ void xcd_barrier_complete(unsigned* bar, unsigned x, unsigned& nloc, unsigned& nx) {
    const unsigned G = gridDim.x * gridDim.y * gridDim.z;
    unsigned sum, cnt, mine, sp = 0u;
    for (;;) {
        sum = 0u; cnt = 0u; mine = 0u;
#pragma unroll
        for (unsigned j = 0; j < 16; ++j) { const unsigned c = xb_ld(&bar[XB_XCNT(j)]); sum += c; cnt += (c > 0u) ? 1u : 0u; mine = (j == x) ? c : mine; }
        if (sum == G) break;
        __builtin_amdgcn_s_sleep(1);
        if ((++sp & 255u) == 0u) { if (xb_ld(&bar[XB_TMO])) break; if (sp > XB_SPIN_CAP) { atomicAdd(&bar[XB_TMO], 1u); break; } }
    }
    nloc = mine > 0u ? mine : 1u; nx = cnt > 0u ? cnt : 1u;
}

__device__ __forceinline__ void xcd_barrier(const XcdBarrier& b, const bool t0  ) {
    asm volatile("s_waitcnt vmcnt(0)" ::: "memory");
    __syncthreads();
    if (t0) {
        unsigned* bar = b.bar;
        __builtin_amdgcn_s_waitcnt(0);
        unsigned nloc = b.st[0], nx = b.st[1];
        if (nloc == 0u) { xcd_barrier_complete(bar, b.x, nloc, nx); b.st[0] = nloc; b.st[1] = nx; }
        const unsigned old = xb_add(&bar[XB_XSUB(b.x)], 1u);
        const unsigned gen = old / nloc;
        if (old + 1u == (gen + 1u) * nloc) {
            __builtin_amdgcn_fence(__ATOMIC_RELEASE, "agent");
            asm volatile("s_waitcnt vmcnt(0)" ::: "memory");
            const unsigned og = xb_add(&bar[XB_TOP], 1u);
            const unsigned tg = og / nx;
            if (og + 1u == (tg + 1u) * nx) xb_add(&bar[XB_TOPGEN], 1u);
            else XB_SPIN(xb_ld(&bar[XB_TOPGEN]) == tg, bar);
            __builtin_amdgcn_fence(__ATOMIC_ACQUIRE, "agent");
            xb_add(&bar[XB_XGEN(b.x)], 1u);
            asm volatile("s_waitcnt vmcnt(0)" ::: "memory");
        } else {
            XB_SPIN(xb_ld(&bar[XB_XGEN(b.x)]) == gen, bar);
            __builtin_amdgcn_fence(__ATOMIC_ACQUIRE, "agent");
            asm volatile("s_waitcnt vmcnt(0)" ::: "memory");
        }
    }
    __syncthreads();
}


__device__ __forceinline__ float lane_xor(float v, int k, int lane) { return __builtin_bit_cast(float, __builtin_amdgcn_ds_bpermute((lane ^ k) << 2, __builtin_bit_cast(int, v))); }
__device__ __forceinline__ float lane_up(float v, int o, int lane) { return __builtin_bit_cast(float, __builtin_amdgcn_ds_bpermute(((lane - o) & 63) << 2, __builtin_bit_cast(int, v))); }
__device__ __forceinline__ float wave_sum(float v, int lane) {
#pragma unroll
    for (int o = 1; o < 64; o <<= 1) v += lane_xor(v, o, lane);
    return v;
}
__device__ __forceinline__ float bf2f(unsigned h) { return __builtin_bit_cast(float, h << 16); }
__device__ __forceinline__ float log_sigmoid(float z) { return fminf(z, 0.f) - log1pf(expf(-fabsf(z))); }

__device__ __forceinline__ int p0_rowmap(int n, int mode) {
    if (mode == 1) return n < 4096 ? ((n & ~192) | ((n & 64) << 1) | ((n & 128) >> 1)) : n;
    if (mode == 2) return n - NPROJ;
    return n;
}
__device__ __forceinline__ void p0_transpose_item(const float* W, int ldw, int K, bf16* WT, LAS float* scr, int k0, int n0, int nvalid, int mode, int lane) {
    const int n4 = (lane & 7) * 4;
#pragma unroll
    for (int i = 0; i < 8; ++i) { const int kk = 8 * i + (lane >> 3); f32x4 v = {0.f, 0.f, 0.f, 0.f}; if (n4 < nvalid) v = *(const GAS f32x4*)(W + (size_t)(k0 + kk) * ldw + n0 + n4);
        LAS float* d = scr + kk * 33 + n4; d[0] = v.x; d[1] = v.y; d[2] = v.z; d[3] = v.w; }
    LDS_WAIT(); asm volatile("" ::: "memory");
    const int c = lane & 7;
#pragma unroll
    for (int j = 0; j < 4; ++j) { const int n = (lane >> 3) + 8 * j; const LAS float* s = scr + (8 * c) * 33 + n;
        v4u o; o.x = pk2(s[0 * 33], s[1 * 33]); o.y = pk2(s[2 * 33], s[3 * 33]); o.z = pk2(s[4 * 33], s[5 * 33]); o.w = pk2(s[6 * 33], s[7 * 33]);
        if (n < nvalid) *(GAS v4u*)(WT + (size_t)p0_rowmap(n0 + n, mode) * K + k0 + 8 * c) = o; }
    LDS_WAIT(); asm volatile("" ::: "memory");
}
__device__ __forceinline__ void ln_row(const float* src, const float* g, const float* bta, int lane, float* dstf, bf16* dstb, float* stats) {
    const GAS f32x4* xr = (const GAS f32x4*)src + lane;
    f32x4 v[16]; float s = 0.f;
#pragma unroll
    for (int j = 0; j < 16; ++j) { v[j] = xr[64 * j]; s += (v[j].x + v[j].y) + (v[j].z + v[j].w); }
    const float mean = wave_sum(s, lane) * (1.f / DM); float s2 = 0.f;
#pragma unroll
    for (int j = 0; j < 16; ++j) { v[j] = v[j] - mean; s2 += (v[j].x * v[j].x + v[j].y * v[j].y) + (v[j].z * v[j].z + v[j].w * v[j].w); }
    const float rstd = 1.f / sqrtf(wave_sum(s2, lane) * (1.f / DM) + LN_EPS);
    if (stats && lane == 0) { stats[0] = mean; stats[1] = rstd; }
    const GAS f32x4* g4 = (const GAS f32x4*)g + lane; const GAS f32x4* b4 = (const GAS f32x4*)bta + lane;
#pragma unroll
    for (int j = 0; j < 16; ++j) { const f32x4 o = v[j] * rstd * g4[64 * j] + b4[64 * j];
        if (dstf) ((GAS f32x4*)dstf + lane)[64 * j] = o;
        if (dstb) ((GAS unsigned long long*)dstb + lane)[64 * j] = (unsigned long long)pk2(o.x, o.y) | ((unsigned long long)pk2(o.z, o.w) << 32); }
}
template <int R> __device__ __forceinline__ void ln_rows(const float* src, size_t rstride, const float* g, const float* bta, int lane, float* dstf, bf16* dstb, float* stats, size_t sstride) {
    f32x4 v[R][16]; float s[R];
#pragma unroll
    for (int r = 0; r < R; ++r) { const GAS f32x4* xr = (const GAS f32x4*)(src + r * rstride) + lane; s[r] = 0.f;
#pragma unroll
        for (int j = 0; j < 16; ++j) { v[r][j] = xr[64 * j]; s[r] += (v[r][j].x + v[r][j].y) + (v[r][j].z + v[r][j].w); } }
    float rstd[R];
#pragma unroll
    for (int r = 0; r < R; ++r) { const float mean = wave_sum(s[r], lane) * (1.f / DM); float s2 = 0.f;
#pragma unroll
        for (int j = 0; j < 16; ++j) { v[r][j] = v[r][j] - mean; s2 += (v[r][j].x * v[r][j].x + v[r][j].y * v[r][j].y) + (v[r][j].z * v[r][j].z + v[r][j].w * v[r][j].w); }
        rstd[r] = 1.f / sqrtf(wave_sum(s2, lane) * (1.f / DM) + LN_EPS);
        if (stats && lane == 0) { stats[r * sstride] = mean; stats[r * sstride + 1] = rstd[r]; } }
    const GAS f32x4* g4 = (const GAS f32x4*)g + lane; const GAS f32x4* b4 = (const GAS f32x4*)bta + lane;
#pragma unroll
    for (int j = 0; j < 16; ++j) { const f32x4 gv = g4[64 * j], bv = b4[64 * j];
#pragma unroll
        for (int r = 0; r < R; ++r) { const f32x4 o = v[r][j] * rstd[r] * gv + bv;
            if (dstf) ((GAS f32x4*)(dstf + r * rstride) + lane)[64 * j] = o;
            if (dstb) ((GAS unsigned long long*)(dstb + r * rstride) + lane)[64 * j] = (unsigned long long)pk2(o.x, o.y) | ((unsigned long long)pk2(o.z, o.w) << 32); } }
}
__device__ __forceinline__ void late_conv_decode(int it, const float* w_out, const float* w_up, const float* w_down, bf16* Wout, bf16* Wup, bf16* Wdn,
                                                 const float*& W, int& ldw, int& K, bf16*& WT, int& k0, int& n0) {
    constexpr int I_OUT = 64 * 128, I_UP = 64 * 512;
    if (it < I_OUT) { W = w_out; ldw = DM; K = DM; WT = Wout; k0 = 64 * (it / 128); n0 = 32 * (it % 128); return; } it -= I_OUT;
    if (it < I_UP) { W = w_up; ldw = FFW; K = DM; WT = Wup; k0 = 64 * (it / 512); n0 = 32 * (it % 512); return; } it -= I_UP;
    W = w_down; ldw = DM; K = FFW; WT = Wdn; k0 = 64 * (it / 128); n0 = 32 * (it % 128);
}
__device__ __forceinline__ void late_weight_conv(const float* w_out, const float* w_up, const float* w_down, bf16* Wout, bf16* Wup, bf16* Wdn, LAS float* scr, int gw, int lane, const float* g1, const float* b1, float* upart, float* cpart) {
    constexpr int NIT = 64 * 128 + 64 * 512 + 256 * 128, NGW_ = 256 * NWAVES; static_assert(NIT % (4 * NGW_) == 0, "whole batches of four items per wave");
    const int n4 = (lane & 7) * 4, c = lane & 7;
#pragma unroll 1
    for (int it0 = gw; it0 < NIT; it0 += 4 * NGW_) {
        f32x4 v[4][8];
#pragma unroll
        for (int j = 0; j < 4; ++j) { const float* W; int ldw, K, k0, n0; bf16* WT; late_conv_decode(it0 + j * NGW_, w_out, w_up, w_down, Wout, Wup, Wdn, W, ldw, K, WT, k0, n0);
#pragma unroll
            for (int i = 0; i < 8; ++i) v[j][i] = *(const GAS f32x4*)(W + (size_t)(k0 + 8 * i + (lane >> 3)) * ldw + n0 + n4); }
#pragma unroll
        for (int j = 0; j < 4; ++j) { const float* W; int ldw, K, k0, n0; bf16* WT; late_conv_decode(it0 + j * NGW_, w_out, w_up, w_down, Wout, Wup, Wdn, W, ldw, K, WT, k0, n0);
#pragma unroll
            for (int i = 0; i < 8; ++i) { LAS float* d = scr + (8 * i + (lane >> 3)) * 33 + n4; d[0] = v[j][i].x; d[1] = v[j][i].y; d[2] = v[j][i].z; d[3] = v[j][i].w; }
            LDS_WAIT(); asm volatile("" ::: "memory");
            const int itj = it0 + j * NGW_;
            if (itj >= 64 * 128 && itj < 64 * 128 + 64 * 512) {
                const f32x4 ga = *(const GAS f32x4*)(g1 + k0 + 8 * c), gb = *(const GAS f32x4*)(g1 + k0 + 8 * c + 4), ba = *(const GAS f32x4*)(b1 + k0 + 8 * c), bb = *(const GAS f32x4*)(b1 + k0 + 8 * c + 4);
#pragma unroll
                for (int q = 0; q < 4; ++q) { const int n = (lane >> 3) + 8 * q; const LAS float* s = scr + (8 * c) * 33 + n;
                    const float w0 = s[0 * 33], w1 = s[1 * 33], w2 = s[2 * 33], w3 = s[3 * 33], w4 = s[4 * 33], w5 = s[5 * 33], w6 = s[6 * 33], w7 = s[7 * 33];
                    float cs = ((ba.x * w0 + ba.y * w1) + (ba.z * w2 + ba.w * w3)) + ((bb.x * w4 + bb.y * w5) + (bb.z * w6 + bb.w * w7));
                    v4u o; o.x = pk2(ga.x * w0, ga.y * w1); o.y = pk2(ga.z * w2, ga.w * w3); o.z = pk2(gb.x * w4, gb.y * w5); o.w = pk2(gb.z * w6, gb.w * w7);
                    *(GAS v4u*)(WT + (size_t)(n0 + n) * K + k0 + 8 * c) = o;
                    float us = ((bf2f(o.x & 0xffffu) + bf2f(o.x >> 16)) + (bf2f(o.y & 0xffffu) + bf2f(o.y >> 16))) + ((bf2f(o.z & 0xffffu) + bf2f(o.z >> 16)) + (bf2f(o.w & 0xffffu) + bf2f(o.w >> 16)));
#pragma unroll
                    for (int x = 1; x < 8; x <<= 1) { us += lane_xor(us, x, lane); cs += lane_xor(cs, x, lane); }
                    if (c == 0) { upart[(size_t)(k0 >> 6) * FFW + n0 + n] = us; cpart[(size_t)(k0 >> 6) * FFW + n0 + n] = cs; } }
            } else {
#pragma unroll
            for (int q = 0; q < 4; ++q) { const int n = (lane >> 3) + 8 * q; const LAS float* s = scr + (8 * c) * 33 + n;
                v4u o; o.x = pk2(s[0 * 33], s[1 * 33]); o.y = pk2(s[2 * 33], s[3 * 33]); o.z = pk2(s[4 * 33], s[5 * 33]); o.w = pk2(s[6 * 33], s[7 * 33]);
                *(GAS v4u*)(WT + (size_t)(n0 + n) * K + k0 + 8 * c) = o; }
            }
            LDS_WAIT(); asm volatile("" ::: "memory"); }
    }
}
template <int R> __device__ __forceinline__ void ln_rows_b(const bf16* src, size_t rstride, const float* g, const float* bta, int lane, float* dstf, bf16* dstb, float* stats, size_t sstride, size_t dstride) {
    f32x4 v[R][16]; float s[R];
#pragma unroll
    for (int r = 0; r < R; ++r) { const GAS unsigned long long* xr = (const GAS unsigned long long*)(src + r * rstride) + lane; s[r] = 0.f;
#pragma unroll
        for (int j = 0; j < 16; ++j) { const unsigned long long w = xr[64 * j]; const unsigned lo = (unsigned)w, hi = (unsigned)(w >> 32);
            v[r][j] = (f32x4){bf2f(lo & 0xffffu), bf2f(lo >> 16), bf2f(hi & 0xffffu), bf2f(hi >> 16)}; s[r] += (v[r][j].x + v[r][j].y) + (v[r][j].z + v[r][j].w); } }
    float rstd[R];
#pragma unroll
    for (int r = 0; r < R; ++r) { const float mean = wave_sum(s[r], lane) * (1.f / DM); float s2 = 0.f;
#pragma unroll
        for (int j = 0; j < 16; ++j) { v[r][j] = v[r][j] - mean; s2 += (v[r][j].x * v[r][j].x + v[r][j].y * v[r][j].y) + (v[r][j].z * v[r][j].z + v[r][j].w * v[r][j].w); }
        rstd[r] = 1.f / sqrtf(wave_sum(s2, lane) * (1.f / DM) + LN_EPS);
        if (stats && lane == 0) { stats[r * sstride] = mean; stats[r * sstride + 1] = rstd[r]; } }
    const GAS f32x4* g4 = (const GAS f32x4*)g + lane; const GAS f32x4* b4 = (const GAS f32x4*)bta + lane;
#pragma unroll
    for (int j = 0; j < 16; ++j) { const f32x4 gv = g4[64 * j], bv = b4[64 * j];
#pragma unroll
        for (int r = 0; r < R; ++r) { const f32x4 o = v[r][j] * rstd[r] * gv + bv;
            if (dstf) ((GAS f32x4*)(dstf + r * dstride) + lane)[64 * j] = o;
            if (dstb) ((GAS unsigned long long*)(dstb + r * dstride) + lane)[64 * j] = (unsigned long long)pk2(o.x, o.y) | ((unsigned long long)pk2(o.z, o.w) << 32); } }
}
__device__ __forceinline__ void grp_barrier(gu32* ctl, const int slot, const int bx, const bool t0) {
    asm volatile("s_waitcnt vmcnt(0)" ::: "memory");
    __syncthreads();
    if (t0) {
        unsigned* bar = (unsigned*)(ctl + CW_BAR);
        __builtin_amdgcn_s_waitcnt(0);
        __builtin_amdgcn_fence(__ATOMIC_RELEASE, "agent"); asm volatile("s_waitcnt vmcnt(0)" ::: "memory");
        unsigned* c = (unsigned*)(ctl + CW_GRP + slot * 64 + (bx & 63));
        (void)xb_add(c, 1u);
        XB_SPIN(xb_ld(c) < 4u, bar);
        __builtin_amdgcn_fence(__ATOMIC_ACQUIRE, "agent");
        asm volatile("s_waitcnt vmcnt(0)" ::: "memory");
    }
    __syncthreads();
}
__device__ __forceinline__ void sincos_d(double x, double& sn, double& cs) {
    const double kq = rint(x * 0.63661977236758134308);
    double r = fma(-kq, 1.57079632673412561417e+00, x); r = fma(-kq, 6.07710050630396597660e-11, r); r = fma(-kq, 2.02226624879595063154e-21, r);
    const int q = ((int)kq) & 3; const double z = r * r;
    const double sp = r + r * z * (-1.66666666666666324348e-01 + z * (8.33333333332248946124e-03 + z * (-1.98412698298579493134e-04 + z * (2.75573137070700676789e-06 + z * (-2.50507602534068634195e-08 + z * 1.58969099521155010221e-10)))));
    const double cp = 1.0 - 0.5 * z + z * z * (4.16666666666666019037e-02 + z * (-1.38888888888741095749e-03 + z * (2.48015872894767294178e-05 + z * (-2.75573143513906633035e-07 + z * (2.08757232129817482790e-09 + z * -1.13596475577881948265e-11)))));
    sn = (q == 0) ? sp : (q == 1) ? cp : (q == 2) ? -sp : -cp;
    cs = (q == 0) ? cp : (q == 1) ? -sp : (q == 2) ? -cp : sp;
}

#ifndef STAG_F32
#define STAG_F32 0
#endif
#ifndef STAG_BF
#define STAG_BF 0
#endif
__device__ __forceinline__ void xcd_stagger(unsigned ticks_per) {
    if (ticks_per == 0u) return;
    const unsigned long long t0 = __builtin_amdgcn_s_memrealtime(), w = (unsigned long long)(xb_xcc_id() & 7u) * ticks_per;
    while (__builtin_amdgcn_s_memrealtime() - t0 < w) __builtin_amdgcn_s_sleep(4);
}
struct Args { const float* in[18]; float* out; unsigned char* ws; int ph_lo, ph_hi; };
static_assert(sizeof(Args) == 18 * 8 + 8 + 8 + 8, "Args has padding");
__device__ const float INV_FREQ[64] = {0x1.0000000000000p+0f, 0x1.bb5fae0000000p-1f, 0x1.7ff2220000000p-1f, 0x1.4c7bc00000000p-1f, 0x1.1feb340000000p-1f, 0x1.f2a79e0000000p-2f, 0x1.afd1360000000p-2f, 0x1.75f0360000000p-2f, 0x1.43d1360000000p-2f, 0x1.186a080000000p-2f, 0x1.e5a8460000000p-3f, 0x1.a48fda0000000p-3f, 0x1.6c310e0000000p-3f, 0x1.3b60800000000p-3f, 0x1.111aee0000000p-3f, 0x1.d8ffac0000000p-4f, 0x1.99999a0000000p-4f, 0x1.62b2f00000000p-4f, 0x1.33281a0000000p-4f, 0x1.09fc9a0000000p-4f, 0x1.ccab840000000p-5f, 0x1.8eec7e0000000p-5f, 0x1.59742a0000000p-5f, 0x1.2b26900000000p-5f, 0x1.030dc60000000p-5f, 0x1.c0a9a40000000p-6f, 0x1.84869e0000000p-6f, 0x1.5073160000000p-6f, 0x1.235a720000000p-6f, 0x1.f89a660000000p-7f, 0x1.b4f7e40000000p-7f, 0x1.7a66220000000p-7f, 0x1.47ae140000000p-7f, 0x1.1bc25a0000000p-7f, 0x1.eb73600000000p-8f, 0x1.a9942a0000000p-8f, 0x1.7089380000000p-8f, 0x1.3f23980000000p-8f, 0x1.145cee0000000p-8f, 0x1.dea41c0000000p-9f, 0x1.9e7c700000000p-9f, 0x1.66ee1e0000000p-9f, 0x1.36d21a0000000p-9f, 0x1.0d28de0000000p-9f, 0x1.d22a500000000p-10f, 0x1.93aeb80000000p-10f, 0x1.5d931c0000000p-10f, 0x1.2eb81c0000000p-10f, 0x1.0624de0000000p-10f, 0x1.c603c40000000p-11f, 0x1.8929180000000p-11f, 0x1.5476880000000p-11f, 0x1.26d42c0000000p-11f, 0x1.fe9f580000000p-12f, 0x1.ba2e4a0000000p-12f, 0x1.7ee9ae0000000p-12f, 0x1.4b96c00000000p-12f, 0x1.1f24e40000000p-12f, 0x1.f1502a0000000p-13f, 0x1.aea7c80000000p-13f, 0x1.74eea60000000p-13f, 0x1.42f22c0000000p-13f, 0x1.17a8e40000000p-13f, 0x1.e459c40000000p-14f};
typedef att::BlockRef<att::bf16, att::bf16> ABR;
typedef att::Bases<att::bf16, att::bf16> ABS;
__device__ __forceinline__ att::DiffRef mkref_diff(int ph, int c, int qb) {
    const int b = ph >> 3, h = ph & 7; att::DiffRef r;
    r.qoff = (unsigned)((((2 * h + c) * NB + b) * KVR + 64 + 256 * qb) * 128); r.koff = (unsigned)(((16 + 2 * h + c) * NB + b) * KVR * 128);
    r.v0off = (unsigned)(((32 + 2 * h) * NB + b) * KVR * 128); r.v1off = (unsigned)(((33 + 2 * h) * NB + b) * KVR * 128);
    r.ooff = (unsigned)((c ? WS_PART1 : WS_PART0) / 2) + (unsigned)((b * T + 256 * qb) * 2048 + h * 256); r.qb = qb; return r;
}
__device__ __forceinline__ int fox_jlo(int idx, const float* cums, const LAS float* base_all, const LAS float* smax2_l, int lane) {
    asm volatile("" : "+v"(lane));
    const int qb = 31 - (idx >> 5), bh = idx & 31;
    const float* cb = cums + (size_t)bh * KVR; const LAS float* bl = base_all + bh * 64;
    const float cq = bl[2 * qb] + cb[64 + 256 * qb], thr = -60.5f - smax2_l[bh];
    int jlo = 0; bool found = false;
#pragma unroll
    for (int pass = 0; pass < 2; ++pass) { const int j = pass * 64 + lane; bool keep = true;
        if (j <= 4 * qb) { const float cend = (j == 0) ? cb[15] : bl[(j - 1) >> 1] + cb[64 * j + 63]; keep = !((cq - cend) <= thr); }
        const unsigned long long km = __ballot(keep);
        if (!found && km != 0ull) { jlo = pass * 64 + (int)__builtin_ctzll(km); found = true; } }
    return __builtin_amdgcn_readfirstlane(jlo);
}
struct FoxRef {
    int idx, jlo_;
    __device__ __forceinline__ int qb() const { return 31 - (idx >> 5); }
    __device__ __forceinline__ int bh() const { return idx & 31; }
    __device__ __forceinline__ unsigned qoff() const { const int h = idx & 15, b = (idx >> 4) & 1; return (unsigned)((((48 + h) * NB + b) * KVR + 64 + 256 * qb()) * 128); }
    __device__ __forceinline__ unsigned koff() const { const int h = idx & 15, b = (idx >> 4) & 1; return (unsigned)(((64 + h) * NB + b) * KVR * 128); }
    __device__ __forceinline__ unsigned voff() const { const int h = idx & 15, b = (idx >> 4) & 1; return (unsigned)(((80 + h) * NB + b) * KVR * 128); }
    __device__ __forceinline__ unsigned ooff() const { const int h = idx & 15, b = (idx >> 4) & 1; return (unsigned)((b * T + 256 * qb()) * (2 * DM) + 2048 + h * 128); }
    __device__ __forceinline__ unsigned coff() const { return (unsigned)(bh() * KVR); }
    __device__ __forceinline__ int P0() const { return 64 + 256 * qb(); }
    __device__ __forceinline__ int ldo() const { return DM; }
    __device__ __forceinline__ int boff() const { return LDSCTL_OFF + 4096 + bh() * 256; }
    __device__ __forceinline__ int jlo() const { return jlo_; }
};
struct FoxNext {
    int cidx, cjlo, nidx, njlo; bool pulled; int wv_, qx;
    unsigned* qh; volatile LAS int* slot; const float* cums; const LAS float* base_all; const LAS float* smax2_l;
    __device__ __forceinline__ void early(int t, int NT) { if (!pulled && t + 5 >= NT) { if (wv_ == 0 && att::fresh_lane() == 0) slot[0] = (int)atomicAdd(qh, 1u); pulled = true; } }
    __device__ __forceinline__ FoxRef operator()() { const int li = __builtin_amdgcn_readfirstlane(slot[0]); nidx = (li < 128) ? (((li >> 2) << 5) | (4 * qx + (li & 3))) : 1024; FoxRef r;
        if (nidx < 1024) { njlo = fox_jlo(nidx, cums, base_all, smax2_l, att::fresh_lane()); r.idx = nidx; r.jlo_ = njlo; } else { njlo = cjlo; r.idx = cidx; r.jlo_ = cjlo; }
        return r; }
};
constexpr int N_PHASES = 8;
#ifndef MK_FUSED
#define MK_FUSED 1
#endif

__device__ __forceinline__ const float* karg_f(int idx) {
    const char __attribute__((address_space(4)))* kb = (const char __attribute__((address_space(4)))*)__builtin_amdgcn_kernarg_segment_ptr();
    int off = 8 * idx; asm volatile("" : "+s"(off));
    return (const float*)(const __attribute__((address_space(1))) float*)*(const unsigned long long __attribute__((address_space(4)))*)(kb + off);
}
__global__ void __launch_bounds__(NWAVES * 64, 2) mk_fwd(Args args) {
    extern __shared__ __attribute__((aligned(16))) unsigned char lds_raw[];
    LAS unsigned char* lds = (LAS unsigned char*)lds_raw;
    volatile LAS unsigned* MISC = (volatile LAS unsigned*)(lds + MISC_OFF);
    const int wv = __builtin_amdgcn_readfirstlane((int)threadIdx.x >> 6);
    constexpr int G = 256;
    const int bx = blockIdx.x;
#define vcu ((bx % 8) * (G / 8) + bx / 8)
    constexpr int NGW = G * NWAVES;
#define LANE_IDS() const int tid = att::fresh_tid(wv), lane = tid & 63, wave = wv, gw = vcu * NWAVES + wave; (void)lane; (void)gw
#define T0() (wv == 0 && att::fresh_tid(0) == 0)
    unsigned char* ws = args.ws;
    gu32* ctl = (gu32*)(ws + WS_CTL);
    float* out = args.out;
    float* stats0 = (float*)(ws + WS_STATS0); float* stats1 = (float*)(ws + WS_STATS1);
    bf16* hmeta = (bf16*)(ws + WS_HMETA); bf16* wff = (bf16*)(ws + WS_WFF);
    float* ftot = (float*)(ws + WS_ZF); float* fmeta = ftot + NB * 64 * 16; float* cums = (float*)(ws + WS_CUMS);
    float* ropeC = (float*)(ws + WS_ROPE); float* ropeS = ropeC + (size_t)LSEQ * 64;
    bf16* Wup = (bf16*)(ws + WS_WUP); bf16* Wdn = (bf16*)(ws + WS_WDN); bf16* Wout = (bf16*)(ws + WS_WOUT); bf16* Win = (bf16*)(ws + WS_WIN);
    bf16* h0b = (bf16*)(ws + WS_H0B); bf16* mixb = (bf16*)out;     bf16* qkv = (bf16*)(ws + WS_QKV);
    bf16* part0 = (bf16*)(ws + WS_PART0); bf16* part1 = (bf16*)(ws + WS_PART1);
    bf16* h1b = (bf16*)(ws + WS_H1B); bf16* actb = (bf16*)(ws + WS_ACT);
    float* rpart = (float*)(ws + WS_RPART); float* upart = (float*)(ws + WS_UPART); float* cpart = (float*)(ws + WS_CPART); float* ucol = (float*)(ws + WS_UCOL); float* ccol = (float*)(ws + WS_CCOL);

    for (int u = threadIdx.x; u < (LDS_BYTES - LDSCTL_OFF) / 4; u += NWAVES * 64) ((LAS unsigned*)(lds + LDSCTL_OFF))[u] = 0u;
    __syncthreads();
#if MK_FUSED
#define OPQ1() ({ int one_; asm volatile("s_mov_b32 %0, 1" : "=s"(one_)); one_ != 0; })
    constexpr int lo = 0, hi = N_PHASES;
#else
    const int lo = args.ph_lo, hi = args.ph_hi;
#define OPQ1() true
#endif
    if (hi - lo > 1) (void)xcd_barrier_post((unsigned*)(ctl + CW_BAR), MISC + 8, T0());
#define MKBAR() XcdBarrier bar_; bar_.bar = (unsigned*)(ctl + CW_BAR); bar_.x = xb_xcc_id(); bar_.st = MISC + 8
#ifndef REP_PHASE
#define REP_PHASE (-1)
#endif
#define IN(k) (lo <= (k) && (k) < hi && OPQ1())
#if defined(PROBE_SPIN)
    volatile LAS unsigned long long* PW = (volatile LAS unsigned long long*)(lds + LDSCTL_OFF + 1024);
    if (bx == 0 && T0()) PW[31] = __builtin_amdgcn_s_memrealtime();
#ifndef PROBE_PH
#define PROBE_PH (-9)
#endif
#define PSTAMP(k) do { if constexpr (PROBE_PH < 0 || (k) == PROBE_PH || (k) == PROBE_PH - 1) { if (bx == 0 && T0()) { const unsigned long long n_ = __builtin_amdgcn_s_memrealtime(); PW[k] = n_ - PW[31]; PW[31] = n_; } } } while (0)
#if defined(PROBE_EPI)
#define PCOPY(j) do { if (bx == 0 && T0()) PW[j] = PW[16]; } while (0)
#else
#define PCOPY(j) do { } while (0)
#endif
#if defined(PROBE_CLK)
#define PCLK0() do { if (bx == 0 && T0()) { PW[29] = __builtin_amdgcn_s_memtime(); PW[30] = __builtin_amdgcn_s_memrealtime(); } } while (0)
#define PCLK1(j) do { if (bx == 0 && T0()) { PW[j] = (__builtin_amdgcn_s_memtime() - PW[29]) * 1000ull / (__builtin_amdgcn_s_memrealtime() - PW[30]); } } while (0)
#else
#define PCLK0() do { } while (0)
#define PCLK1(j) do { } while (0)
#endif
#else
#define PSTAMP(k) do { } while (0)
#define PCOPY(j) do { } while (0)
#define PCLK0() do { } while (0)
#define PCLK1(j) do { } while (0)
#endif
#define NREP(k) ((REP_PHASE == (k)) ? 2 : 1)
#if defined(PROBE_SPIN) && defined(PROBE_SPREAD)
#define SEAM(k) do { if (IN(k) && IN((k) + 1)) { MKBAR(); if ((k) == PROBE_SPREAD && T0()) { const unsigned long long v_ = (__builtin_amdgcn_s_memrealtime() << 10) | (unsigned long long)bx; \
            atomicMax((unsigned long long*)(ctl + 2052), v_); atomicMax((unsigned long long*)(ctl + 2054), (1ull << 62) - v_); } xcd_barrier(bar_, T0()); } } while (0)
#elif defined(PROBE_SPIN) && defined(PROBE_SEAM)
#ifndef PROBE_BLK
#define PROBE_BLK 0
#endif
#define SEAM(k) do { if (IN(k) && IN((k) + 1)) { MKBAR(); unsigned long long sb_ = 0; if ((k) == PROBE_SEAM && bx == PROBE_BLK && T0()) sb_ = __builtin_amdgcn_s_memrealtime(); xcd_barrier(bar_, T0()); \
        if ((k) == PROBE_SEAM && bx == PROBE_BLK && T0()) atomicExch((unsigned*)(ctl + 2048), (unsigned)(__builtin_amdgcn_s_memrealtime() - sb_)); } } while (0)
#else
#define SEAM(k) do { if (IN(k) && IN((k) + 1)) { MKBAR(); xcd_barrier(bar_, T0()); } } while (0)
#endif

    if (IN(0)) {
        LANE_IDS();
        const float* x = karg_f(0); const float* meta_tok = karg_f(1); const float* ln_in_g = karg_f(2); const float* ln_in_b = karg_f(3);
        const float* w_in = karg_f(4);
        LAS float* scr = (LAS float*)(lds + RING_OFF + wave * 16384);
        constexpr int I_IN = 64 * 385;
        for (int it = gw; it < I_IN; it += NGW) { const int kb = it / 385, nb = it % 385;
            if (nb < 384) p0_transpose_item(w_in, INW, DM, Win, scr, 64 * kb, 32 * nb, 32, 1, lane);
            else p0_transpose_item(w_in, INW, DM, wff, scr, 64 * kb, NPROJ, 16, 2, lane);
        }
        for (int m = 2 * gw; m < MR; m += 2 * NGW) ln_rows<2>(x + (size_t)m * DM, DM, ln_in_g, ln_in_b, lane, nullptr, h0b + (size_t)m * DM, stats0 + 2 * m, 2);
        if (gw < NMETA) ln_row(meta_tok + (size_t)gw * DM, ln_in_g, ln_in_b, lane, nullptr, hmeta + (size_t)gw * DM, nullptr);
        for (int idx = bx * (NWAVES * 64) + tid; idx < LSEQ * 64; idx += G * NWAVES * 64) {
            const int pos = idx >> 6, i = idx & 63; const float ang = (float)pos * INV_FREQ[i]; double sn, cs; sincos_d((double)ang, sn, cs);
            ropeC[idx] = (float)cs; ropeS[idx] = (float)sn; }
        if (gw < NGRP * NB) { GAS v4u* p = (GAS v4u*)(qkv + ((size_t)gw * KVR + 16) * 128);
#pragma unroll
            for (int j = 0; j < 12; ++j) p[64 * j + lane] = (v4u){0u, 0u, 0u, 0u}; }
    }
    SEAM(0); PSTAMP(0);

    if (IN(1)) {
        LANE_IDS();
        const int r16 = lane & 15, q4 = lane >> 4;
        if (bx < 128) {
            const float* b_forget = karg_f(5);
            LAS float* wt = (LAS float*)(lds + LDSCTL_OFF + 2048);
            const int m0 = 128 * bx + 16 * wave;
            const bf16* ap = h0b + (size_t)(m0 + r16) * DM + 8 * q4; const bf16* bp = wff + (size_t)r16 * DM + 8 * q4;
            f32x4 acc = {0.f, 0.f, 0.f, 0.f};
            for (int k0 = 0; k0 < DM; k0 += 512) {
                bf16x8 av[16], bv[16];
#pragma unroll
                for (int j = 0; j < 16; ++j) { av[j] = *(const bf16x8*)(ap + k0 + 32 * j); bv[j] = *(const bf16x8*)(bp + k0 + 32 * j); }
                __builtin_amdgcn_sched_barrier(0);
#pragma unroll
                for (int j = 0; j < 16; ++j) acc = __builtin_amdgcn_mfma_f32_16x16x32_bf16(av[j], bv[j], acc, 0, 0, 0);
                __builtin_amdgcn_sched_barrier(0); }
            const float bfg = b_forget[r16];
            const float lf0 = log_sigmoid(acc[0] + bfg), lf1 = lf0 + log_sigmoid(acc[1] + bfg), lf2 = lf1 + log_sigmoid(acc[2] + bfg), lf3 = lf2 + log_sigmoid(acc[3] + bfg);
            float s = lf3; { const float u = lane_up(s, 16, lane); if (q4 >= 1) s += u; } { const float u = lane_up(s, 32, lane); if (q4 >= 2) s += u; }
            const float exg = s - lf3;
            if (q4 == 3) wt[wave * 16 + r16] = s;
            __syncthreads();
            float wex = 0.f, wall = 0.f;
#pragma unroll
            for (int w2 = 0; w2 < NWAVES; ++w2) { const float v = wt[w2 * 16 + r16]; wall += v; if (w2 < wave) wex += v; }
            const int b = m0 >> 13, t0 = (m0 & 8191) + 4 * q4; float* cp = cums + (size_t)(b * NFH + r16) * KVR + 64 + t0; const float o = wex + exg;
            cp[0] = o + lf0; cp[1] = o + lf1; cp[2] = o + lf2; cp[3] = o + lf3;
            if (wave == 0 && q4 == 0) ftot[(size_t)(b * 64 + (bx & 63)) * 16 + r16] = wall;
        } else if (bx < 128 + 96) {
            const int pn = (bx - 128) >> 1, hh = (bx - 128) & 1, wq = wave & 3, kh = wave >> 2, s = 64 * hh + 16 * wq + r16;
            const bf16* ap = hmeta + (size_t)r16 * DM + 8 * q4 + 2048 * kh; const bf16* bp0 = Win + (size_t)(256 * pn + s) * DM + 8 * q4 + 2048 * kh; const bf16* bp1 = bp0 + (size_t)128 * DM;
            f32x4 a0 = {0.f, 0.f, 0.f, 0.f}, a1 = {0.f, 0.f, 0.f, 0.f};
            for (int k0 = 0; k0 < DM / 2; k0 += 512) {
                bf16x8 av[16], b0v[16], b1v[16];
#pragma unroll
                for (int j = 0; j < 16; ++j) { av[j] = *(const bf16x8*)(ap + k0 + 32 * j); b0v[j] = *(const bf16x8*)(bp0 + k0 + 32 * j); b1v[j] = *(const bf16x8*)(bp1 + k0 + 32 * j); }
                __builtin_amdgcn_sched_barrier(0);
#pragma unroll
                for (int j = 0; j < 16; ++j) { a0 = __builtin_amdgcn_mfma_f32_16x16x32_bf16(av[j], b0v[j], a0, 0, 0, 0); a1 = __builtin_amdgcn_mfma_f32_16x16x32_bf16(av[j], b1v[j], a1, 0, 0, 0); }
                __builtin_amdgcn_sched_barrier(0); }
            { LAS f32x4* xch = (LAS f32x4*)(lds + RING_OFF) + (wq * 64 + lane) * 2;
              if (kh == 1) { xch[0] = a0; xch[1] = a1; }
              __syncthreads();
              if (kh == 0) { a0 = a0 + xch[0]; a1 = a1 + xch[1]; } }
            if (kh == 0) {
#pragma unroll
            for (int rg = 0; rg < 4; ++rg) { const int i = 4 * q4 + rg;
                if (pn < 16) { const int hh = s >> 6, dl = s & 63, g = 2 * pn + hh; const float c = ropeC[i * 64 + dl], sn = ropeS[i * 64 + dl];
                    const unsigned o1 = f2bf(a0[rg] * c - a1[rg] * sn), o2 = f2bf(a1[rg] * c + a0[rg] * sn);
#pragma unroll
                    for (int b = 0; b < NB; ++b) { bf16* p = qkv + ((size_t)(g * NB + b) * KVR + i) * 128 + dl; p[0] = (bf16)o1; p[64] = (bf16)o2; }
                } else {
#pragma unroll
                    for (int b = 0; b < NB; ++b) { qkv[((size_t)((2 * pn) * NB + b) * KVR + i) * 128 + s] = (bf16)f2bf(a0[rg]); qkv[((size_t)((2 * pn + 1) * NB + b) * KVR + i) * 128 + s] = (bf16)f2bf(a1[rg]); }
                } }
            if (pn >= 32 && pn < 40) {
                float m0 = 0.f, m1 = 0.f;
#pragma unroll
                for (int rg = 0; rg < 4; ++rg) { float s0 = a0[rg] * a0[rg], s1 = a1[rg] * a1[rg];
#pragma unroll
                    for (int o = 1; o < 16; o <<= 1) { s0 += lane_xor(s0, o, lane); s1 += lane_xor(s1, o, lane); }
                    m0 = fmaxf(m0, s0); m1 = fmaxf(m1, s1); }
                m0 = fmaxf(m0, lane_xor(m0, 16, lane)); m0 = fmaxf(m0, lane_xor(m0, 32, lane)); m1 = fmaxf(m1, lane_xor(m1, 16, lane)); m1 = fmaxf(m1, lane_xor(m1, 32, lane));
                if (lane == 0) { gu32* nrm = ctl + CW_NRM;
#pragma unroll
                    for (int b = 0; b < NB; ++b) { atomicMax((unsigned*)nrm + ((2 * pn - 48) * NB + b) * 16 + 4 + 4 * hh + wq, __float_as_uint(m0 * 1.02f)); atomicMax((unsigned*)nrm + ((2 * pn + 1 - 48) * NB + b) * 16 + 4 + 4 * hh + wq, __float_as_uint(m1 * 1.02f)); } }
            }
            }
            __syncthreads();
        } else if (bx == 224) {
            const float* b_forget = karg_f(5);
            const bf16* ap = hmeta + (size_t)r16 * DM + 8 * q4 + 512 * wave; const bf16* bp = wff + (size_t)r16 * DM + 8 * q4 + 512 * wave;
            f32x4 acc = {0.f, 0.f, 0.f, 0.f};
            {   bf16x8 av[16], bv[16];
#pragma unroll
                for (int j = 0; j < 16; ++j) { av[j] = *(const bf16x8*)(ap + 32 * j); bv[j] = *(const bf16x8*)(bp + 32 * j); }
                __builtin_amdgcn_sched_barrier(0);
#pragma unroll
                for (int j = 0; j < 16; ++j) acc = __builtin_amdgcn_mfma_f32_16x16x32_bf16(av[j], bv[j], acc, 0, 0, 0);
                __builtin_amdgcn_sched_barrier(0); }
            LAS f32x4* xch = (LAS f32x4*)(lds + RING_OFF);
            xch[wave * 64 + lane] = acc;
            __syncthreads();
            if (wave == 0) {
#pragma unroll
                for (int w2 = 1; w2 < NWAVES; ++w2) acc = acc + xch[w2 * 64 + lane];
                const float bfg = b_forget[r16];
                const float lf0 = log_sigmoid(acc[0] + bfg), lf1 = lf0 + log_sigmoid(acc[1] + bfg), lf2 = lf1 + log_sigmoid(acc[2] + bfg), lf3 = lf2 + log_sigmoid(acc[3] + bfg);
                float s = lf3; { const float u = lane_up(s, 16, lane); if (q4 >= 1) s += u; } { const float u = lane_up(s, 32, lane); if (q4 >= 2) s += u; }
                const float exg = s - lf3;
#pragma unroll
                for (int b = 0; b < NB; ++b) { float* cp = cums + (size_t)(b * NFH + r16) * KVR + 4 * q4; cp[0] = exg + lf0; cp[1] = exg + lf1; cp[2] = exg + lf2; cp[3] = exg + lf3; }
                if (q4 == 3) fmeta[r16] = s;
            }
            __syncthreads();
        }
        pg8::Gemm g{h0b, Win, MR, NPROJ, DM}; pg8::StaticOrder S; S.init(MR, NPROJ, G, bx);
        pg8::EpiProj E{qkv, ropeC, ropeS, KVR, NB, (unsigned*)(ctl + CW_NRM)};
        xcd_stagger(STAG_BF);
        pg8::gemm_phase<pg8::EpiProj, pg8::StaticOrder, PG8_ALIGN, PG8_SP2>(lds + RING_OFF, g, S, E, wv); PCOPY(17);
    }
    SEAM(1); PSTAMP(1);

    if (IN(2)) {
        PCLK0();
        const ABS AB{(const att::bf16*)qkv, (att::bf16*)out, cums};
        LAS float* base_all = (LAS float*)(lds + LDSCTL_OFF + 4096);
        LAS float* smax2_l = (LAS float*)(lds + LDSCTL_OFF + 12288);
        volatile LAS int* qslot = (volatile LAS int*)(lds + LDSCTL_OFF + 12288 + 128);
#define QSLOT() ({ int qo_ = LDSCTL_OFF + 12288 + 128; asm volatile("" : "+s"(qo_)); (volatile LAS int*)(lds + qo_); })
        gu32* qh = ctl + CW_QUEUE;
        if (((bx >> 3) & 1) == 0) { LANE_IDS(); late_weight_conv(karg_f(11), karg_f(14), karg_f(15), Wout, Wup, Wdn, (LAS float*)(lds + RING_OFF + wave * 16384), gw, lane, karg_f(12), karg_f(13), upart, cpart); __syncthreads(); }
        int ci = 0;
        {   LANE_IDS();
#pragma unroll
            for (int k = 0; k < 4; ++k) { const int bh = wave * 4 + k, b = bh >> 4, h = bh & 15;
                const float v = ftot[(size_t)(b * 64 + lane) * 16 + h]; float s = v;
#pragma unroll
                for (int o = 1; o < 64; o <<= 1) { const float u = lane_up(s, o, lane); if (lane >= o) s += u; }
                base_all[bh * 64 + lane] = fmeta[h] + (s - v); }
            if (tid < 32) { const int b = tid >> 4, h = tid & 15; const gu32* nq = ctl + CW_NRM + (h * NB + b) * 16; const gu32* nk = ctl + CW_NRM + ((16 + h) * NB + b) * 16;
                float q2 = 0.f, k2 = 0.f, km2 = 0.f;
#pragma unroll
                for (int s = 0; s < 4; ++s) { q2 += __uint_as_float(nq[s]); k2 += __uint_as_float(nk[s]); }
#pragma unroll
                for (int s = 4; s < 12; ++s) km2 += __uint_as_float(nk[s]);
                smax2_l[tid] = 2.f * sqrtf(q2 * fmaxf(k2, km2)) * att::SCALE; }
            __syncthreads();
        }
#define XCC() ((int)(xb_xcc_id() & 7u))
#pragma unroll 1
        for (int kq = 0; kq < 8; ++kq) {
          const int qx = (XCC() + kq) & 7;
#pragma unroll 1
          for (;;) {
            __syncthreads();
            if (T0()) qslot[0] = (int)atomicAdd((unsigned*)(ctl + CW_QUEUE2 + 64 * qx), 1u);
            __syncthreads();
            ci = qslot[0];
            if (ci >= 64) break;
            const int qb = 31 - (ci >> 1), rr = 2 * qx + (ci & 1);
#pragma unroll 1
            for (int c = 0; c < 2; ++c) { const att::DiffRef R = mkref_diff(rr, c, qb); att::diff_block(R, (const att::bf16*)qkv, (att::bf16*)ws, 2048, (char*)lds_raw, wv); }
            asm volatile("s_waitcnt vmcnt(0)" ::: "memory"); __syncthreads();
            {   LANE_IDS();
                const float* lq1 = karg_f(6); const float* lk1 = karg_f(7); const float* lq2 = karg_f(8); const float* lk2 = karg_f(9); const float* subln_g = karg_f(10);
                const float s1 = wave_sum(lq1[lane] * lk1[lane] + lq1[lane + 64] * lk1[lane + 64], lane), s2 = wave_sum(lq2[lane] * lk2[lane] + lq2[lane + 64] * lk2[lane + 64], lane);
                const float lam = expf(s1) - expf(s2) + LAMBDA_INIT;
                const f32x4 gl = *(const f32x4*)(subln_g + 4 * lane) * (1.0f - LAMBDA_INIT);
                const int b = rr >> 3, h = rr & 7; const size_t m0 = (size_t)b * T + 256 * qb + 32 * wave;
#pragma unroll 4
                for (int r = 0; r < 32; ++r) { const size_t m = m0 + r;
                    const unsigned long long u0 = *((const GAS unsigned long long*)(part0 + m * 2048 + h * 256) + lane), u1 = *((const GAS unsigned long long*)(part1 + m * 2048 + h * 256) + lane);
                    f32x4 d; d.x = bf2f((unsigned)u0 & 0xffffu) - lam * bf2f((unsigned)u1 & 0xffffu); d.y = bf2f(((unsigned)u0 >> 16)) - lam * bf2f(((unsigned)u1 >> 16));
                    d.z = bf2f((unsigned)(u0 >> 32) & 0xffffu) - lam * bf2f((unsigned)(u1 >> 32) & 0xffffu); d.w = bf2f((unsigned)(u0 >> 48)) - lam * bf2f((unsigned)(u1 >> 48));
                    const float ss = wave_sum((d.x * d.x + d.y * d.y) + (d.z * d.z + d.w * d.w), lane);
                    const float rq = 1.f / sqrtf(ss * (1.f / 256.f) + SUBLN_EPS);
                    const f32x4 o = d * rq * gl;
                    *((GAS unsigned long long*)(mixb + ((m >> 8) * 512 + (m & 255)) * DM + h * 256) + lane) = (unsigned long long)pk2(o.x, o.y) | ((unsigned long long)pk2(o.z, o.w) << 32); }
            }
          }
        }
        if (((bx >> 3) & 1) == 1) { __syncthreads(); LANE_IDS(); late_weight_conv(karg_f(11), karg_f(14), karg_f(15), Wout, Wup, Wdn, (LAS float*)(lds + RING_OFF + wave * 16384), gw, lane, karg_f(12), karg_f(13), upart, cpart); __syncthreads(); }
#pragma unroll 1
        for (int kf = 0; kf < 8; ++kf) {
            const int qxf = ((int)(xb_xcc_id() & 7u) + kf) & 7;
            __syncthreads();
            if (T0()) QSLOT()[0] = (int)atomicAdd((unsigned*)(ctl + CW_QUEUE3 + 64 * qxf), 1u);
            __syncthreads();
            const int li0 = QSLOT()[0];
            if (li0 >= 128) continue;
            ci = ((li0 >> 2) << 5) | (4 * qxf + (li0 & 3));
            att::Seam<att::bf16> S; S.st_b = 0.f; int cj = fox_jlo(ci, cums, base_all, smax2_l, att::fresh_lane());
            { FoxRef cur; cur.idx = ci; cur.jlo_ = cj; att::causal_swa_prime<att::bf16, att::bf16, 1, FoxRef>(cur, AB, 1 << 30, (char*)lds_raw, S, wv); }
#pragma unroll 1
            for (;;) {
                FoxNext nf; nf.cidx = ci; nf.cjlo = cj; nf.nidx = 1024; nf.njlo = 0; nf.pulled = false; nf.wv_ = wv; nf.qx = qxf; nf.qh = (unsigned*)(ctl + CW_QUEUE3 + 64 * qxf); nf.slot = qslot; nf.cums = cums; nf.base_all = base_all; nf.smax2_l = smax2_l;
                { FoxRef cur; cur.idx = ci; cur.jlo_ = cj; att::causal_swa_block<att::bf16, att::bf16, 1, FoxRef, FoxNext>(cur, nf, AB, KVR, 1 << 30, (char*)lds_raw, S, wv); }
                if (nf.nidx >= 1024) break;
                ci = nf.nidx; cj = nf.njlo;
            }
        }
    }
    PCLK1(22);
    SEAM(2); PSTAMP(2);

    if (IN(3)) {
        {   LANE_IDS();
            LAS float* red = (LAS float*)(lds + LDSCTL_OFF + 4096);
            const int nl = tid & 63, ch = tid >> 6, n = bx * 64 + nl; float us = 0.f, cs = 0.f;
#pragma unroll
            for (int kb = 0; kb < 8; ++kb) { us += upart[(size_t)(8 * ch + kb) * FFW + n]; cs += cpart[(size_t)(8 * ch + kb) * FFW + n]; }
            red[ch * 64 + nl] = us; red[512 + ch * 64 + nl] = cs;
            __syncthreads();
            if (tid < 128) { const LAS float* r = red + (tid >> 6) * 512 + nl; float a = 0.f;
#pragma unroll
                for (int k2 = 0; k2 < 8; ++k2) a += r[k2 * 64];
                __hip_atomic_store((tid < 64 ? ucol : ccol) + n, a, RLX_AGENT); }
            asm volatile("s_waitcnt vmcnt(0)" ::: "memory"); __syncthreads();
            if (T0()) (void)xb_add((unsigned*)(ctl + CW_UC), 1u); }
        const float* x = karg_f(0); const float* ln_in_g = karg_f(2); const float* ln_in_b = karg_f(3);
        pg8::Gemm g{mixb, Wout, MR, DM, DM, 1}; pg8::StaticOrder S; S.init(MR, DM, G, bx);
        pg8::EpiOutS E{x, stats0, ln_in_g, ln_in_b, h1b, DM, DN_ALPHA, rpart};
        pg8::gemm_phase<pg8::EpiOutS, pg8::StaticOrder, PG8_ALIGN, PG8_SP2>(lds + RING_OFF, g, S, E, wv); PCOPY(18);
    }
    if (IN(3) && IN(5)) grp_barrier(ctl, 2, bx, T0());
    PSTAMP(3);

    PSTAMP(4);

    if (IN(5)) {
        pg8::Gemm g{h1b, Wup, MR, FFW, DM}; pg8::StaticOrder S; S.init(MR, FFW, G, bx);
        LAS float* st1 = (LAS float*)(lds + LDSCTL_OFF + 4096);
        {   LANE_IDS(); pg8::Unit u0; S.next(0, u0);
            const int rl = tid >> 1, hf = tid & 1, row = u0.pm * 256 + rl; const GAS f32x4* p = (const GAS f32x4*)(rpart + (size_t)row * 128 + 64 * hf);
            float s1 = 0.f, s2 = 0.f;
#pragma unroll
            for (int i = 0; i < 16; ++i) { const f32x4 v = p[i]; s1 += v.x + v.z; s2 += v.y + v.w; }
            s1 += lane_xor(s1, 1, lane); s2 += lane_xor(s2, 1, lane);
            const float mean = s1 * (1.f / DM), var = fmaxf(s2 * (1.f / DM) - mean * mean, 0.f), rstd = 1.f / sqrtf(var + LN_EPS);
            if (hf == 0) { st1[2 * rl] = mean; st1[2 * rl + 1] = rstd; if (bx < 64) { stats1[2 * row] = mean; stats1[2 * row + 1] = rstd; } }
            if (T0()) { unsigned* bar = (unsigned*)(ctl + CW_BAR); XB_SPIN(xb_ld((unsigned*)(ctl + CW_UC)) < 256u, bar); __builtin_amdgcn_fence(__ATOMIC_ACQUIRE, "agent"); asm volatile("s_waitcnt vmcnt(0)" ::: "memory"); }
            __syncthreads(); }
        pg8::EpiUpS E{actb, FFW, ucol, ccol, st1};
        xcd_stagger(STAG_BF);
        PCLK0();
        pg8::gemm_phase<pg8::EpiUpS, pg8::StaticOrder, PG8_ALIGN, PG8_SP2>(lds + RING_OFF, g, S, E, wv); PCOPY(19); PCLK1(21);
    }
    if (IN(5) && IN(6)) grp_barrier(ctl, 0, bx, T0());
    PSTAMP(5);

    if (IN(6)) {
        const float* ln_attn_g = karg_f(12); const float* ln_attn_b = karg_f(13);
        pg8::Gemm g{actb, Wdn, MR, DM, FFW}; pg8::StaticOrder S; S.init(MR, DM, G, bx);
        pg8::EpiDownB E{h1b, (bf16*)out + DM, stats1, ln_attn_g, ln_attn_b, DM, DN_ALPHA, 2 * DM};
        pg8::gemm_phase<pg8::EpiDownB, pg8::StaticOrder, PG8_ALIGN, PG8_SP2>(lds + RING_OFF, g, S, E, wv); PCOPY(20);
    }
    if (IN(6) && IN(7)) grp_barrier(ctl, 1, bx, T0());
    PSTAMP(6);

    if (IN(7)) { PCLK0(); LANE_IDS(); const float* ln_mlp_g = karg_f(16); const float* ln_mlp_b = karg_f(17);
        const int m0 = (8 * (bx & 7) + ((bx >> 3) & 7)) * 256 + 64 * (bx >> 6) + 8 * wave;
#pragma unroll 1
        for (int m = m0; m < m0 + 8; m += 2) ln_rows_b<2>((const bf16*)out + (size_t)m * (2 * DM) + DM, 2 * DM, ln_mlp_g, ln_mlp_b, lane, out + (size_t)m * DM, nullptr, nullptr, 0, DM); }
    PCLK1(23); PSTAMP(7);
#if defined(PROBE_SPIN)
#ifndef PROBE_MUL
#define PROBE_MUL 1
#endif
#ifndef PROBE_DIV
#define PROBE_DIV 1
#endif
    const unsigned PSEAM = __hip_atomic_load((unsigned*)(ctl + 2048), __ATOMIC_RELAXED, __HIP_MEMORY_SCOPE_AGENT); (void)PSEAM;
    const unsigned long long PMAXV = __hip_atomic_load((unsigned long long*)(ctl + 2052), __ATOMIC_RELAXED, __HIP_MEMORY_SCOPE_AGENT), PMINV = (1ull << 62) - __hip_atomic_load((unsigned long long*)(ctl + 2054), __ATOMIC_RELAXED, __HIP_MEMORY_SCOPE_AGENT);
    const unsigned long long PSPREAD = (PMAXV >> 10) - (PMINV >> 10), PLASTBLK = PMAXV & 1023ull, PFIRSTBLK = PMINV & 1023ull; (void)PSPREAD; (void)PLASTBLK; (void)PFIRSTBLK;
    if (bx == 0 && T0()) { const unsigned long long w = (unsigned long long)(PROBE_SPIN) * PROBE_MUL / PROBE_DIV, t0 = __builtin_amdgcn_s_memrealtime();
        while (__builtin_amdgcn_s_memrealtime() - t0 < w) __builtin_amdgcn_s_sleep(8); }
#endif
#undef IN
#undef SEAM
}

extern "C" void kernel_launch(void* const* d_in, const int* in_sizes, int n_in, void* d_out, int out_size, void* d_ws, size_t ws_size, hipStream_t stream) {
    static int grid = 0;
    if (grid == 0) {
        if (n_in != 18 || in_sizes[0] != MR * DM || out_size != MR * DM || ws_size < WS_END) { fprintf(stderr, "kernel_launch: shape/workspace mismatch (n_in %d, in0 %d, out %d, ws %zu < %zu)\n", n_in, n_in > 0 ? in_sizes[0] : -1, out_size, ws_size, (size_t)WS_END); grid = -1; return; }
        if (hipFuncSetAttribute((const void*)mk_fwd, hipFuncAttributeMaxDynamicSharedMemorySize, LDS_BYTES) != hipSuccess) { fprintf(stderr, "kernel_launch: hipFuncSetAttribute failed\n"); grid = -1; return; }
        int per_cu = 0;
        if (hipOccupancyMaxActiveBlocksPerMultiprocessor(&per_cu, (const void*)mk_fwd, NWAVES * 64, LDS_BYTES) != hipSuccess || per_cu < 1) fprintf(stderr, "kernel_launch: occupancy query reports %d\n", per_cu);
        (void)hipGetLastError();
        grid = 256;
    }
    if (grid < 0) return;
    if (hipMemsetAsync((char*)d_ws + WS_CTL, 0, CTL_ZERO_BYTES, stream) != hipSuccess) { fprintf(stderr, "kernel_launch: memset failed\n"); return; }
    Args a{};
    for (int i = 0; i < 18; ++i) a.in[i] = (const float*)d_in[i];
    a.out = (float*)d_out; a.ws = (unsigned char*)d_ws;
#if MK_FUSED
    a.ph_lo = 0; a.ph_hi = N_PHASES;
    hipLaunchKernelGGL(mk_fwd, dim3(grid), dim3(NWAVES * 64), LDS_BYTES, stream, a);
#else
    for (int p = 0; p < N_PHASES; ++p) { a.ph_lo = p; a.ph_hi = p + 1;
        for (int r = 0; r < ((p == REP_PHASE) ? 2 : 1); ++r) hipLaunchKernelGGL(mk_fwd, dim3(grid), dim3(NWAVES * 64), LDS_BYTES, stream, a); }
#endif
    const hipError_t le = hipPeekAtLastError();
    if (le != hipSuccess) fprintf(stderr, "kernel_launch: launch failed: %s\n", hipGetErrorName(le));
}
```
